# Optimizing an MI355X kernel written in HIP

```python
import math
import jax, jax.numpy as jnp
from jax import lax
import numpy as np

D_MODEL = 2048
BATCH = 4
SEQ = 4096
DEPTH = 2

MEM_LEN = 256
HEAD_DIM = 128
A_HEADS = 8
A_PATTERNS = ((128, 1), (512, 4), (2048, 16))
A_BLOCK = 128
N_BUCKETS = 32
MAX_DISTANCE = 2048
B_HEADS = 4
B_DK = 512
B_DV = 1024
B_GATE_RANK = 16
B_GATE_TAU = 16.0
B_CHUNK = 64
C_HEADS = 8
C_Q_RANK = 512
C_KV_RANK = 512
C_NOPE = 128
C_ROPE = 64
C_V = 128
ROPE_THETA = 10000.0
C_BLOCK = 128
X_HEADS = 4
X_HEAD_DIM = D_MODEL // X_HEADS
D_FF = -(-8 * D_MODEL // (3 * 256)) * 256
N_BRANCH = 3
IN_SIZES = (A_HEADS * HEAD_DIM, A_HEADS * HEAD_DIM, A_HEADS * HEAD_DIM,
            B_DK, B_DK, B_DV, B_GATE_RANK, B_DV,
            C_Q_RANK, C_KV_RANK, C_ROPE,
            N_BRANCH * D_MODEL)
D_IN = sum(IN_SIZES)
F32 = jnp.float32
NEG = -1e30
EPS = 1e-6

kernel_name = 'hybrid_gated_dilated_gla_mla_block'


def rmsnorm(x, g):
    xf = x.astype(F32)
    y = xf * lax.rsqrt(jnp.mean(xf * xf, axis=-1, keepdims=True) + EPS)
    return (y * g.astype(F32)).astype(x.dtype)


def split_columns(z):
    idx, acc = [], 0
    for size in IN_SIZES[:-1]:
        acc += size
        idx.append(acc)
    return jnp.split(z, idx, axis=-1)


def t5_bucket(dist):
    max_exact = N_BUCKETS // 2
    n = jnp.maximum(dist, 1).astype(F32)
    large = max_exact + (jnp.log(n / max_exact) / math.log(MAX_DISTANCE / max_exact)
                         * (N_BUCKETS - max_exact)).astype(jnp.int32)
    large = jnp.minimum(large, N_BUCKETS - 1)
    return jnp.where(dist < max_exact, dist, large)


def dilated_attention(q, k, v, rel_bias):
    b, s, h, d = q.shape
    scale = d ** -0.5
    qi = jnp.arange(A_BLOCK)[:, None]
    kj = jnp.arange(2 * A_BLOCK)[None, :]
    steps_back = qi + A_BLOCK - kj
    outs, lses = [], []
    for window, dil in A_PATTERNS:
        n_steps = window // dil
        L = s // dil
        nb = -(-L // A_BLOCK)
        Lp = nb * A_BLOCK

        def to_blocks(t):
            t = t.reshape(b, L, dil, h, d).transpose(0, 2, 1, 3, 4)
            t = jnp.pad(t, ((0, 0), (0, 0), (0, Lp - L), (0, 0), (0, 0)))
            return t.reshape(b, dil, nb, A_BLOCK, h, d)

        def with_prev(t):
            prev = jnp.pad(t[:, :, :-1], ((0, 0), (0, 0), (1, 0), (0, 0), (0, 0), (0, 0)))
            return jnp.concatenate([prev, t], axis=3)

        qb = to_blocks(q)
        kb = with_prev(to_blocks(k))
        vb = with_prev(to_blocks(v))
        key_idx = jnp.arange(nb)[:, None, None] * A_BLOCK + kj[None] - A_BLOCK
        valid = (steps_back >= 0) & (steps_back <= n_steps) & (key_idx >= 0)
        dist = jnp.clip(steps_back, 0, n_steps) * dil
        bias = rel_bias[t5_bucket(dist)].astype(F32).transpose(2, 0, 1)
        logits = jnp.einsum('brnqhd,brnkhd->brnhqk', qb, kb).astype(F32) * scale + bias
        logits = jnp.where(valid[None, None, :, None], logits, NEG)
        lse = jax.nn.logsumexp(logits, axis=-1)
        p = jnp.exp(logits - lse[..., None]).astype(v.dtype)
        o = jnp.einsum('brnhqk,brnkhd->brnqhd', p, vb)
        o = o.reshape(b, dil, Lp, h, d)[:, :, :L].transpose(0, 2, 1, 3, 4).reshape(b, s, h, d)
        lse = lse.transpose(0, 1, 2, 4, 3).reshape(b, dil, Lp, h)[:, :, :L]
        lse = lse.transpose(0, 2, 1, 3).reshape(b, s, h)
        outs.append(o)
        lses.append(lse)
    wts = jax.nn.softmax(jnp.stack(lses, axis=0), axis=0)
    out = jnp.sum(wts[..., None] * jnp.stack(outs, axis=0).astype(F32), axis=0)
    return out.astype(q.dtype)


def gated_linear_attention(q, k, v, log_a, r, norm_g):
    b, s, h, dk = q.shape
    dv = v.shape[-1]
    c = B_CHUNK
    n = s // c
    qc = (q.astype(F32) * dk ** -0.5).reshape(b, n, c, h, dk)
    kc = k.astype(F32).reshape(b, n, c, h, dk)
    vc = v.astype(F32).reshape(b, n, c, h, dv)
    cum = jnp.cumsum(log_a.astype(F32).reshape(b, n, c, h, dk), axis=2)
    cum_last = cum[:, :, -1:]
    q_dec = qc * jnp.exp(cum)
    k_inv = kc * jnp.exp(-cum)
    k_state = kc * jnp.exp(cum_last - cum)
    causal = jnp.tril(jnp.ones((c, c), dtype=bool))
    att = jnp.where(causal, jnp.einsum('bnihk,bnjhk->bnhij', q_dec, k_inv), 0.0)
    o_intra = jnp.einsum('bnhij,bnjhv->bnihv', att, vc)
    d_state = jnp.einsum('bnjhk,bnjhv->nbhkv', k_state, vc)
    decay = jnp.exp(cum_last[:, :, 0]).transpose(1, 0, 2, 3)

    def step(state, inp):
        dec, ds = inp
        return dec[..., None] * state + ds, state

    _, prev_states = lax.scan(step, jnp.zeros((b, h, dk, dv), F32), (decay, d_state))
    o_inter = jnp.einsum('bnihk,nbhkv->bnihv', q_dec, prev_states)
    o = (o_intra + o_inter).reshape(b, s, h, dv)
    o = rmsnorm(o, norm_g) * jax.nn.silu(r.astype(F32))
    return o.reshape(b, s, h * dv).astype(v.dtype)


def rope_tables(s):
    pos = jnp.arange(s, dtype=F32)
    inv = ROPE_THETA ** (-jnp.arange(0, C_ROPE, 2, dtype=F32) / C_ROPE)
    ang = pos[:, None] * inv[None, :]
    return jnp.cos(ang), jnp.sin(ang)


def apply_rope(x, cos, sin):
    half = x.shape[-1] // 2
    x1 = x[..., :half].astype(F32)
    x2 = x[..., half:].astype(F32)
    return jnp.concatenate([x1 * cos - x2 * sin, x1 * sin + x2 * cos], axis=-1).astype(x.dtype)


def latent_attention(c_qa, c_kva, c_kr, q_a_norm, w_qb, kv_a_norm, w_kvb):
    b, s, _ = c_qa.shape
    q = (rmsnorm(c_qa, q_a_norm) @ w_qb).reshape(b, s, C_HEADS, C_NOPE + C_ROPE)
    kv = (rmsnorm(c_kva, kv_a_norm) @ w_kvb).reshape(b, s, C_HEADS, C_NOPE + C_V)
    cos, sin = rope_tables(s)
    q = jnp.concatenate([q[..., :C_NOPE], apply_rope(q[..., C_NOPE:], cos[:, None], sin[:, None])], axis=-1)
    k_rope = apply_rope(c_kr, cos, sin)
    k = jnp.concatenate([kv[..., :C_NOPE],
                         jnp.broadcast_to(k_rope[:, :, None], (b, s, C_HEADS, C_ROPE))], axis=-1)
    v = kv[..., C_NOPE:]
    scale = (C_NOPE + C_ROPE) ** -0.5
    nb = s // C_BLOCK
    q_blocks = q.reshape(b, nb, C_BLOCK, C_HEADS, C_NOPE + C_ROPE).transpose(1, 0, 2, 3, 4)
    k_pos = jnp.arange(s)

    def one_block(args):
        qblk, start = args
        logits = jnp.einsum('bqhd,bkhd->bhqk', qblk, k).astype(F32) * scale
        q_pos = start + jnp.arange(C_BLOCK)
        logits = jnp.where(k_pos[None, :] <= q_pos[:, None], logits, NEG)
        p = jax.nn.softmax(logits, axis=-1).astype(v.dtype)
        return jnp.einsum('bhqk,bkhd->bqhd', p, v)

    o = lax.map(one_block, (q_blocks, jnp.arange(nb) * C_BLOCK))
    return o.transpose(1, 0, 2, 3, 4).reshape(b, s, C_HEADS * C_V)


def memory_cross_attention(hx, mem_n, w_xq, w_xkv, w_xo):
    b, s, _ = hx.shape
    m = mem_n.shape[1]
    q = (hx @ w_xq).reshape(b, s, X_HEADS, X_HEAD_DIM)
    kv = (mem_n @ w_xkv).reshape(b, m, 2, X_HEADS, X_HEAD_DIM)
    logits = jnp.einsum('bshd,bmhd->bhsm', q, kv[:, :, 0]).astype(F32) * X_HEAD_DIM ** -0.5
    p = jax.nn.softmax(logits, axis=-1).astype(hx.dtype)
    o = jnp.einsum('bhsm,bmhd->bshd', p, kv[:, :, 1]).reshape(b, s, X_HEADS * X_HEAD_DIM)
    return o @ w_xo


def setup_inputs(seed: int = 0) -> dict:
    key = jax.random.key(seed)
    ks = iter(jax.random.split(key, 40))
    L, D = DEPTH, D_MODEL

    def w(shape, fan_in):
        return jax.random.normal(next(ks), shape, F32) * fan_in ** -0.5

    def gain(shape):
        return 1.0 + 0.02 * jax.random.normal(next(ks), shape, F32)

    def small(shape, sc):
        return sc * jax.random.normal(next(ks), shape, F32)

    return {
        'x': jax.random.normal(next(ks), (BATCH, SEQ, D), F32),
        'mem': jax.random.normal(next(ks), (BATCH, MEM_LEN, D), F32),
        'rel_bias': small((N_BUCKETS, A_HEADS), 0.5),
        'norm_mix': gain((L, D)),
        'w_in': w((L, D, D_IN), D),
        'b_gate': small((L, N_BRANCH * D), 0.02),
        'w_alpha': w((L, B_GATE_RANK, B_DK), B_GATE_RANK),
        'b_alpha': small((L, B_DK), 0.1),
        'gla_norm': gain((L, B_HEADS, B_DV // B_HEADS)),
        'q_a_norm': gain((L, C_Q_RANK)),
        'w_qb': w((L, C_Q_RANK, C_HEADS * (C_NOPE + C_ROPE)), C_Q_RANK),
        'kv_a_norm': gain((L, C_KV_RANK)),
        'w_kvb': w((L, C_KV_RANK, C_HEADS * (C_NOPE + C_V)), C_KV_RANK),
        'w_up_a': w((L, A_HEADS * HEAD_DIM, D), A_HEADS * HEAD_DIM),
        'w_up_b': w((L, B_DV, D), B_DV),
        'w_up_c': w((L, C_HEADS * C_V, D), C_HEADS * C_V),
        'w_o': w((L, D, D), D),
        'norm_x': gain((L, D)),
        'norm_mem': gain((L, D)),
        'w_xq': w((L, D, X_HEADS * X_HEAD_DIM), D),
        'w_xkv': w((L, D, 2 * X_HEADS * X_HEAD_DIM), D),
        'w_xo': w((L, X_HEADS * X_HEAD_DIM, D), X_HEADS * X_HEAD_DIM),
        'norm_ffn': gain((L, D)),
        'w_ffn_gate': w((L, D, D_FF), D),
        'w_ffn_up': w((L, D, D_FF), D),
        'w_ffn_down': w((L, D_FF, D), D_FF),
        'norm_final': gain((D,)),
    }


def reference(x, mem, rel_bias, norm_mix, w_in, b_gate, w_alpha, b_alpha, gla_norm,
              q_a_norm, w_qb, kv_a_norm, w_kvb, w_up_a, w_up_b, w_up_c, w_o,
              norm_x, norm_mem, w_xq, w_xkv, w_xo,
              norm_ffn, w_ffn_gate, w_ffn_up, w_ffn_down, norm_final):
    b, s, d = x.shape
    for l in range(DEPTH):
        h = rmsnorm(x, norm_mix[l])
        z = h @ w_in[l]
        (aq, ak, av, bq, bk, bv, b_lr, br, c_qa, c_kva, c_kr, gates) = split_columns(z)
        o_a = dilated_attention(aq.reshape(b, s, A_HEADS, HEAD_DIM), ak.reshape(b, s, A_HEADS, HEAD_DIM),
                                av.reshape(b, s, A_HEADS, HEAD_DIM), rel_bias).reshape(b, s, A_HEADS * HEAD_DIM)
        log_a = jax.nn.log_sigmoid((b_lr @ w_alpha[l] + b_alpha[l]).astype(F32)) / B_GATE_TAU
        o_b = gated_linear_attention(bq.reshape(b, s, B_HEADS, B_DK // B_HEADS),
                                     bk.reshape(b, s, B_HEADS, B_DK // B_HEADS),
                                     bv.reshape(b, s, B_HEADS, B_DV // B_HEADS),
                                     log_a.reshape(b, s, B_HEADS, B_DK // B_HEADS),
                                     br.reshape(b, s, B_HEADS, B_DV // B_HEADS), gla_norm[l])
        o_c = latent_attention(c_qa, c_kva, c_kr, q_a_norm[l], w_qb[l], kv_a_norm[l], w_kvb[l])
        g = jax.nn.sigmoid((gates + b_gate[l]).astype(F32)).astype(x.dtype).reshape(b, s, N_BRANCH, d)
        merged = (g[:, :, 0] * (o_a @ w_up_a[l]) + g[:, :, 1] * (o_b @ w_up_b[l])
                  + g[:, :, 2] * (o_c @ w_up_c[l]))
        x = x + (merged @ w_o[l]).astype(x.dtype)
        x = x + memory_cross_attention(rmsnorm(x, norm_x[l]), rmsnorm(mem, norm_mem[l]),
                                       w_xq[l], w_xkv[l], w_xo[l]).astype(x.dtype)
        hf = rmsnorm(x, norm_ffn[l])
        x = x + ((jax.nn.silu(hf @ w_ffn_gate[l]) * (hf @ w_ffn_up[l])) @ w_ffn_down[l]).astype(x.dtype)
    return rmsnorm(x, norm_final)
```

```cpp
#include <hip/hip_runtime.h>
#include <cstdio>
#include <cstdint>

#ifndef A_SINGLE
#define A_SINGLE 0
#endif
#ifndef GLA_NAIVE
#define GLA_NAIVE 0
#endif
#ifndef PHASE_TWICE
#define PHASE_TWICE 0
#endif
#ifndef PHASE_MASK
#define PHASE_MASK 0x7fff
#endif
#ifndef MK_ONE_LAUNCH
#define MK_ONE_LAUNCH 1
#endif

template <int CTRL> __device__ __forceinline__ float dpp_f(float v) { return __uint_as_float((unsigned)__builtin_amdgcn_update_dpp(0, (int)__float_as_uint(v), CTRL, 0xF, 0xF, true)); }
__device__ __forceinline__ float lane_xor1(float v) { return dpp_f<0xB1>(v); }
__device__ __forceinline__ float sum_xor16(float v) { auto r = __builtin_amdgcn_permlane16_swap(__float_as_uint(v), __float_as_uint(v), false, false); return __uint_as_float(r[0]) + __uint_as_float(r[1]); }
__device__ __forceinline__ float sum_xor32(float v) { auto r = __builtin_amdgcn_permlane32_swap(__float_as_uint(v), __float_as_uint(v), false, false); return __uint_as_float(r[0]) + __uint_as_float(r[1]); }
__device__ __forceinline__ float max_xor16(float v) { auto r = __builtin_amdgcn_permlane16_swap(__float_as_uint(v), __float_as_uint(v), false, false); return fmaxf(__uint_as_float(r[0]), __uint_as_float(r[1])); }
__device__ __forceinline__ float max_xor32(float v) { auto r = __builtin_amdgcn_permlane32_swap(__float_as_uint(v), __float_as_uint(v), false, false); return fmaxf(__uint_as_float(r[0]), __uint_as_float(r[1])); }
__device__ __forceinline__ float wave_sum(float v) { v += dpp_f<0xB1>(v); v += dpp_f<0x4E>(v); v += dpp_f<0x141>(v); v += dpp_f<0x140>(v); return sum_xor32(sum_xor16(v)); }
__device__ __forceinline__ float wave_max(float v) { v = fmaxf(v, dpp_f<0xB1>(v)); v = fmaxf(v, dpp_f<0x4E>(v)); v = fmaxf(v, dpp_f<0x141>(v)); v = fmaxf(v, dpp_f<0x140>(v)); return max_xor32(max_xor16(v)); }

namespace pg8 {
#define PG8_LAS __attribute__((address_space(3)))
typedef unsigned short bf16_t;
typedef short bf16x8 __attribute__((ext_vector_type(8)));
typedef float f32x4 __attribute__((ext_vector_type(4)));
typedef int i32x4 __attribute__((ext_vector_type(4)));
typedef int i32x8 __attribute__((ext_vector_type(8)));
typedef unsigned u32x4 __attribute__((ext_vector_type(4)));
typedef unsigned u32x2 __attribute__((ext_vector_type(2)));
constexpr int BM = 256, BK = 64, HALF = 128, HTB = HALF * BK * 2, STAGE_BYTES = 8 * HTB, NXCD = 8, WGM = 8;

__host__ __device__ __forceinline__ int lds_byte(int r, int c) { const int st = (r >> 4) * 2 + (c >> 5), rr = r & 15, cc = c & 31, ob = rr * 64 + cc * 2; return st * 1024 + (ob ^ (((ob >> 9) & 1) << 5)); }
__host__ __device__ __forceinline__ void stage_rc(int b, int& R, int& C) { const int st = b / 1024, sb = b % 1024, swz = sb ^ (((sb >> 9) & 1) << 5); R = (st >> 1) * 16 + swz / 64; C = (st & 1) * 32 + (swz % 64) / 2; }
__host__ __device__ __forceinline__ int perm32(int rho) { const int n = rho >> 4, i = rho & 15; return 8 * (i >> 2) + 4 * n + (i & 3); }

struct Unit { int pm, pn, ka, kb, br; long aoff, boff; };
struct Gemm { const bf16_t* A; const bf16_t* Bt; int lda, ldb, K; };

__device__ __forceinline__ void map_tile(int L, int nM, int nN, int& pm, int& pn) {
    const int nwg = nM * nN; int wgid = L; { const int q = nwg / NXCD, r = nwg % NXCD, xcd = wgid % NXCD, off = wgid / NXCD; wgid = (xcd < r ? xcd * (q + 1) : r * (q + 1) + (xcd - r) * q) + off; }
    const int nig = WGM * nN, gid = wgid / nig, fm = gid * WGM, gsz = (nM - fm) < WGM ? (nM - fm) : WGM;
    pm = fm + ((wgid % nig) % gsz); pn = (wgid % nig) / gsz;
}
struct StaticOrder {
    int nM, nN, nwg, G, c, nbr, kbr;
    __device__ __forceinline__ void init(int M, int N, int G_, int c_, int nbr_ = 1, int kbr_ = 0) { nM = M / BM; nN = N / BM; nwg = nM * nN; G = G_; c = c_; nbr = nbr_; kbr = kbr_; }
    __device__ __forceinline__ bool next(int i, Unit& u) const {
        const int it = i / nbr, br = i - it * nbr;
        const long L = (long)it * G + c; if (L >= nwg) return false;
        map_tile((int)L, nM, nN, u.pm, u.pn); u.br = br; u.ka = br * kbr; u.kb = br * kbr; u.aoff = 0; u.boff = 0; return true;
    }
    __device__ __forceinline__ void a_ready(const Unit&) const {}
    __device__ __forceinline__ void done(const Unit&) const {}
};


struct WinOrder {
    int G, c; long aoff3, boff3;
    __device__ __forceinline__ bool next(int i, Unit& u) const {
        const int L = i * G + c; u.ka = 0; u.kb = 0;
        if (L < 64 * 29) { map_tile(L, 64, 29, u.pm, u.pn); u.br = (u.pn < 12) ? 0 : 1; u.aoff = 0; u.boff = 0; return true; }
        const int j = L - 64 * 29; if (j >= 64) return false;
        u.pm = j >> 4; u.pn = j & 15; u.br = 3; u.aoff = aoff3; u.boff = boff3; return true;
    }
    __device__ __forceinline__ void a_ready(const Unit&) const {}
    __device__ __forceinline__ void done(const Unit&) const {}
};
struct GateOrder {
    int G, c;
    __device__ __forceinline__ bool next(int i, Unit& u) const {
        u.ka = 0; u.kb = 0; u.br = 2; u.aoff = 0; u.boff = 0;
        if (G == 256) {
            const int j = c >> 6, cnt = (j < 2) ? 5 : 7, base = (j == 0) ? 0 : ((j == 1) ? 5 : ((j == 2) ? 10 : 17));
            if (i >= cnt) return false;
            u.pm = 8 * (c & 7) + ((c >> 3) & 7); u.pn = 29 + base + i; return true; }
        const int L = i * G + c; if (L >= 64 * 24) return false;
        map_tile(L, 64, 24, u.pm, u.pn); u.pn += 29; return true; }
    __device__ __forceinline__ void a_ready(const Unit&) const {}
    __device__ __forceinline__ void done(const Unit&) const {}
};
struct UpOrder {
    int G, c; long aoff1, boff1;
    __device__ __forceinline__ bool next(int i, Unit& u) const {
        const int L = i * G + c; u.ka = 0; u.kb = 0;
        if (L < 64 * 6) { map_tile(L, 64, 6, u.pm, u.pn); u.br = 0; u.aoff = 0; u.boff = 0; return true; }
        const int j = L - 64 * 6; if (j >= 64 * 8) return false;
        map_tile(j, 64, 8, u.pm, u.pn); u.br = 1; u.aoff = aoff1; u.boff = boff1; return true;
    }
    __device__ __forceinline__ void a_ready(const Unit&) const {}
    __device__ __forceinline__ void done(const Unit&) const {}
};
__device__ __forceinline__ unsigned cvt_pk_bf16(float lo, float hi) { unsigned r; asm volatile("v_cvt_pk_bf16_f32 %0, %1, %2" : "=v"(r) : "v"(lo), "v"(hi)); return r; }
__device__ __forceinline__ float bf_lo(unsigned w) { return __uint_as_float(w << 16); }
__device__ __forceinline__ float bf_hi(unsigned w) { return __uint_as_float(w & 0xffff0000u); }
__device__ __forceinline__ float fast_sigmoid(float x) { return __builtin_amdgcn_rcpf(1.0f + __builtin_amdgcn_exp2f(-1.44269504089f * x)); }

__device__ __forceinline__ float row_rstd(const float* SS, size_t row) {
    const f32x4* p = (const f32x4*)(SS + row * 32); float s = 0.f;
#pragma unroll
    for (int j = 0; j < 8; ++j) { const f32x4 v = p[j]; s += (v[0] + v[1]) + (v[2] + v[3]); }
    return 1.0f / sqrtf(s * (1.0f / 2048.0f) + 1e-6f);
}
struct EpiBf16 {
    static constexpr bool PERM = true;
    bf16_t* O; int ldc;
    __device__ __forceinline__ void operator()(const f32x4 (&acc)[2][2][4][2], const Unit& u, int wr, int wc, int fr, int fq) const {
        const int row0 = u.pm * BM + wr * 64 + fr, col0 = u.pn * BM + wc * 32 + 8 * fq;
        float zf = 0.f; asm volatile("" : "+v"(zf));
#pragma unroll
        for (int ai = 0; ai < 2; ++ai)
#pragma unroll
            for (int m = 0; m < 4; ++m) { bf16_t* rowp = O + (size_t)(row0 + ai * HALF + m * 16) * ldc + col0;
#pragma unroll
                for (int bj = 0; bj < 2; ++bj) { const f32x4 v0 = acc[ai][bj][m][0] + zf, v1 = acc[ai][bj][m][1] + zf;
                    u32x4 w; w.x = cvt_pk_bf16(v0[0], v0[1]); w.y = cvt_pk_bf16(v0[2], v0[3]); w.z = cvt_pk_bf16(v1[0], v1[1]); w.w = cvt_pk_bf16(v1[2], v1[3]);
                    *(u32x4*)(rowp + bj * HALF) = w; } }
    }
};
struct EpiRes {
    static constexpr bool PERM = false;
    const float* base; float* out; int ldc;
    __device__ __forceinline__ void operator()(const f32x4 (&acc)[2][2][4][2], const Unit& u, int wr, int wc, int fr, int fq) const {
        const int row0 = u.pm * BM + wr * 64 + fr, col0 = u.pn * BM + wc * 32 + 4 * fq;
#pragma unroll
        for (int ai = 0; ai < 2; ++ai)
#pragma unroll
            for (int m = 0; m < 4; ++m) { const size_t off = (size_t)(row0 + ai * HALF + m * 16) * ldc + col0;
#pragma unroll
                for (int bj = 0; bj < 2; ++bj)
#pragma unroll
                    for (int n = 0; n < 2; ++n) { const f32x4 bs = *(const f32x4*)(base + off + bj * HALF + n * 16); *(f32x4*)(out + off + bj * HALF + n * 16) = bs + acc[ai][bj][m][n]; }
                if (m & 1) asm volatile("" ::: "memory"); }
    }
};
struct EpiGateRS {
    static constexpr bool PERM = true;
    bf16_t* O; int ldc; const float* RS; const float* bias;
    __device__ __forceinline__ void operator()(const f32x4 (&acc)[2][2][4][2], const Unit& u, int wr, int wc, int fr, int fq) const {
        const int row0 = u.pm * BM + wr * 64 + fr, col0 = u.pn * BM + wc * 32 + 8 * fq;
        f32x4 bg[2][2];
#pragma unroll
        for (int bj = 0; bj < 2; ++bj) { bg[bj][0] = *(const f32x4*)(bias + col0 + bj * HALF); bg[bj][1] = *(const f32x4*)(bias + col0 + bj * HALF + 4); }
#pragma unroll
        for (int ai = 0; ai < 2; ++ai)
#pragma unroll
            for (int m = 0; m < 4; ++m) { const size_t row = (size_t)(row0 + ai * HALF + m * 16); const float rs = RS[row]; bf16_t* rowp = O + row * ldc + col0;
#pragma unroll
                for (int bj = 0; bj < 2; ++bj) { const f32x4 a0 = acc[ai][bj][m][0] * rs + bg[bj][0], a1 = acc[ai][bj][m][1] * rs + bg[bj][1];
                    u32x4 w; w.x = cvt_pk_bf16(fast_sigmoid(a0[0]), fast_sigmoid(a0[1])); w.y = cvt_pk_bf16(fast_sigmoid(a0[2]), fast_sigmoid(a0[3]));
                    w.z = cvt_pk_bf16(fast_sigmoid(a1[0]), fast_sigmoid(a1[1])); w.w = cvt_pk_bf16(fast_sigmoid(a1[2]), fast_sigmoid(a1[3]));
                    *(u32x4*)(rowp + bj * HALF) = w; } }
    }
};
template <bool LRS> struct EpiWin {
    static constexpr bool PERM = true;
    bf16_t* za; bf16_t* zbc; bf16_t* zg; bf16_t* memkv; const float* RS; const float* bgate; const PG8_LAS float* rsl; float gsc = 1.0f;
    __device__ __forceinline__ void operator()(const f32x4 (&acc)[2][2][4][2], const Unit& u, int wr, int wc, int fr, int fq) const {
        const int row0 = u.pm * BM + wr * 64 + fr, cw = wc * 32 + 8 * fq;
        bf16_t* O; int ldc, colb;
        if (u.br == 0) { O = za; ldc = 3072; colb = u.pn * BM; } else if (u.br == 1) { O = zbc; ldc = 4352; colb = (u.pn - 12) * BM; } else if (u.br == 2) { O = zg; ldc = 6144; colb = (u.pn - 29) * BM; } else { O = memkv; ldc = 4096; colb = u.pn * BM; }
        const bool gate = (u.br == 2), scaled = (u.br != 3);
        f32x4 bg[2][2];
#pragma unroll
        for (int bj = 0; bj < 2; ++bj) { bg[bj][0] = gate ? *(const f32x4*)(bgate + colb + cw + bj * HALF) : (f32x4){0.f, 0.f, 0.f, 0.f}; bg[bj][1] = gate ? *(const f32x4*)(bgate + colb + cw + bj * HALF + 4) : (f32x4){0.f, 0.f, 0.f, 0.f}; }
#pragma unroll
        for (int ai = 0; ai < 2; ++ai)
#pragma unroll
            for (int m = 0; m < 4; ++m) { const size_t row = (size_t)(row0 + ai * HALF + m * 16); const float rs = scaled ? (LRS ? rsl[wr * 64 + fr + ai * HALF + m * 16] : row_rstd(RS, row)) : 1.0f; bf16_t* rowp = O + row * ldc + colb + cw;
#pragma unroll
                for (int bj = 0; bj < 2; ++bj) { const float rg = gate ? rs * gsc : rs; f32x4 a0 = acc[ai][bj][m][0] * rg + bg[bj][0], a1 = acc[ai][bj][m][1] * rg + bg[bj][1];
                    if (gate) {
#pragma unroll
                        for (int e = 0; e < 4; ++e) { a0[e] = fast_sigmoid(a0[e]); a1[e] = fast_sigmoid(a1[e]); } }
                    u32x4 w; w.x = cvt_pk_bf16(a0[0], a0[1]); w.y = cvt_pk_bf16(a0[2], a0[3]); w.z = cvt_pk_bf16(a1[0], a1[1]); w.w = cvt_pk_bf16(a1[2], a1[3]);
                    *(u32x4*)(rowp + bj * HALF) = w; } }
    }
};
struct EpiUp {
    static constexpr bool PERM = true;
    bf16_t* q; bf16_t* kv;
    __device__ __forceinline__ void operator()(const f32x4 (&acc)[2][2][4][2], const Unit& u, int wr, int wc, int fr, int fq) const {
        const int row0 = u.pm * BM + wr * 64 + fr, col0 = u.pn * BM + wc * 32 + 8 * fq;
        bf16_t* O = (u.br == 0) ? q : kv; const int ldc = (u.br == 0) ? 1536 : 2048;
        float zf = 0.f; asm volatile("" : "+v"(zf));
#pragma unroll
        for (int ai = 0; ai < 2; ++ai)
#pragma unroll
            for (int m = 0; m < 4; ++m) { bf16_t* rowp = O + (size_t)(row0 + ai * HALF + m * 16) * ldc + col0;
#pragma unroll
                for (int bj = 0; bj < 2; ++bj) { const f32x4 v0 = acc[ai][bj][m][0] + zf, v1 = acc[ai][bj][m][1] + zf;
                    u32x4 w; w.x = cvt_pk_bf16(v0[0], v0[1]); w.y = cvt_pk_bf16(v0[2], v0[3]); w.z = cvt_pk_bf16(v1[0], v1[1]); w.w = cvt_pk_bf16(v1[2], v1[3]);
                    *(u32x4*)(rowp + bj * HALF) = w; } }
    }
};
struct KwOrder { int G, c0;
    __device__ __forceinline__ bool next(int i, Unit& u) const { const int c = i * G + c0; if (c >= 128) return false; const int b = c >> 5, h = (c >> 3) & 3; u.pm = 0; u.pn = c & 7; u.ka = 512 * h; u.kb = 512 * h; u.br = (b << 2) | h;
        u.aoff = (long)b * 256 * 4096 * 2; u.boff = 0; return true; }
    __device__ __forceinline__ void a_ready(const Unit&) const {} __device__ __forceinline__ void done(const Unit&) const {} };
struct VwOrder { int G, c0;
    __device__ __forceinline__ bool next(int i, Unit& u) const { const int c = i * G + c0; if (c >= 128) return false; const int b = c >> 5, h = (c >> 3) & 3; u.pm = c & 7; u.pn = 0; u.ka = 512 * h; u.kb = 2048 + 512 * h; u.br = (b << 2) | h;
        u.aoff = 0; u.boff = (long)b * 256 * 4096 * 2; return true; }
    __device__ __forceinline__ void a_ready(const Unit&) const {} __device__ __forceinline__ void done(const Unit&) const {} };
struct EpiXW {
    static constexpr bool PERM = true;
    bf16_t* O; int mode;
    __device__ __forceinline__ void operator()(const f32x4 (&acc)[2][2][4][2], const Unit& u, int wr, int wc, int fr, int fq) const {
        const int b = u.br >> 2, h = u.br & 3; const int cw = wc * 32 + 8 * fq, rw = wr * 64 + fr;
        bf16_t* base; int ldc;
        if (mode == 0) { ldc = 2048; base = O + ((size_t)b * 1024 + 256 * h + rw) * 2048 + u.pn * BM + cw; }
        else { ldc = 1024; base = O + ((size_t)b * 2048 + u.pm * BM + rw) * 1024 + 256 * h + cw; }
        float zf = 0.f; asm volatile("" : "+v"(zf));
#pragma unroll
        for (int ai = 0; ai < 2; ++ai)
#pragma unroll
            for (int m = 0; m < 4; ++m) { bf16_t* rowp = base + (size_t)(ai * HALF + m * 16) * ldc;
#pragma unroll
                for (int bj = 0; bj < 2; ++bj) { const f32x4 v0 = acc[ai][bj][m][0] + zf, v1 = acc[ai][bj][m][1] + zf;
                    u32x4 w; w.x = cvt_pk_bf16(v0[0], v0[1]); w.y = cvt_pk_bf16(v0[2], v0[3]); w.z = cvt_pk_bf16(v1[0], v1[1]); w.w = cvt_pk_bf16(v1[2], v1[3]);
                    *(u32x4*)(rowp + bj * HALF) = w; } }
    }
};
struct BatchOrder : StaticOrder { long bstride;
    __device__ __forceinline__ bool next(int i, Unit& u) const { if (!StaticOrder::next(i, u)) return false; u.boff = (long)(u.pm >> 4) * bstride; return true; } };
constexpr int LDP = 1024;
template <bool LRS> struct EpiSoftmaxP {
    static constexpr bool PERM = true;
    bf16_t* P; const float* RS; PG8_LAS float* xch; const PG8_LAS float* rsl;
    __device__ __forceinline__ void operator()(const f32x4 (&acc)[2][2][4][2], const Unit& u, int wr, int wc, int fr, int fq) const {
        constexpr float C = 0.04419417382415922f * 1.4426950408889634f;
        PG8_LAS float* xm = xch; PG8_LAS float* xs = xch + 1024;
        f32x4 v[2][4][2][2]; float mx[2][4];
#pragma unroll
        for (int ai = 0; ai < 2; ++ai)
#pragma unroll
            for (int m = 0; m < 4; ++m) { const float rs = (LRS ? rsl[ai * HALF + wr * 64 + m * 16 + fr] : row_rstd(RS, (size_t)(u.pm * BM + ai * HALF + wr * 64 + m * 16 + fr))) * C; float mm = -3.0e38f;
#pragma unroll
                for (int bj = 0; bj < 2; ++bj)
#pragma unroll
                    for (int n = 0; n < 2; ++n) { const f32x4 x = acc[ai][bj][m][n] * rs; v[ai][m][bj][n] = x; mm = fmaxf(mm, fmaxf(fmaxf(x[0], x[1]), fmaxf(x[2], x[3]))); }
                mm = max_xor32(max_xor16(mm)); mx[ai][m] = mm;
                if (fq == 0) xm[wc * 256 + ai * HALF + wr * 64 + m * 16 + fr] = mm; }
        asm volatile("s_waitcnt lgkmcnt(0)" ::: "memory"); __builtin_amdgcn_s_barrier(); asm volatile("" ::: "memory");
        float sm[2][4];
#pragma unroll
        for (int ai = 0; ai < 2; ++ai)
#pragma unroll
            for (int m = 0; m < 4; ++m) { const int r = ai * HALF + wr * 64 + m * 16 + fr; const float mm = fmaxf(fmaxf(xm[r], xm[256 + r]), fmaxf(xm[512 + r], xm[768 + r])); float s = 0.f;
#pragma unroll
                for (int bj = 0; bj < 2; ++bj)
#pragma unroll
                    for (int n = 0; n < 2; ++n) { f32x4 x = v[ai][m][bj][n];
#pragma unroll
                        for (int e = 0; e < 4; ++e) { x[e] = __builtin_amdgcn_exp2f(x[e] - mm); s += x[e]; }
                        v[ai][m][bj][n] = x; }
                s = sum_xor32(sum_xor16(s)); sm[ai][m] = s;
                if (fq == 0) xs[wc * 256 + r] = s; }
        asm volatile("s_waitcnt lgkmcnt(0)" ::: "memory"); __builtin_amdgcn_s_barrier(); asm volatile("" ::: "memory");
        const int row0 = u.pm * BM + wr * 64 + fr, col0 = u.pn * BM + wc * 32 + 8 * fq;
#pragma unroll
        for (int ai = 0; ai < 2; ++ai)
#pragma unroll
            for (int m = 0; m < 4; ++m) { const int r = ai * HALF + wr * 64 + m * 16 + fr; const float inv = __builtin_amdgcn_rcpf((xs[r] + xs[256 + r]) + (xs[512 + r] + xs[768 + r]));
                bf16_t* rowp = P + (size_t)(row0 + ai * HALF + m * 16) * LDP + col0;
#pragma unroll
                for (int bj = 0; bj < 2; ++bj) { const f32x4 v0 = v[ai][m][bj][0] * inv, v1 = v[ai][m][bj][1] * inv;
                    u32x4 w; w.x = cvt_pk_bf16(v0[0], v0[1]); w.y = cvt_pk_bf16(v0[2], v0[3]); w.z = cvt_pk_bf16(v1[0], v1[1]); w.w = cvt_pk_bf16(v1[2], v1[3]);
                    *(u32x4*)(rowp + bj * HALF) = w; } }
        asm volatile("s_waitcnt lgkmcnt(0)" ::: "memory"); __builtin_amdgcn_s_barrier(); asm volatile("" ::: "memory");
        (void)mx; (void)sm;
    }
};
struct EpiMerge {
    static constexpr bool PERM = true, CHAIN = true;
    bf16_t* O; const bf16_t* zg;
    __device__ __forceinline__ void operator()(f32x4 (&acc)[2][2][4][2], const Unit& u, int wr, int wc, int fr, int fq) const {
        const int row0 = u.pm * BM + wr * 64 + fr, col0 = u.pn * BM + wc * 32 + 8 * fq, gc0 = u.br * 2048 + col0;
        const bool more = (u.br < 2);
        u32x4 z[2][2][2], zn[2][2][2];
#define MG_LOAD(buf_, q_) do { _Pragma("unroll") for (int mm = 0; mm < 2; ++mm) { const size_t row = (size_t)(row0 + ((q_) >> 1) * HALF + (2 * ((q_) & 1) + mm) * 16); \
            _Pragma("unroll") for (int bj = 0; bj < 2; ++bj) { z[buf_][mm][bj] = *(const u32x4*)(zg + row * 6144 + gc0 + bj * HALF); \
                zn[buf_][mm][bj] = more ? *(const u32x4*)(zg + row * 6144 + gc0 + 2048 + bj * HALF) : (u32x4){0x3f803f80u, 0x3f803f80u, 0x3f803f80u, 0x3f803f80u}; } } } while (0)
#define MG_APPLY(buf_, q_) do { _Pragma("unroll") for (int mm = 0; mm < 2; ++mm) { const int ai = (q_) >> 1, m = 2 * ((q_) & 1) + mm; bf16_t* rowp = O + (size_t)(row0 + ai * HALF + m * 16) * 2048 + col0; \
            _Pragma("unroll") for (int bj = 0; bj < 2; ++bj) { const u32x4 a = z[buf_][mm][bj], b = zn[buf_][mm][bj]; float f[8]; \
                f[0] = bf_lo(a.x); f[1] = bf_hi(a.x); f[2] = bf_lo(a.y); f[3] = bf_hi(a.y); f[4] = bf_lo(a.z); f[5] = bf_hi(a.z); f[6] = bf_lo(a.w); f[7] = bf_hi(a.w); \
                const float d[8] = {bf_lo(b.x), bf_hi(b.x), bf_lo(b.y), bf_hi(b.y), bf_lo(b.z), bf_hi(b.z), bf_lo(b.w), bf_hi(b.w)}; \
                _Pragma("unroll") for (int e = 0; e < 8; ++e) { const float ge = (u.br == 0) ? f[e] : fmaxf(f[e], 1e-20f); f[e] = more ? ge * __builtin_amdgcn_rcpf(fmaxf(d[e], 1e-20f)) : ge; } \
                f32x4 a0 = acc[ai][bj][m][0], a1 = acc[ai][bj][m][1]; \
                a0[0] *= f[0]; a0[1] *= f[1]; a0[2] *= f[2]; a0[3] *= f[3]; a1[0] *= f[4]; a1[1] *= f[5]; a1[2] *= f[6]; a1[3] *= f[7]; \
                acc[ai][bj][m][0] = a0; acc[ai][bj][m][1] = a1; \
                if (!more) { u32x4 w; w.x = cvt_pk_bf16(a0[0], a0[1]); w.y = cvt_pk_bf16(a0[2], a0[3]); w.z = cvt_pk_bf16(a1[0], a1[1]); w.w = cvt_pk_bf16(a1[2], a1[3]); *(u32x4*)(rowp + bj * HALF) = w; } } } } while (0)
        MG_LOAD(0, 0);
        MG_LOAD(1, 1); asm volatile("" ::: "memory"); MG_APPLY(0, 0);
        MG_LOAD(0, 2); asm volatile("" ::: "memory"); MG_APPLY(1, 1);
        MG_LOAD(1, 3); asm volatile("" ::: "memory"); MG_APPLY(0, 2);
        asm volatile("" ::: "memory"); MG_APPLY(1, 3);
#undef MG_LOAD
#undef MG_APPLY
    }
};
struct EpiSwiGLU {
    static constexpr bool PERM = false;
    bf16_t* O; int ldc;
    __device__ __forceinline__ void operator()(const f32x4 (&acc)[2][2][4][2], const Unit& u, int wr, int wc, int fr, int fq) const {
        const int row0 = u.pm * BM + wr * 64 + fr;
#pragma unroll
        for (int ai = 0; ai < 2; ++ai)
#pragma unroll
            for (int m = 0; m < 4; ++m) { bf16_t* rowp = O + (size_t)(row0 + ai * HALF + m * 16) * ldc;
#pragma unroll
                for (int bj = 0; bj < 2; ++bj) { const int G = 8 * u.pn + 4 * bj + wc; const f32x4 g = acc[ai][bj][m][0], up = acc[ai][bj][m][1];
                    float o[4];
#pragma unroll
                    for (int e = 0; e < 4; ++e) o[e] = g[e] * fast_sigmoid(g[e]) * up[e];
                    u32x2 w; w.x = cvt_pk_bf16(o[0], o[1]); w.y = cvt_pk_bf16(o[2], o[3]);
                    *(u32x2*)(rowp + 16 * G + 4 * fq) = w; } }
    }
};


struct EpiBf16RS {
    static constexpr bool PERM = true;
    bf16_t* O; int ldc; const float* SS;
    __device__ __forceinline__ void operator()(const f32x4 (&acc)[2][2][4][2], const Unit& u, int wr, int wc, int fr, int fq) const {
        const int row0 = u.pm * BM + wr * 64 + fr, col0 = u.pn * BM + wc * 32 + 8 * fq;
#pragma unroll
        for (int ai = 0; ai < 2; ++ai)
#pragma unroll
            for (int m = 0; m < 4; ++m) { const size_t row = (size_t)(row0 + ai * HALF + m * 16); const float rs = row_rstd(SS, row); bf16_t* rowp = O + row * ldc + col0;
#pragma unroll
                for (int bj = 0; bj < 2; ++bj) { const f32x4 v0 = acc[ai][bj][m][0] * rs, v1 = acc[ai][bj][m][1] * rs;
                    u32x4 w; w.x = cvt_pk_bf16(v0[0], v0[1]); w.y = cvt_pk_bf16(v0[2], v0[3]); w.z = cvt_pk_bf16(v1[0], v1[1]); w.w = cvt_pk_bf16(v1[2], v1[3]);
                    *(u32x4*)(rowp + bj * HALF) = w; } }
    }
};
struct EpiResN {
    static constexpr bool PERM = false;
    const float* base; float* out; int ldc; bf16_t* xb; const float* gnext; float* SS;
    __device__ __forceinline__ void operator()(const f32x4 (&acc)[2][2][4][2], const Unit& u, int wr, int wc, int fr, int fq) const {
        const int row0 = u.pm * BM + wr * 64 + fr, col0 = u.pn * BM + wc * 32 + 4 * fq;
        f32x4 gv[2][2];
#pragma unroll
        for (int bj = 0; bj < 2; ++bj)
#pragma unroll
            for (int n = 0; n < 2; ++n) gv[bj][n] = *(const f32x4*)(gnext + col0 + bj * HALF + n * 16);
#pragma unroll
        for (int ai = 0; ai < 2; ++ai)
#pragma unroll
            for (int m = 0; m < 4; ++m) { const size_t row = (size_t)(row0 + ai * HALF + m * 16); const size_t off = row * ldc + col0; float ss = 0.f;
#pragma unroll
                for (int bj = 0; bj < 2; ++bj)
#pragma unroll
                    for (int n = 0; n < 2; ++n) { const f32x4 bs = *(const f32x4*)(base + off + bj * HALF + n * 16); const f32x4 x = bs + acc[ai][bj][m][n];
                        *(f32x4*)(out + off + bj * HALF + n * 16) = x; ss += (x[0] * x[0] + x[1] * x[1]) + (x[2] * x[2] + x[3] * x[3]);
                        const f32x4 xg = x * gv[bj][n]; u32x2 w; w.x = cvt_pk_bf16(xg[0], xg[1]); w.y = cvt_pk_bf16(xg[2], xg[3]);
                        *(u32x2*)(xb + off + bj * HALF + n * 16) = w; }
                ss = sum_xor32(sum_xor16(ss));
                if (fq == 0) SS[row * 32 + u.pn * 4 + wc] = ss;
                if (m & 1) asm volatile("" ::: "memory"); }
    }
};
constexpr float F8_SA_ = 2.0f;
__device__ __forceinline__ unsigned pk4_fp8_(float a, float b, float c, float d) { int w = __builtin_amdgcn_cvt_pk_fp8_f32(a, b, 0, false); w = __builtin_amdgcn_cvt_pk_fp8_f32(c, d, w, true); return (unsigned)w; }
struct EpiResB {
    static constexpr bool PERM = true;
    bf16_t* xb; float* SS; unsigned char* h8 = nullptr;
    __device__ __forceinline__ void operator()(const f32x4 (&acc)[2][2][4][2], const Unit& u, int wr, int wc, int fr, int fq) const {
        const int row0 = u.pm * BM + wr * 64 + fr, col0 = u.pn * BM + wc * 32 + 8 * fq;
#pragma unroll
        for (int ai = 0; ai < 2; ++ai) {
            u32x4 old[4][2];
#pragma unroll
            for (int m = 0; m < 4; ++m)
#pragma unroll
                for (int bj = 0; bj < 2; ++bj) old[m][bj] = *(const u32x4*)(xb + (size_t)(row0 + ai * HALF + m * 16) * 2048 + col0 + bj * HALF);
#pragma unroll
            for (int m = 0; m < 4; ++m) { const size_t row = (size_t)(row0 + ai * HALF + m * 16); bf16_t* rowp = xb + row * 2048 + col0; float ss = 0.f;
#pragma unroll
                for (int bj = 0; bj < 2; ++bj) { const u32x4 oo = old[m][bj]; const f32x4 a0 = acc[ai][bj][m][0], a1 = acc[ai][bj][m][1];
                    const float x0 = a0[0] + bf_lo(oo.x), x1 = a0[1] + bf_hi(oo.x), x2 = a0[2] + bf_lo(oo.y), x3 = a0[3] + bf_hi(oo.y), x4 = a1[0] + bf_lo(oo.z), x5 = a1[1] + bf_hi(oo.z), x6 = a1[2] + bf_lo(oo.w), x7 = a1[3] + bf_hi(oo.w);
                    ss += (x0 * x0 + x1 * x1) + (x2 * x2 + x3 * x3) + (x4 * x4 + x5 * x5) + (x6 * x6 + x7 * x7);
                    u32x4 w; w.x = cvt_pk_bf16(x0, x1); w.y = cvt_pk_bf16(x2, x3); w.z = cvt_pk_bf16(x4, x5); w.w = cvt_pk_bf16(x6, x7);
                    *(u32x4*)(rowp + bj * HALF) = w;
                    if (h8) { u32x2 q; q.x = pk4_fp8_(x0 * F8_SA_, x1 * F8_SA_, x2 * F8_SA_, x3 * F8_SA_); q.y = pk4_fp8_(x4 * F8_SA_, x5 * F8_SA_, x6 * F8_SA_, x7 * F8_SA_);
                        *(u32x2*)(h8 + row * 2048 + col0 + bj * HALF) = q; } }
                ss = sum_xor32(sum_xor16(ss));
                if (fq == 0) SS[row * 32 + u.pn * 4 + wc] = ss; }
            asm volatile("" ::: "memory"); }
    }
};
struct EpiResF {
    static constexpr bool PERM = false;
    const bf16_t* xb; float* out;
    __device__ __forceinline__ void operator()(const f32x4 (&acc)[2][2][4][2], const Unit& u, int wr, int wc, int fr, int fq) const {
        const int row0 = u.pm * BM + wr * 64 + fr, col0 = u.pn * BM + wc * 32 + 4 * fq;
#pragma unroll
        for (int ai = 0; ai < 2; ++ai) {
            u32x2 old[16];
#pragma unroll
            for (int e = 0; e < 16; ++e) old[e] = *(const u32x2*)(xb + (size_t)(row0 + ai * HALF + (e >> 2) * 16) * 2048 + col0 + ((e >> 1) & 1) * HALF + (e & 1) * 16);
            asm volatile("" : "+v"(old[0]), "+v"(old[1]), "+v"(old[2]), "+v"(old[3]), "+v"(old[4]), "+v"(old[5]), "+v"(old[6]), "+v"(old[7]), "+v"(old[8]), "+v"(old[9]), "+v"(old[10]), "+v"(old[11]), "+v"(old[12]), "+v"(old[13]), "+v"(old[14]), "+v"(old[15]) :: "memory");
#pragma unroll
            for (int m = 0; m < 4; ++m) { const size_t off = (size_t)(row0 + ai * HALF + m * 16) * 2048 + col0;
#pragma unroll
                for (int bj = 0; bj < 2; ++bj)
#pragma unroll
                    for (int n = 0; n < 2; ++n) { const u32x2 oo = old[m * 4 + bj * 2 + n]; const f32x4 a = acc[ai][bj][m][n];
                        *(f32x4*)(out + off + bj * HALF + n * 16) = (f32x4){a[0] + bf_lo(oo.x), a[1] + bf_hi(oo.x), a[2] + bf_lo(oo.y), a[3] + bf_hi(oo.y)}; }
                if (m & 1) asm volatile("" ::: "memory"); } }
    }
};
template <bool LRS> struct EpiSwiGLURS {
    static constexpr bool PERM = false;
    bf16_t* O; int ldc; const float* SS; const PG8_LAS float* rsl;
    __device__ __forceinline__ void operator()(const f32x4 (&acc)[2][2][4][2], const Unit& u, int wr, int wc, int fr, int fq) const {
        const int row0 = u.pm * BM + wr * 64 + fr;
#pragma unroll
        for (int ai = 0; ai < 2; ++ai)
#pragma unroll
            for (int mp = 0; mp < 4; mp += 2) {
                float rs2[2];
#pragma unroll
                for (int q = 0; q < 2; ++q) rs2[q] = LRS ? rsl[wr * 64 + fr + ai * HALF + (mp + q) * 16] : row_rstd(SS, (size_t)(row0 + ai * HALF + (mp + q) * 16));
                bf16_t* rowp = O + (size_t)(row0 + ai * HALF + (mp + (fq & 1)) * 16) * ldc + 8 * (fq >> 1);
#pragma unroll
                for (int bj = 0; bj < 2; ++bj) { const int Gq = 8 * u.pn + 4 * bj + wc; unsigned px[2], py[2];
#pragma unroll
                    for (int q = 0; q < 2; ++q) { const f32x4 g = acc[ai][bj][mp + q][0] * rs2[q], up = acc[ai][bj][mp + q][1] * rs2[q];
                        float o[4];
#pragma unroll
                        for (int e = 0; e < 4; ++e) o[e] = g[e] * fast_sigmoid(g[e]) * up[e];
                        px[q] = cvt_pk_bf16(o[0], o[1]); py[q] = cvt_pk_bf16(o[2], o[3]); }
                    const auto r0 = __builtin_amdgcn_permlane16_swap(px[0], px[1], false, false), r1 = __builtin_amdgcn_permlane16_swap(py[0], py[1], false, false);
                    u32x4 w; w.x = r0[0]; w.y = r1[0]; w.z = r0[1]; w.w = r1[1];
                    *(u32x4*)(rowp + 16 * Gq) = w; } }
    }
};
template <class E, class = void> struct epi_chain { static constexpr bool value = false; };
template <class E> struct epi_chain<E, decltype((void)E::CHAIN)> { static constexpr bool value = E::CHAIN; };
template <class Epi, class Sched, bool ALIGN_EPI, bool F8 = false>
__device__ __forceinline__ void gemm_phase(PG8_LAS unsigned char* lds, const Gemm g, const Sched& S, const Epi& E, int tid) {
    asm volatile("" : "+v"(tid));
    const int wid = __builtin_amdgcn_readfirstlane(tid >> 6), lane = tid & 63, wr = wid >> 2, wc = wid & 3, fr = lane & 15, fq = lane >> 4;
    const int nt = g.K / BK;
    unsigned voffA[2], voffB[2];
#pragma unroll
    for (int i = 0; i < 2; ++i) { int R, C; stage_rc(tid * 16 + i * 8192, R, C); const int Rb = Epi::PERM ? ((R & ~31) + perm32(R & 31)) : R;
        voffA[i] = (unsigned)(R * g.lda + C) * 2u; voffB[i] = (unsigned)(Rb * g.ldb + C) * 2u; }
    const size_t kstep = (size_t)(BK * 2);
    const size_t hstepA = (size_t)HALF * g.lda * 2, hstepB = (size_t)HALF * g.ldb * 2;
    const unsigned ldsw = (unsigned)wid * 1024u;
    const int aoff = lds_byte(wr * 64 + fr, fq * 8), boff = lds_byte(wc * 32 + fr, fq * 8);
#define PG8_SA(b, h) (((b) * 2 + (h)) * HTB)
#define PG8_SB(b, h) ((4 + (b) * 2 + (h)) * HTB)
#define PG8_STAGE(bufoff, gbase, voff) do { _Pragma("unroll") for (int _i = 0; _i < 2; ++_i) \
        __builtin_amdgcn_global_load_lds((const unsigned*)((const char*)(gbase) + (voff)[_i]), (PG8_LAS unsigned*)(lds + (bufoff) + ldsw + _i * 8192), 16, 0, 0); } while (0)
#define PG8_CAT8(lo_, hi_) __builtin_shufflevector(lo_, hi_, 0, 1, 2, 3, 4, 5, 6, 7)
#define PG8_LDA(dst, b, h) do { if constexpr (F8) { _Pragma("unroll") for (int m = 0; m < 4; ++m) dst##8[m] = PG8_CAT8(*(const PG8_LAS i32x4*)(lds + PG8_SA(b, h) + aoff + m * 2048), *(const PG8_LAS i32x4*)(lds + PG8_SA(b, h) + aoff + m * 2048 + 1024)); } \
        else { _Pragma("unroll") for (int m = 0; m < 4; ++m) _Pragma("unroll") for (int k = 0; k < 2; ++k) dst[m][k] = *(const PG8_LAS bf16x8*)(lds + PG8_SA(b, h) + aoff + m * 2048 + k * 1024); } } while (0)
#define PG8_LDB(dst, b, h) do { if constexpr (F8) { _Pragma("unroll") for (int n = 0; n < 2; ++n) dst##8[n] = PG8_CAT8(*(const PG8_LAS i32x4*)(lds + PG8_SB(b, h) + boff + n * 2048), *(const PG8_LAS i32x4*)(lds + PG8_SB(b, h) + boff + n * 2048 + 1024)); } \
        else { _Pragma("unroll") for (int n = 0; n < 2; ++n) _Pragma("unroll") for (int k = 0; k < 2; ++k) dst[n][k] = *(const PG8_LAS bf16x8*)(lds + PG8_SB(b, h) + boff + n * 2048 + k * 1024); } } while (0)
#define PG8_MMA(ai, bj, At, Bt) do { __builtin_amdgcn_s_setprio(1); _Pragma("unroll") for (int m = 0; m < 4; ++m) _Pragma("unroll") for (int n = 0; n < 2; ++n) { \
        if constexpr (F8) asm volatile("v_mfma_f32_16x16x128_f8f6f4 %0, %1, %2, %0" : "+v"(acc[ai][bj][m][n]) : "v"(Bt##8[n]), "v"(At##8[m]));   \
        else { _Pragma("unroll") for (int k = 0; k < 2; ++k) acc[ai][bj][m][n] = __builtin_amdgcn_mfma_f32_16x16x32_bf16(Bt[n][k], At[m][k], acc[ai][bj][m][n], 0, 0, 0); } } \
        __builtin_amdgcn_s_setprio(0); } while (0)
#define PG8_WAIT_V(n) asm volatile("s_waitcnt vmcnt(" #n ")" ::: "memory")
#define PG8_WAIT_L(n) asm volatile("s_waitcnt lgkmcnt(" #n ")" ::: "memory")
#define PG8_BAR __builtin_amdgcn_s_barrier()
#define PG8_SCHED __builtin_amdgcn_sched_barrier(0)
    Unit cur, nxt; int ui = 0;
    if (!S.next(0, cur)) return;
    f32x4 acc[2][2][4][2];
#pragma unroll
    for (int a = 0; a < 2; ++a)
#pragma unroll
        for (int b = 0; b < 2; ++b)
#pragma unroll
            for (int m = 0; m < 4; ++m)
#pragma unroll
                for (int n = 0; n < 2; ++n) acc[a][b][m][n] = (f32x4){0.f, 0.f, 0.f, 0.f};
    bf16x8 At[4][2], B0[2][2], B1[2][2]; i32x8 At8[4], B08[2], B18[2];
    const char* cA = (const char*)g.A + cur.aoff + (size_t)cur.pm * 2 * hstepA + (size_t)cur.ka * 2; const char* cB = (const char*)g.Bt + cur.boff + (size_t)cur.pn * 2 * hstepB + (size_t)cur.kb * 2;
    S.a_ready(cur);
    PG8_STAGE(PG8_SB(0, 0), cB, voffB); PG8_STAGE(PG8_SB(0, 1), cB + hstepB, voffB); PG8_STAGE(PG8_SA(0, 0), cA, voffA); PG8_STAGE(PG8_SA(0, 1), cA + hstepA, voffA);
    if (wr == 1) PG8_BAR;
    PG8_WAIT_V(2); PG8_BAR;
    PG8_STAGE(PG8_SB(1, 0), cB + kstep, voffB); PG8_STAGE(PG8_SA(1, 0), cA + kstep, voffA); PG8_STAGE(PG8_SB(1, 1), cB + hstepB + kstep, voffB);
    PG8_WAIT_V(6); PG8_BAR;
    for (;;) {
        const bool has_next = S.next(ui + 1, nxt);
        const char* nA = has_next ? (const char*)g.A + nxt.aoff + (size_t)nxt.pm * 2 * hstepA + (size_t)nxt.ka * 2 : cA; const char* nB = has_next ? (const char*)g.Bt + nxt.boff + (size_t)nxt.pn * 2 * hstepB + (size_t)nxt.kb * 2 : cB;
        for (int t = 0; t < nt; t += 2) {
            const bool last = (t == nt - 2);
            const char* a1 = cA + (size_t)(t + 1) * kstep;
            const char* a2 = last ? nA : cA + (size_t)(t + 2) * kstep; const char* b2 = last ? nB : cB + (size_t)(t + 2) * kstep;
            const char* a3 = a2 + kstep; const char* b3 = b2 + kstep;
            if (last && has_next) S.a_ready(nxt);
            PG8_LDB(B0, 0, 0); PG8_LDB(B1, 0, 1); PG8_SCHED; PG8_LDA(At, 0, 0); PG8_STAGE(PG8_SA(1, 1), a1 + hstepA, voffA);
            PG8_WAIT_V(8); PG8_WAIT_L(0); PG8_BAR; PG8_MMA(0, 0, At, B0); PG8_MMA(0, 1, At, B1); PG8_BAR; PG8_SCHED;
            PG8_LDA(At, 0, 1); PG8_STAGE(PG8_SB(0, 0), b2, voffB); PG8_STAGE(PG8_SB(0, 1), b2 + hstepB, voffB); PG8_STAGE(PG8_SA(0, 0), a2, voffA);
            PG8_WAIT_V(8); PG8_WAIT_L(0); PG8_BAR; PG8_MMA(1, 0, At, B0); PG8_MMA(1, 1, At, B1); PG8_BAR; PG8_SCHED;
            PG8_LDB(B0, 1, 0); PG8_LDB(B1, 1, 1); PG8_SCHED; PG8_LDA(At, 1, 0); PG8_STAGE(PG8_SA(0, 1), a2 + hstepA, voffA);
            PG8_WAIT_V(8); PG8_WAIT_L(0); PG8_BAR; PG8_MMA(0, 0, At, B0); PG8_MMA(0, 1, At, B1); PG8_BAR; PG8_SCHED;
            PG8_LDA(At, 1, 1); PG8_STAGE(PG8_SB(1, 0), b3, voffB); PG8_STAGE(PG8_SB(1, 1), b3 + hstepB, voffB); PG8_STAGE(PG8_SA(1, 0), a3, voffA);
            PG8_WAIT_V(8); PG8_WAIT_L(0); PG8_BAR; PG8_MMA(1, 0, At, B0); PG8_MMA(1, 1, At, B1); PG8_BAR; PG8_SCHED;
        }
        if constexpr (ALIGN_EPI) { if (wr == 0) PG8_BAR; }
        if constexpr (F8) asm volatile("s_nop 15\n\ts_nop 15" ::: "memory");
        E(acc, cur, wr, wc, fr, fq); S.done(cur);
        if (!has_next) break;
        if (!(epi_chain<Epi>::value && nxt.br != 0))
#pragma unroll
        for (int a = 0; a < 2; ++a)
#pragma unroll
            for (int b = 0; b < 2; ++b)
#pragma unroll
                for (int m = 0; m < 4; ++m)
#pragma unroll
                    for (int n = 0; n < 2; ++n) acc[a][b][m][n] = (f32x4){0.f, 0.f, 0.f, 0.f};
        cur = nxt; cA = nA; cB = nB; ++ui;
        if constexpr (ALIGN_EPI) { if (wr == 1) PG8_BAR; }
    }
    PG8_WAIT_V(0);
    if constexpr (!ALIGN_EPI) { if (wr == 0) PG8_BAR; }
    PG8_BAR;
#undef PG8_SA
#undef PG8_SB
#undef PG8_STAGE
#undef PG8_LDA
#undef PG8_LDB
#undef PG8_MMA
#undef PG8_WAIT_V
#undef PG8_WAIT_L
#undef PG8_BAR
#undef PG8_SCHED
}
}

constexpr int NWAVES = 8;
constexpr int NB = 4, SEQ = 4096, M = NB * SEQ, D = 2048, MEML = 256, MROWS = NB * MEML;
constexpr int NA = 3072, NABC = 4352  , NG = 6144, NIN = NA + NABC + NG, DFF = 5632, NFF2 = 2 * DFF, DIN_SRC = 13392, LDW = D + 64  , LDACT = DFF + 64  ;
constexpr int ZA_Q = 0, ZA_K = 1024, ZA_V = 2048;
constexpr int ZC_BQ = 0, ZC_BK = 512, ZC_BV = 1024, ZC_BR = 2048, ZC_CQA = 3072, ZC_CKVA = 3584, ZC_CKR = 4096, ZC_BLR = 4160;
constexpr float EPS = 1e-6f;
constexpr int PH_PER_LAYER = 15, N_PHASES = 2 * PH_PER_LAYER + 1;

constexpr size_t MiB = 1u << 20;
constexpr size_t WS_CTL = 0, CTL_ZERO_BYTES = 32768;
constexpr size_t WS_ROPE = 1 * MiB;
constexpr size_t WS_WIN = 2 * MiB, WS_WQB = 55 * MiB, WS_WKVB = 57 * MiB, WS_WUP = 59 * MiB, WS_WO = 71 * MiB, WS_WXQ = 79 * MiB, WS_WXKV = 87 * MiB, WS_WXO = 103 * MiB, WS_WFF = 111 * MiB, WS_WDN = 158 * MiB;
constexpr size_t WS_H = 182 * MiB;
constexpr size_t WS_ZA = 246 * MiB, WS_MLAKV = 246 * MiB, WS_ZABC = 342 * MiB  , WS_GLAST = 182 * MiB  , WS_GLADEC = 826 * MiB, WS_AML = 826 * MiB + 512 * 1024  ;
constexpr size_t WS_MERGED = 246 * MiB, WS_XQ = 246 * MiB, WS_OX = 310 * MiB;
constexpr size_t WS_P = 342 * MiB  , WS_KW = 310 * MiB  , WS_VW = 326 * MiB  ;
constexpr size_t WS_ZG = 478 * MiB;
constexpr size_t WS_ACT = 478 * MiB;
constexpr size_t WS_OABC = 670 * MiB;
constexpr size_t WS_MLAQ = 766 * MiB;
constexpr size_t WS_MEMKV = 814 * MiB;
constexpr size_t WS_MEMN = 822 * MiB;
constexpr size_t WS_SS = 828 * MiB;
constexpr size_t WS_RS = 830 * MiB;
constexpr size_t WS_END = 831 * MiB;
static_assert(WS_WFF + (size_t)NFF2 * LDW * 2 <= WS_WDN && WS_WIN + (size_t)NIN * D * 2 <= WS_WQB && WS_WDN + (size_t)D * LDACT * 2 <= WS_H && WS_ZA + (size_t)M * NA * 2 <= WS_ZABC && WS_ZABC + (size_t)M * NABC * 2 <= WS_ZG && WS_ZG + (size_t)M * NG * 2 <= WS_OABC && WS_ACT + (size_t)M * LDACT * 2 <= WS_OABC, "ws map");
constexpr size_t WS_W8 = WS_WIN + (size_t)7424 * D * 2, WS_H8 = WS_MLAQ;
static_assert(pg8::F8_SA_ == 2.0f, "fp8 stream scale");
constexpr float F8_SA = 2.0f, F8_SW = 256.0f, F8_GSC = 1.0f / (F8_SA * F8_SW);
constexpr int CW_BAR = 4096, CW_XID = 128  , CW_GRP = 512  ;

constexpr int RING_OFF = 0, RING_BYTES = 131072;
constexpr int LDSCTL_OFF = RING_BYTES, MISC_OFF = LDSCTL_OFF + 320;
constexpr int PTAB_OFF = MISC_OFF + 128;
constexpr int LDS_BYTES = 147456;

#define GAS __attribute__((address_space(1)))
#define LAS __attribute__((address_space(3)))
typedef unsigned short bf16;
typedef unsigned v4u __attribute__((ext_vector_type(4)));
typedef unsigned v2u __attribute__((ext_vector_type(2)));
typedef float f32x4 __attribute__((ext_vector_type(4)));
typedef GAS unsigned gu32;
#define LDS_WAIT() asm volatile("s_waitcnt lgkmcnt(0)" ::: "memory")
__device__ __forceinline__ unsigned f2bf(float f) { unsigned u = __builtin_bit_cast(unsigned, f); return (u + 0x7fffu + ((u >> 16) & 1u)) >> 16; }
__device__ __forceinline__ unsigned pk2(float lo, float hi) { return f2bf(lo) | (f2bf(hi) << 16); }
__device__ __forceinline__ float bf2f(bf16 b) { return __uint_as_float(((unsigned)b) << 16); }
__device__ __forceinline__ float bflo(unsigned w) { return __uint_as_float(w << 16); }
__device__ __forceinline__ float bfhi(unsigned w) { return __uint_as_float(w & 0xffff0000u); }

__device__ __forceinline__ int lane_id_now() { int l; asm volatile("v_mbcnt_lo_u32_b32 %0, -1, 0\n\tv_mbcnt_hi_u32_b32 %0, -1, %0" : "=&v"(l)); return l; }
#define XB_TMO      128
#define XB_XCNT(j)  (256  + 64 * (j))
#define XB_XSUB(j)  (1280 + 64 * (j))
#define XB_XGEN(j)  (2304 + 64 * (j))
#define XB_TOP      3328
#define XB_TOPGEN   3392
#define XCD_BAR_WORDS 3456
#define XB_SPIN_CAP (1u << 22)
__device__ __forceinline__ unsigned xb_ld(unsigned* p)              { return __hip_atomic_load(p, __ATOMIC_RELAXED, __HIP_MEMORY_SCOPE_AGENT); }
__device__ __forceinline__ unsigned xb_add(unsigned* p, unsigned v) { return __hip_atomic_fetch_add(p, v, __ATOMIC_RELAXED, __HIP_MEMORY_SCOPE_AGENT); }
__device__ __forceinline__ unsigned xb_xcc_id() { return (unsigned)__builtin_amdgcn_s_getreg((3 << 11) | 20) & 0xFu; }
#define XB_SPIN(cond, bar) do { unsigned _sp = 0; while (cond) { __builtin_amdgcn_s_sleep(1); \
    if ((++_sp & 255u) == 0u) { if (xb_ld(&(bar)[XB_TMO])) break; if (_sp > XB_SPIN_CAP) { atomicAdd(&(bar)[XB_TMO], 1u); break; } } } } while (0)
struct XcdBarrier { unsigned* bar; unsigned x; volatile LAS unsigned* st; };
__device__ __forceinline__ XcdBarrier xcd_barrier_post(unsigned* bar, volatile LAS unsigned* st) {
    XcdBarrier b; b.bar = bar; b.x = xb_xcc_id(); b.st = st;
    if (threadIdx.x == 0) (void)xb_add(&bar[XB_XCNT(b.x)], 1u);
    return b;
}
__device__ __forceinline__ void xcd_barrier_complete(unsigned* bar, unsigned x, unsigned& nloc, unsigned& nx) {
    const unsigned G = gridDim.x * gridDim.y * gridDim.z;
    unsigned sum, cnt, mine, sp = 0u;
    for (;;) {
        sum = 0u; cnt = 0u; mine = 0u;
#pragma unroll
        for (unsigned j = 0; j < 16; ++j) { const unsigned c = xb_ld(&bar[XB_XCNT(j)]); sum += c; cnt += (c > 0u) ? 1u : 0u; mine = (j == x) ? c : mine; }
        if (sum == G) break;
        __builtin_amdgcn_s_sleep(1);
        if ((++sp & 255u) == 0u) { if (xb_ld(&bar[XB_TMO])) break; if (sp > XB_SPIN_CAP) { atomicAdd(&bar[XB_TMO], 1u); break; } }
    }
    nloc = mine > 0u ? mine : 1u; nx = cnt > 0u ? cnt : 1u;
}
__device__ __forceinline__ void xcd_barrier(const XcdBarrier& b, const bool thread0) {
    asm volatile("s_waitcnt vmcnt(0)" ::: "memory");
    __syncthreads();
    if (thread0) {
        unsigned* bar = b.bar; asm volatile("" : "+s"(bar));
        __builtin_amdgcn_s_waitcnt(0);
        unsigned nloc = b.st[0], nx = b.st[1];
        if (nloc == 0u) { xcd_barrier_complete(bar, b.x, nloc, nx); b.st[0] = nloc; b.st[1] = nx; }
        const unsigned old = xb_add(&bar[XB_XSUB(b.x)], 1u);
        const unsigned gen = old / nloc;
        if (old + 1u == (gen + 1u) * nloc) {
            __builtin_amdgcn_fence(__ATOMIC_RELEASE, "agent");
            asm volatile("s_waitcnt vmcnt(0)" ::: "memory");
            const unsigned og = xb_add(&bar[XB_TOP], 1u);
            const unsigned tg = og / nx;
            if (og + 1u == (tg + 1u) * nx) xb_add(&bar[XB_TOPGEN], 1u);
            else XB_SPIN(xb_ld(&bar[XB_TOPGEN]) == tg, bar);
            __builtin_amdgcn_fence(__ATOMIC_ACQUIRE, "agent");
            xb_add(&bar[XB_XGEN(b.x)], 1u);
            asm volatile("s_waitcnt vmcnt(0)" ::: "memory");
        } else {
            XB_SPIN(xb_ld(&bar[XB_XGEN(b.x)]) == gen, bar);
            __builtin_amdgcn_fence(__ATOMIC_ACQUIRE, "agent");
            asm volatile("s_waitcnt vmcnt(0)" ::: "memory");
        }
    }
    __syncthreads();
}

__device__ __forceinline__ float dot8(v4u k, const LAS float* q) {
    const f32x4 q0 = *(const LAS f32x4*)q, q1 = *(const LAS f32x4*)(q + 4);
    float s = bflo(k.x) * q0.x; s += bfhi(k.x) * q0.y; s += bflo(k.y) * q0.z; s += bfhi(k.y) * q0.w;
    s += bflo(k.z) * q1.x; s += bfhi(k.z) * q1.y; s += bflo(k.w) * q1.z; s += bfhi(k.w) * q1.w; return s;
}

enum { MAP_LIN = 0, MAP_GATE = 1, MAP_UP = 2 };
__device__ __forceinline__ unsigned pk4_fp8(float a, float b, float c, float d) { int w = __builtin_amdgcn_cvt_pk_fp8_f32(a, b, 0, false); w = __builtin_amdgcn_cvt_pk_fp8_f32(c, d, w, true); return (unsigned)w; }
__device__ __forceinline__ void transpose_item8(const float* W, int ldw, int k0, int n0, int ncnt, unsigned char* W8, int nbase, LAS float* scr, int lane, const float* gk) {
    { const int kr = lane >> 3, c4 = (lane & 7) * 4;
      const float* wp = W + (size_t)(k0 + kr) * ldw + n0 + c4;
      f32x4 v[8]; float gj[8];
#pragma unroll
      for (int j = 0; j < 8; ++j) gj[j] = gk[k0 + 8 * j + kr] * F8_SW;
#pragma unroll
      for (int j = 0; j < 8; ++j) v[j] = (c4 < ncnt) ? *(const f32x4*)(wp + (size_t)(8 * j) * ldw) : (f32x4){0.f, 0.f, 0.f, 0.f};
      asm volatile("" : "+v"(v[0]), "+v"(v[1]), "+v"(v[2]), "+v"(v[3]), "+v"(v[4]), "+v"(v[5]), "+v"(v[6]), "+v"(v[7]) :: "memory");
#pragma unroll
      for (int j = 0; j < 8; ++j) { v[j] = v[j] * gj[j]; LAS float* d = scr + (8 * j + kr) * 33 + c4; d[0] = v[j].x; d[1] = v[j].y; d[2] = v[j].z; d[3] = v[j].w; } }
    LDS_WAIT(); asm volatile("" ::: "memory");
    const int c = lane & 7;
#pragma unroll
    for (int j = 0; j < 4; ++j) { const int n = (lane >> 3) + 8 * j; const LAS float* sp = scr + (8 * c) * 33 + n;
        v2u o; o.x = pk4_fp8(sp[0 * 33], sp[1 * 33], sp[2 * 33], sp[3 * 33]); o.y = pk4_fp8(sp[4 * 33], sp[5 * 33], sp[6 * 33], sp[7 * 33]);
        if (n < ncnt) *(v2u*)(W8 + (size_t)(n0 + n - nbase) * 2048 + k0 + 8 * c) = o; }
    LDS_WAIT(); asm volatile("" ::: "memory");
}
__device__ __forceinline__ bool seg_item8(int& r, const float* W, int K, int ldw, int ns, int ncols, unsigned char* W8, LAS float* scr, int lane, const float* gk) {
    const int nblk = (ncols + 31) / 32, cnt = (K / 64) * nblk;
    if (r >= cnt) { r -= cnt; return false; }
    const int kb = r / nblk, nb = r - kb * nblk, n0 = ns + 32 * nb, nc = (ncols - 32 * nb) < 32 ? (ncols - 32 * nb) : 32;
    transpose_item8(W, ldw, 64 * kb, n0, nc, W8, ns, scr, lane, gk);
    return true;
}
template <int MAPK>
__device__ __forceinline__ void transpose_item(const float* W, int ldw, int k0, int n0, int ncnt, bf16* WT, int ldd, int dcol0, int moff, LAS float* scr, int lane, const float* gk) {
    { const int kr = lane >> 3, c4 = (lane & 7) * 4;
      const float* wp = W + (size_t)(k0 + kr) * ldw + n0 + c4;
      f32x4 v[8]; float gj[8];
#pragma unroll
      for (int j = 0; j < 8; ++j) gj[j] = 1.0f;
      if (gk) {
#pragma unroll
          for (int j = 0; j < 8; ++j) gj[j] = gk[k0 + 8 * j + kr]; }
#pragma unroll
      for (int j = 0; j < 8; ++j) v[j] = (c4 < ncnt) ? *(const f32x4*)(wp + (size_t)(8 * j) * ldw) : (f32x4){0.f, 0.f, 0.f, 0.f};
      asm volatile("" : "+v"(v[0]), "+v"(v[1]), "+v"(v[2]), "+v"(v[3]), "+v"(v[4]), "+v"(v[5]), "+v"(v[6]), "+v"(v[7]) :: "memory");
#pragma unroll
      for (int j = 0; j < 8; ++j) v[j] = v[j] * gj[j];
#pragma unroll
      for (int j = 0; j < 8; ++j) { LAS float* d = scr + (8 * j + kr) * 33 + c4; d[0] = v[j].x; d[1] = v[j].y; d[2] = v[j].z; d[3] = v[j].w; } }
    LDS_WAIT(); asm volatile("" ::: "memory");
    const int c = lane & 7;
#pragma unroll
    for (int j = 0; j < 4; ++j) { const int n = (lane >> 3) + 8 * j; const LAS float* s = scr + (8 * c) * 33 + n;
        v4u o; o.x = pk2(s[0 * 33], s[1 * 33]); o.y = pk2(s[2 * 33], s[3 * 33]); o.z = pk2(s[4 * 33], s[5 * 33]); o.w = pk2(s[6 * 33], s[7 * 33]);
        const int sn = n0 + n - moff;
        int drow;
        if (MAPK == MAP_LIN) drow = sn; else if (MAPK == MAP_GATE) drow = 32 * (sn >> 4) + (sn & 15); else drow = 32 * (sn >> 4) + 16 + (sn & 15);
        if (n < ncnt) *(v4u*)(WT + (size_t)drow * ldd + dcol0 + k0 + 8 * c) = o; }
    LDS_WAIT(); asm volatile("" ::: "memory");
}
template <int MAPK>
__device__ __forceinline__ bool seg_item(int& r, const float* W, int K, int ldw, int ns, int ncols, bf16* WT, int ldd, int drow0, int dcol0, LAS float* scr, int lane, const float* gk = nullptr) {
    const int nblk = (ncols + 31) / 32, cnt = (K / 64) * nblk;
    if (r >= cnt) { r -= cnt; return false; }
    const int kb = r / nblk, nb = r - kb * nblk, n0 = ns + 32 * nb, nc = (ncols - 32 * nb) < 32 ? (ncols - 32 * nb) : 32;
    transpose_item<MAPK>(W, ldw, 64 * kb, n0, nc, WT, ldd, dcol0, (MAPK == MAP_LIN) ? (ns - drow0) : ns, scr, lane, gk);
    return true;
}

__device__ __forceinline__ void rms_row_bf16(const float* xrow, const float* g, bf16* orow, int lane) {
    const f32x4* xr = (const f32x4*)xrow + lane; const f32x4* gr = (const f32x4*)g + lane;
    f32x4 v[8]; float s = 0.f;
#pragma unroll
    for (int j = 0; j < 8; ++j) { v[j] = xr[64 * j]; s += (v[j].x * v[j].x + v[j].y * v[j].y) + (v[j].z * v[j].z + v[j].w * v[j].w); }
    const float rstd = 1.0f / sqrtf(wave_sum(s) * (1.f / 2048.f) + EPS);
    v2u* o8 = (v2u*)orow + lane;
#pragma unroll
    for (int j = 0; j < 8; ++j) { const f32x4 gg = gr[64 * j]; v2u w; w.x = pk2(v[j].x * rstd * gg.x, v[j].y * rstd * gg.y); w.y = pk2(v[j].z * rstd * gg.z, v[j].w * rstd * gg.w); o8[64 * j] = w; }
}

__device__ __forceinline__ void gain_row_bf16(const float* xrow, const float* g, bf16* orow, float* ssrow, unsigned char* h8row, int lane) {
    const f32x4* xr = (const f32x4*)xrow + lane; const f32x4* gr = (const f32x4*)g + lane;
    f32x4 v[8]; float s = 0.f;
#pragma unroll
    for (int j = 0; j < 8; ++j) { v[j] = xr[64 * j]; s += (v[j].x * v[j].x + v[j].y * v[j].y) + (v[j].z * v[j].z + v[j].w * v[j].w); }
    s = wave_sum(s);
    v2u* o8 = (v2u*)orow + lane;
#pragma unroll
    for (int j = 0; j < 8; ++j) { (void)gr; v2u w; w.x = pk2(v[j].x, v[j].y); w.y = pk2(v[j].z, v[j].w); o8[64 * j] = w;
        ((unsigned*)h8row)[lane + 64 * j] = pk4_fp8(v[j].x * F8_SA, v[j].y * F8_SA, v[j].z * F8_SA, v[j].w * F8_SA); }
    if (lane < 32) ssrow[lane] = (lane == 0) ? s : 0.f;
}
__device__ __forceinline__ void final_row(const bf16* hrow, const float* ss, const f32x4 (&gv)[8], float* orow, int lane) {
    v4u h[4];
#pragma unroll
    for (int j = 0; j < 4; ++j) h[j] = *(const v4u*)(hrow + 8 * (lane + 64 * j));
    const float s = wave_sum((lane < 32) ? ss[lane & 31] : 0.f);
    const float rstd = 1.0f / sqrtf(s * (1.f / 2048.f) + EPS);
#pragma unroll
    for (int j = 0; j < 4; ++j) { float* op = orow + 8 * (lane + 64 * j);
        *(f32x4*)op = (f32x4){bflo(h[j].x) * rstd * gv[2 * j].x, bfhi(h[j].x) * rstd * gv[2 * j].y, bflo(h[j].y) * rstd * gv[2 * j].z, bfhi(h[j].y) * rstd * gv[2 * j].w};
        *(f32x4*)(op + 4) = (f32x4){bflo(h[j].z) * rstd * gv[2 * j + 1].x, bfhi(h[j].z) * rstd * gv[2 * j + 1].y, bflo(h[j].w) * rstd * gv[2 * j + 1].z, bfhi(h[j].w) * rstd * gv[2 * j + 1].w}; }
}
__device__ __forceinline__ void rms_row_f32_inplace(float* xrow, const float* g, int lane) {
    f32x4* xr = (f32x4*)xrow + lane; const f32x4* gr = (const f32x4*)g + lane;
    f32x4 v[8]; float s = 0.f;
#pragma unroll
    for (int j = 0; j < 8; ++j) { v[j] = xr[64 * j]; s += (v[j].x * v[j].x + v[j].y * v[j].y) + (v[j].z * v[j].z + v[j].w * v[j].w); }
    const float rstd = 1.0f / sqrtf(wave_sum(s) * (1.f / 2048.f) + EPS);
#pragma unroll
    for (int j = 0; j < 8; ++j) { const f32x4 gg = gr[64 * j]; xr[64 * j] = (f32x4){v[j].x * rstd * gg.x, v[j].y * rstd * gg.y, v[j].z * rstd * gg.z, v[j].w * rstd * gg.w}; }
}

__device__ __forceinline__ const float* ldptr(LAS unsigned long long* tab, int k) {
    unsigned ta = (unsigned)(uintptr_t)(tab + k); asm volatile("" : "+s"(ta));
    const unsigned long long v = *(LAS unsigned long long*)ta; const unsigned lo = __builtin_amdgcn_readfirstlane((unsigned)v), hi = __builtin_amdgcn_readfirstlane((unsigned)(v >> 32));
    return (const float*)(const GAS float*)(((unsigned long long)hi << 32) | lo);
}
struct Args { const float* in[27]; float* out; unsigned char* ws; int ph_lo, ph_hi; };

__device__ __forceinline__ int t5_bucket(int dist) {
    if (dist < 16) return dist;
    const float n = (float)dist;
    int large = 16 + (int)(logf(n / 16.0f) / 4.852030263919617f * 16.0f);
    return large < 31 ? large : 31;
}

__device__ __forceinline__ void naive_attn_a(LAS unsigned char* lds, const bf16* Z, bf16* Oabc, const float* rel_bias, int gw, int ngw, int wave, int lane, int tid) {
    LAS float* bias = (LAS float*)lds;
    for (int i = tid; i < 3 * 129 * 8; i += NWAVES * 64) { const int h = i & 7, gd = i >> 3, g = gd / 129, d = gd - g * 129; const int dil = (g == 0) ? 1 : (g == 1 ? 4 : 16);
        bias[i] = rel_bias[t5_bucket(d * dil) * 8 + h]; }
    __syncthreads();
    LAS float* qs = (LAS float*)(lds + 16384 + wave * 1024);
    LAS float* ps = qs + 128;
    const float scale = 0.08838834764831845f;
    for (int item = gw; item < M * 8; item += ngw) {
        const int h = item & 7, mt = item >> 3, b = mt >> 12, t = mt & 4095;
        { const unsigned w = *(const unsigned*)(Z + (size_t)mt * NA + ZA_Q + h * 128 + 2 * lane); qs[2 * lane] = bflo(w) * scale; qs[2 * lane + 1] = bfhi(w) * scale; }
        LDS_WAIT();
        float m_run = -1e30f, l_run = 0.f, o0 = 0.f, o1 = 0.f;
        for (int g = 0; g < 3; ++g) {
            const int dil = (g == 0) ? 1 : (g == 1 ? 4 : 16);
            const int dmax = (t / dil) < 128 ? (t / dil) : 128;
            for (int d0 = 0; d0 <= dmax; d0 += 64) {
                const int d = d0 + lane; const bool valid = d <= dmax; const int tk = valid ? t - d * dil : t;
                const v4u* kp = (const v4u*)(Z + (size_t)(b * SEQ + tk) * NA + ZA_K + h * 128);
                float s = 0.f;
#pragma unroll
                for (int c = 0; c < 16; ++c) s += dot8(kp[c], qs + 8 * c);
                s = valid ? s + bias[(g * 129 + (valid ? d : 0)) * 8 + h] : -1e30f;
                const float m_new = fmaxf(m_run, wave_max(s)); const float alpha = __expf(m_run - m_new); const float p = valid ? __expf(s - m_new) : 0.f;
                l_run = l_run * alpha + wave_sum(p); o0 *= alpha; o1 *= alpha; m_run = m_new;
                ps[lane] = p; LDS_WAIT();
                const int nk = (dmax - d0 + 1) < 64 ? (dmax - d0 + 1) : 64;
                for (int jj = 0; jj < nk; ++jj) { const float pj = ps[jj]; const int tkj = t - (d0 + jj) * dil;
                    const unsigned w = *(const unsigned*)(Z + (size_t)(b * SEQ + tkj) * NA + ZA_V + h * 128 + 2 * lane); o0 += pj * bflo(w); o1 += pj * bfhi(w); }
                LDS_WAIT();
            }
        }
        const float inv = 1.0f / l_run;
        *(unsigned*)(Oabc + (size_t)mt * 3072 + h * 128 + 2 * lane) = pk2(o0 * inv, o1 * inv);
    }
}

__device__ __forceinline__ void mla_prep(bf16* Z, const float* qg, const float* kvg, const float* ropec, const float* ropes, int gw, int ngw, int lane) {
    const f32x4 gq0 = *(const f32x4*)(qg + 8 * lane), gq1 = *(const f32x4*)(qg + 8 * lane + 4), gk0 = *(const f32x4*)(kvg + 8 * lane), gk1 = *(const f32x4*)(kvg + 8 * lane + 4);
    for (int mt0 = gw; mt0 < M; mt0 += 4 * ngw) {
        v4u w[4][2]; float ss[4][2]; float x1[4], x2[4]; int mts[4];
#pragma unroll
        for (int j = 0; j < 4; ++j) { const int mt = (mt0 + j * ngw < M) ? mt0 + j * ngw : mt0; mts[j] = mt; bf16* zr = Z + (size_t)mt * NABC;
            w[j][0] = *(const v4u*)(zr + ZC_CQA + 8 * lane); w[j][1] = *(const v4u*)(zr + ZC_CKVA + 8 * lane);
            x1[j] = bf2f(zr[ZC_CKR + (lane & 31)]); x2[j] = bf2f(zr[ZC_CKR + 32 + (lane & 31)]);
#pragma unroll
            for (int q = 0; q < 2; ++q) { const v4u a = w[j][q]; const float v0 = bflo(a.x), v1 = bfhi(a.x), v2 = bflo(a.y), v3 = bfhi(a.y), v4 = bflo(a.z), v5 = bfhi(a.z), v6 = bflo(a.w), v7 = bfhi(a.w);
                ss[j][q] = (v0 * v0 + v1 * v1) + (v2 * v2 + v3 * v3) + (v4 * v4 + v5 * v5) + (v6 * v6 + v7 * v7); } }
#pragma unroll
        for (int j = 0; j < 4; ++j) { ss[j][0] = wave_sum(ss[j][0]); ss[j][1] = wave_sum(ss[j][1]); }
#pragma unroll
        for (int j = 0; j < 4; ++j) { if (j > 0 && mt0 + j * ngw >= M) continue; const int mt = mts[j]; bf16* zr = Z + (size_t)mt * NABC; const int s_pos = mt & 4095;
#pragma unroll
            for (int q = 0; q < 2; ++q) { const float rstd = 1.0f / sqrtf(ss[j][q] * (1.f / 512.f) + EPS); const v4u a = w[j][q]; const f32x4 g0 = q ? gk0 : gq0, g1 = q ? gk1 : gq1;
                v4u o; o.x = pk2(bflo(a.x) * rstd * g0.x, bfhi(a.x) * rstd * g0.y); o.y = pk2(bflo(a.y) * rstd * g0.z, bfhi(a.y) * rstd * g0.w);
                o.z = pk2(bflo(a.z) * rstd * g1.x, bfhi(a.z) * rstd * g1.y); o.w = pk2(bflo(a.w) * rstd * g1.z, bfhi(a.w) * rstd * g1.w);
                *(v4u*)(zr + (q ? ZC_CKVA : ZC_CQA) + 8 * lane) = o; }
            const float c = ropec[s_pos * 32 + (lane & 31)], sn = ropes[s_pos * 32 + (lane & 31)];
            const float r = (lane < 32) ? (x1[j] * c - x2[j] * sn) : (x1[j] * sn + x2[j] * c);
            zr[ZC_CKR + lane] = (bf16)f2bf(r); }
    }
}

__device__ __forceinline__ void naive_attn_mla(LAS unsigned char* lds, const bf16* Q, const bf16* KV, const bf16* Z, bf16* Oabc, const float* ropec, const float* ropes, int gw, int ngw, int wave, int lane) {
    LAS float* qs = (LAS float*)(lds + wave * 4096);
    LAS float* ps = qs + 768;
    const float scale = 0.07216878364870322f;
    const int nitems = NB * 8 * (SEQ / 4);
    for (int item = gw; item < nitems; item += ngw) {
        const int qg = item % (SEQ / 4), bh = item / (SEQ / 4), b = bh >> 3, h = bh & 7, i0 = 4 * qg;
#pragma unroll
        for (int r = 0; r < 4; ++r) {
            const bf16* qp = Q + (size_t)(b * SEQ + i0 + r) * 1536 + h * 192;
            qs[r * 192 + lane] = bf2f(qp[lane]) * scale; qs[r * 192 + 64 + lane] = bf2f(qp[64 + lane]) * scale;
            const float x1 = bf2f(qp[128 + (lane & 31)]), x2 = bf2f(qp[160 + (lane & 31)]);
            const float c = ropec[(i0 + r) * 32 + (lane & 31)], sn = ropes[(i0 + r) * 32 + (lane & 31)];
            qs[r * 192 + 128 + lane] = ((lane < 32) ? (x1 * c - x2 * sn) : (x1 * sn + x2 * c)) * scale;
        }
        LDS_WAIT();
        float m_run[4], l_run[4], o0[4], o1[4];
#pragma unroll
        for (int r = 0; r < 4; ++r) { m_run[r] = -1e30f; l_run[r] = 0.f; o0[r] = 0.f; o1[r] = 0.f; }
        const int jlast = i0 + 3;
        for (int j0 = 0; j0 <= jlast; j0 += 64) {
            const int j = j0 + lane, jc = j <= jlast ? j : jlast;
            const v4u* kn = (const v4u*)(KV + (size_t)(b * SEQ + jc) * 2048 + h * 256);
            const v4u* kr = (const v4u*)(Z + (size_t)(b * SEQ + jc) * NABC + ZC_CKR);
            float s[4] = {0.f, 0.f, 0.f, 0.f};
#pragma unroll 4
            for (int c = 0; c < 16; ++c) { const v4u kk = kn[c];
#pragma unroll
                for (int r = 0; r < 4; ++r) s[r] += dot8(kk, qs + r * 192 + 8 * c); }
#pragma unroll 4
            for (int c = 0; c < 8; ++c) { const v4u kk = kr[c];
#pragma unroll
                for (int r = 0; r < 4; ++r) s[r] += dot8(kk, qs + r * 192 + 128 + 8 * c); }
#pragma unroll
            for (int r = 0; r < 4; ++r) { const bool valid = j <= i0 + r; const float sv = valid ? s[r] : -1e30f;
                const float m_new = fmaxf(m_run[r], wave_max(sv)); const float alpha = __expf(m_run[r] - m_new); const float p = valid ? __expf(sv - m_new) : 0.f;
                l_run[r] = l_run[r] * alpha + wave_sum(p); o0[r] *= alpha; o1[r] *= alpha; m_run[r] = m_new; ps[r * 64 + lane] = p; }
            LDS_WAIT();
            const int nk = (jlast - j0 + 1) < 64 ? (jlast - j0 + 1) : 64;
            for (int jj = 0; jj < nk; ++jj) {
                const unsigned w = *(const unsigned*)(KV + (size_t)(b * SEQ + j0 + jj) * 2048 + h * 256 + 128 + 2 * lane); const float v0 = bflo(w), v1 = bfhi(w);
#pragma unroll
                for (int r = 0; r < 4; ++r) { const float pj = ps[r * 64 + jj]; o0[r] += pj * v0; o1[r] += pj * v1; } }
            LDS_WAIT();
        }
#pragma unroll
        for (int r = 0; r < 4; ++r) { const float inv = 1.0f / l_run[r]; *(unsigned*)(Oabc + (size_t)(b * SEQ + i0 + r) * 3072 + 2048 + h * 128 + 2 * lane) = pk2(o0[r] * inv, o1[r] * inv); }
    }
}

__device__ __forceinline__ void naive_attn_cross(LAS unsigned char* lds, const bf16* XQ, const bf16* MKV, bf16* OX, int gw, int ngw, int wave, int lane) {
    LAS float* qs = (LAS float*)(lds + wave * 12288);
    LAS float* ps = qs + 2048;
    const float scale = 0.04419417382415922f;
    const int nitems = (M / 4) * 4;
    for (int item = gw; item < nitems; item += ngw) {
        const int h = item & 3, m0 = (item >> 2) * 4, b = m0 >> 12;
#pragma unroll
        for (int r = 0; r < 4; ++r) { const v4u w = *(const v4u*)(XQ + (size_t)(m0 + r) * 2048 + h * 512 + 8 * lane); LAS float* q = qs + r * 512 + 8 * lane;
            q[0] = bflo(w.x) * scale; q[1] = bfhi(w.x) * scale; q[2] = bflo(w.y) * scale; q[3] = bfhi(w.y) * scale; q[4] = bflo(w.z) * scale; q[5] = bfhi(w.z) * scale; q[6] = bflo(w.w) * scale; q[7] = bfhi(w.w) * scale; }
        LDS_WAIT();
        float m_run[4], l_run[4], o[4][8];
#pragma unroll
        for (int r = 0; r < 4; ++r) { m_run[r] = -1e30f; l_run[r] = 0.f;
#pragma unroll
            for (int e = 0; e < 8; ++e) o[r][e] = 0.f; }
        for (int j0 = 0; j0 < MEML; j0 += 64) {
            const v4u* kp = (const v4u*)(MKV + (size_t)(b * MEML + j0 + lane) * 4096 + h * 512);
            float s[4] = {0.f, 0.f, 0.f, 0.f};
#pragma unroll 4
            for (int c = 0; c < 64; ++c) { const v4u kk = kp[c];
#pragma unroll
                for (int r = 0; r < 4; ++r) s[r] += dot8(kk, qs + r * 512 + 8 * c); }
#pragma unroll
            for (int r = 0; r < 4; ++r) { const float m_new = fmaxf(m_run[r], wave_max(s[r])); const float alpha = __expf(m_run[r] - m_new); const float p = __expf(s[r] - m_new);
                l_run[r] = l_run[r] * alpha + wave_sum(p); m_run[r] = m_new; ps[r * 64 + lane] = p;
#pragma unroll
                for (int e = 0; e < 8; ++e) o[r][e] *= alpha; }
            LDS_WAIT();
            for (int jj = 0; jj < 64; ++jj) {
                const v4u w = *(const v4u*)(MKV + (size_t)(b * MEML + j0 + jj) * 4096 + 2048 + h * 512 + 8 * lane);
                const float v[8] = {bflo(w.x), bfhi(w.x), bflo(w.y), bfhi(w.y), bflo(w.z), bfhi(w.z), bflo(w.w), bfhi(w.w)};
#pragma unroll
                for (int r = 0; r < 4; ++r) { const float pj = ps[r * 64 + jj];
#pragma unroll
                    for (int e = 0; e < 8; ++e) o[r][e] += pj * v[e]; } }
            LDS_WAIT();
        }
#pragma unroll
        for (int r = 0; r < 4; ++r) { const float inv = 1.0f / l_run[r]; v4u w; w.x = pk2(o[r][0] * inv, o[r][1] * inv); w.y = pk2(o[r][2] * inv, o[r][3] * inv); w.z = pk2(o[r][4] * inv, o[r][5] * inv); w.w = pk2(o[r][6] * inv, o[r][7] * inv);
            *(v4u*)(OX + (size_t)(m0 + r) * 2048 + h * 512 + 8 * lane) = w; }
    }
}

__device__ __forceinline__ void naive_gla(LAS unsigned char* lds, const bf16* Z, bf16* Oabc, const float* w_alpha, const float* b_alpha, const float* gla_norm, int bh, int tid, int wave, int lane) {
    constexpr int CH = 16;
    LAS float* qs = (LAS float*)lds;
    LAS float* ks = qs + CH * 128;
    LAS float* as = ks + CH * 128;
    LAS float* vs = as + CH * 128;
    LAS float* op = vs + CH * 256;
    const int b = bh >> 2, h = bh & 3, c = tid & 255, half = tid >> 8, kcol = tid & 127;
    float wa[16];
#pragma unroll
    for (int j = 0; j < 16; ++j) wa[j] = w_alpha[j * 512 + h * 128 + kcol];
    const float ba = b_alpha[h * 128 + kcol];
    float S[64];
#pragma unroll
    for (int k = 0; k < 64; ++k) S[k] = 0.f;
    const float qscale = 0.08838834764831845f;
    for (int t0 = 0; t0 < SEQ; t0 += CH) {
        const size_t m0 = (size_t)b * SEQ + t0;
        for (int idx = tid; idx < CH * 128; idx += NWAVES * 64) { const int t = idx >> 7; const bf16* zr = Z + (m0 + t) * NABC;
            qs[idx] = bf2f(zr[ZC_BQ + h * 128 + kcol]) * qscale; ks[idx] = bf2f(zr[ZC_BK + h * 128 + kcol]);
            float x = ba;
#pragma unroll
            for (int j = 0; j < 16; ++j) x += bf2f(zr[ZC_BLR + j]) * wa[j];
            const float ls = fminf(x, 0.f) - log1pf(__expf(-fabsf(x)));
            as[idx] = __expf(ls * (1.0f / 16.0f)); }
        for (int idx = tid; idx < CH * 256; idx += NWAVES * 64) { const int t = idx >> 8; vs[idx] = bf2f(Z[(m0 + t) * NABC + ZC_BV + h * 256 + (idx & 255)]); }
        __syncthreads();
        for (int t = 0; t < CH; ++t) {
            const float v = vs[t * 256 + c]; float acc = 0.f;
            const LAS f32x4* a4 = (const LAS f32x4*)(as + t * 128 + half * 64); const LAS f32x4* k4 = (const LAS f32x4*)(ks + t * 128 + half * 64); const LAS f32x4* q4 = (const LAS f32x4*)(qs + t * 128 + half * 64);
#pragma unroll
            for (int k = 0; k < 16; ++k) { const f32x4 a = a4[k], kk = k4[k], q = q4[k];
                S[4 * k + 0] = a.x * S[4 * k + 0] + kk.x * v; acc += q.x * S[4 * k + 0];
                S[4 * k + 1] = a.y * S[4 * k + 1] + kk.y * v; acc += q.y * S[4 * k + 1];
                S[4 * k + 2] = a.z * S[4 * k + 2] + kk.z * v; acc += q.z * S[4 * k + 2];
                S[4 * k + 3] = a.w * S[4 * k + 3] + kk.w * v; acc += q.w * S[4 * k + 3];
                if ((k & 3) == 3) asm volatile("" ::: "memory"); }
            op[(half * CH + t) * 256 + c] = acc;
        }
        __syncthreads();
        for (int t = wave; t < CH; t += NWAVES) {
            float o[4]; float ss = 0.f;
#pragma unroll
            for (int i = 0; i < 4; ++i) { o[i] = op[t * 256 + lane + 64 * i] + op[(CH + t) * 256 + lane + 64 * i]; ss += o[i] * o[i]; }
            const float rstd = 1.0f / sqrtf(wave_sum(ss) * (1.f / 256.f) + EPS);
#pragma unroll
            for (int i = 0; i < 4; ++i) { const int cc = lane + 64 * i; const float r = bf2f(Z[(m0 + t) * NABC + ZC_BR + h * 256 + cc]);
                const float y = o[i] * rstd * gla_norm[h * 256 + cc] * (r / (1.0f + __expf(-r)));
                Oabc[(m0 + t) * 3072 + 1024 + h * 256 + cc] = (bf16)f2bf(y); }
        }
        __syncthreads();
    }
}


namespace fa {
using bf16x8 = __attribute__((ext_vector_type(8))) short;
using s16x4  = __attribute__((ext_vector_type(4))) short;
using f32x16 = __attribute__((ext_vector_type(16))) float;
using u32x4  = __attribute__((ext_vector_type(4))) unsigned;
#define FA_SBAR() __builtin_amdgcn_sched_barrier(0)
__device__ __forceinline__ int crow(int r, int hi) { return (r & 3) + 8 * (r >> 2) + 4 * hi; }
__device__ __forceinline__ unsigned cvtpk(float lo, float hi) { unsigned r; asm volatile("v_cvt_pk_bf16_f32 %0, %1, %2" : "=v"(r) : "v"(lo), "v"(hi)); return r; }
__device__ __forceinline__ void partialSM(f32x16& p0, f32x16& p1, float& m_reg, float& mn, float& alpha, const float C, const float thr) {
  float pmax = p0[0];
#pragma unroll
  for (int r = 1; r < 16; ++r) pmax = fmaxf(pmax, p0[r]);
#pragma unroll
  for (int r = 0; r < 16; ++r) pmax = fmaxf(pmax, p1[r]);
  { auto rr = __builtin_amdgcn_permlane32_swap(__float_as_uint(pmax), __float_as_uint(pmax), false, false);
    pmax = fmaxf(__uint_as_float(rr[0]), __uint_as_float(rr[1])); }
  if (__builtin_expect(__all(pmax - m_reg <= thr), 1)) { mn = m_reg; alpha = 1.f; }
  else { mn = fmaxf(m_reg, pmax); alpha = __builtin_amdgcn_exp2f((m_reg - mn) * C); m_reg = mn; }
  const float mnC = -mn * C;
#pragma unroll
  for (int r = 0; r < 16; ++r) p0[r] = fmaf(p0[r], C, mnC);
#pragma unroll
  for (int r = 0; r < 16; ++r) p1[r] = fmaf(p1[r], C, mnC);
#pragma unroll
  for (int r = 0; r < 16; ++r) p0[r] = __builtin_amdgcn_exp2f(p0[r]);
}
#define FA_PK4(P, BASE, OUT) do { unsigned a0 = fa::cvtpk(P[BASE + 0], P[BASE + 1]), a1 = fa::cvtpk(P[BASE + 2], P[BASE + 3]);   \
    unsigned b0 = fa::cvtpk(P[BASE + 4], P[BASE + 5]), b1 = fa::cvtpk(P[BASE + 6], P[BASE + 7]);                              \
    auto r0 = __builtin_amdgcn_permlane32_swap(a0, b0, false, false); auto r1 = __builtin_amdgcn_permlane32_swap(a1, b1, false, false); \
    fa::u32x4 w = {r0[0], r1[0], r0[1], r1[1]}; OUT = *reinterpret_cast<fa::bf16x8*>(&w); } while (0)
__device__ __forceinline__ void finishSM(f32x16& p0, f32x16& p1, float alpha, float& l_reg, bf16x8& pa0, bf16x8& pa1, bf16x8& pa2, bf16x8& pa3) {
#pragma unroll
  for (int r = 0; r < 16; ++r) p1[r] = __builtin_amdgcn_exp2f(p1[r]);
  float ps = 0;
#pragma unroll
  for (int r = 0; r < 16; ++r) ps += p0[r];
#pragma unroll
  for (int r = 0; r < 16; ++r) ps += p1[r];
  { auto rr = __builtin_amdgcn_permlane32_swap(__float_as_uint(ps), __float_as_uint(ps), false, false);
    ps = __uint_as_float(rr[0]) + __uint_as_float(rr[1]); }
  l_reg = l_reg * alpha + ps;
  FA_PK4(p0, 0, pa0); FA_PK4(p0, 8, pa1); FA_PK4(p1, 0, pa2); FA_PK4(p1, 8, pa3);
}
__device__ __forceinline__ int v_st(int k, int c) { const int kk = (k & ~0xC) | ((k & 4) << 1) | ((k & 8) >> 1); return ((kk >> 3) * 4 + (c >> 5)) * 512 + ((kk & 7) * 32 + (c & 31)) * 2; }
__device__ __forceinline__ int v_rd_base(int lane) { return ((lane & 3) << 3) | (((lane >> 2) & 3) << 6) | (((lane >> 4) & 1) << 5) | (((lane >> 5) & 1) << 8); }
constexpr int v_rd_off(int d0, int ks, int half) { return d0 * 512 + ks * 4096 + half * 2048; }
template <int OFF> __device__ __forceinline__ s16x4 tr_read(int vb) {
  s16x4 r; asm volatile("ds_read_b64_tr_b16 %0, %1 offset:%2" : "=&v"(r) : "v"(vb), "i"(OFF) : "memory"); return r;
}
template <int D0, int BASE = 0> __device__ __forceinline__ void pv_one(f32x16& od, int vb, bf16x8 pa0, bf16x8 pa1, bf16x8 pa2, bf16x8 pa3) {
  s16x4 l0 = tr_read<BASE + v_rd_off(D0, 0, 0)>(vb), h0 = tr_read<BASE + v_rd_off(D0, 0, 1)>(vb), l1 = tr_read<BASE + v_rd_off(D0, 1, 0)>(vb), h1 = tr_read<BASE + v_rd_off(D0, 1, 1)>(vb);
  s16x4 l2 = tr_read<BASE + v_rd_off(D0, 2, 0)>(vb), h2 = tr_read<BASE + v_rd_off(D0, 2, 1)>(vb), l3 = tr_read<BASE + v_rd_off(D0, 3, 0)>(vb), h3 = tr_read<BASE + v_rd_off(D0, 3, 1)>(vb);
  asm volatile("s_waitcnt lgkmcnt(0)" : "+v"(l0), "+v"(h0), "+v"(l1), "+v"(h1), "+v"(l2), "+v"(h2), "+v"(l3), "+v"(h3) :: "memory"); FA_SBAR();
#define FA_PK(L, H) (bf16x8){L[0], L[1], L[2], L[3], H[0], H[1], H[2], H[3]}
  od = __builtin_amdgcn_mfma_f32_32x32x16_bf16(pa0, FA_PK(l0, h0), od, 0, 0, 0);
  od = __builtin_amdgcn_mfma_f32_32x32x16_bf16(pa1, FA_PK(l1, h1), od, 0, 0, 0);
  od = __builtin_amdgcn_mfma_f32_32x32x16_bf16(pa2, FA_PK(l2, h2), od, 0, 0, 0);
  od = __builtin_amdgcn_mfma_f32_32x32x16_bf16(pa3, FA_PK(l3, h3), od, 0, 0, 0);
#undef FA_PK
}
template <int BASE = 0> __device__ __forceinline__ void pv_d0(f32x16* o, int vb, bf16x8 pa0, bf16x8 pa1, bf16x8 pa2, bf16x8 pa3) {
  pv_one<0, BASE>(o[0], vb, pa0, pa1, pa2, pa3); pv_one<1, BASE>(o[1], vb, pa0, pa1, pa2, pa3); pv_one<2, BASE>(o[2], vb, pa0, pa1, pa2, pa3); pv_one<3, BASE>(o[3], vb, pa0, pa1, pa2, pa3);
}
#define FA_RESC(a, o, al_l, r32, hi) do { if (__any((a) < 1.f)) { if ((hi) == 0) (al_l)[r32] = (a); asm volatile("s_waitcnt lgkmcnt(0)" ::: "memory"); \
    _Pragma("unroll") for (int d_ = 0; d_ < 4; ++d_) _Pragma("unroll") for (int r_ = 0; r_ < 16; ++r_) (o)[d_][r_] *= (al_l)[fa::crow(r_, hi)]; } } while (0)
__device__ __forceinline__ void store_o_bf16(const f32x16* o, const float* rli, bf16* Ow, int ldo, int lane, int r32, int hi) {
  const unsigned loff = (unsigned)((((lane & 1) + 4 * hi) * ldo + (r32 & ~1)) * 2);
#pragma unroll
  for (int r = 0; r < 16; r += 2) {
    char* rowp = (char*)(Ow + (size_t)((r & 3) + 8 * (r >> 2)) * ldo);
#pragma unroll
    for (int d0 = 0; d0 < 4; ++d0) {
      const float a = o[d0][r] * rli[r], b = o[d0][r + 1] * rli[r + 1];
      const float send = (lane & 1) ? a : b; const float recv = lane_xor1(send);
      const unsigned w = cvtpk((lane & 1) ? recv : a, (lane & 1) ? b : recv);
      *(unsigned*)(rowp + loff + d0 * 64) = w; } }
}
}

#define KSWZ192(row, colB) ((row) * 384 + ((colB) ^ (((row) & 7) << 4)))
__device__ __forceinline__ void mla_attn_phase(LAS unsigned char* lds, const bf16* Q, const bf16* KV, const bf16* Z, bf16* Oabc, const float* ropec, const float* ropes, int vcu, int G, int tid) {
    using namespace fa;
    asm volatile("" : "+v"(tid));
    const int wid = __builtin_amdgcn_readfirstlane(tid >> 6), lane = tid & 63, r32 = lane & 31, hi = lane >> 5;
    constexpr int SHM_K = 64 * 384, SHM_V = 16384;
    LAS unsigned char* K_lds = lds; LAS unsigned char* V_lds = lds + 2 * SHM_K;
    LAS float* wsf = (LAS float*)(lds + 2 * SHM_K + 2 * SHM_V) + wid * 64; LAS float* li_l = wsf; LAS float* al_l = wsf + 32;
    LAS unsigned char* qrl = lds + 86016 + wid * 4096;
    const int sr = tid >> 4, sc = (tid & 15) * 8, vst0 = v_st(sr, sc);
    const int kr_row = tid >> 3, kr_c = (tid & 7) * 8;
    const int kst0 = KSWZ192(sr, sc * 2), kst2 = KSWZ192(kr_row, 256 + kr_c * 2);
    const int vb0 = (int)(uintptr_t)V_lds + v_rd_base(lane);
    int ka[4];
#pragma unroll
    for (int j = 0; j < 4; ++j) ka[j] = r32 * 384 + (((j * 2 + hi) ^ (r32 & 7)) << 4);
    constexpr float SCALE = 0.07216878364870322f, C = SCALE * 1.4426950408889634f, THRS = 8.0f / SCALE;
    const unsigned qoff = (unsigned)(((wid * 32 + r32) * 1536 + hi * 8) * 2), roff = (unsigned)(((wid * 32 + r32) * 32 + hi * 8) * 4);
    const unsigned kvoff = (unsigned)((sr * 2048 + sc) * 2), zoff = (unsigned)((kr_row * NABC + ZC_CKR + kr_c) * 2);
#pragma unroll 1
    for (int pi = vcu; pi < 256; pi += G) {
        const int bh = pi >> 3, b = bh >> 3, h = bh & 7;
        const size_t tok0 = (size_t)b * SEQ;
#pragma unroll 1
        for (int half = 0; half < 2; ++half) {
            const int qb = half ? 15 - (pi & 7) : (pi & 7);
            bf16x8 qr[8];
            { bf16x8 qrope[4]; unsigned qoff_ = qoff, roff_ = roff; asm volatile("" : "+v"(qoff_), "+v"(roff_));
              const char* Qu = (const char*)(Q + (tok0 + qb * 256) * 1536 + h * 192);
              const char* cu = (const char*)(ropec + (size_t)(qb * 256) * 32); const char* su = (const char*)(ropes + (size_t)(qb * 256) * 32);
#pragma unroll
              for (int d0 = 0; d0 < 8; ++d0) qr[d0] = *(const bf16x8*)(Qu + qoff_ + d0 * 32);
#pragma unroll
              for (int d0 = 0; d0 < 4; ++d0) qrope[d0] = *(const bf16x8*)(Qu + qoff_ + (8 + d0) * 32);
#pragma unroll
              for (int pr = 0; pr < 2; ++pr) {
                  const f32x4 c0 = *(const f32x4*)(cu + roff_ + pr * 64), c1 = *(const f32x4*)(cu + roff_ + pr * 64 + 16), s0 = *(const f32x4*)(su + roff_ + pr * 64), s1 = *(const f32x4*)(su + roff_ + pr * 64 + 16);
                  const float cc[8] = {c0.x, c0.y, c0.z, c0.w, c1.x, c1.y, c1.z, c1.w}, ss[8] = {s0.x, s0.y, s0.z, s0.w, s1.x, s1.y, s1.z, s1.w};
                  bf16x8 xa = qrope[pr], xb = qrope[2 + pr];
#pragma unroll
                  for (int e = 0; e < 8; ++e) { const float x1 = bf2f((bf16)xa[e]), x2 = bf2f((bf16)xb[e]);
                      xa[e] = (short)f2bf(x1 * cc[e] - x2 * ss[e]); xb[e] = (short)f2bf(x1 * ss[e] + x2 * cc[e]); }
                  *(LAS bf16x8*)(qrl + (pr * 64 + lane) * 16) = xa; *(LAS bf16x8*)(qrl + ((2 + pr) * 64 + lane) * 16) = xb; } }
            v4u vs0, vs1, ks0, ks1, krr;
            const char* KVu = (const char*)(KV + tok0 * 2048 + h * 256); const char* Zu = (const char*)(Z + tok0 * NABC);
#define MLA_SLOAD(k0) do { const char* kvp = KVu + (size_t)(k0) * 4096; const char* zp = Zu + (size_t)(k0) * (NABC * 2); \
            ks0 = *(const v4u*)(kvp + kvoff); vs0 = *(const v4u*)(kvp + kvoff + 256); ks1 = *(const v4u*)(kvp + 32 * 4096 + kvoff); vs1 = *(const v4u*)(kvp + 32 * 4096 + kvoff + 256); \
            krr = *(const v4u*)(zp + zoff); } while (0)
#define MLA_SWRITE(bb) do { *(LAS v4u*)(V_lds + (bb) * SHM_V + vst0) = vs0; *(LAS v4u*)(V_lds + (bb) * SHM_V + vst0 + 8192) = vs1; \
            *(LAS v4u*)(K_lds + (bb) * SHM_K + kst0) = ks0; *(LAS v4u*)(K_lds + (bb) * SHM_K + kst0 + 32 * 384) = ks1; \
            *(LAS v4u*)(K_lds + (bb) * SHM_K + kst2) = krr; } while (0)
            const int nt = 4 * qb + 4;
            float m_reg = -1e30f, l_reg = 0.f; f32x16 o[4];
#pragma unroll
            for (int d = 0; d < 4; ++d)
#pragma unroll
                for (int r = 0; r < 16; ++r) o[d][r] = 0.f;
            MLA_SLOAD(0); MLA_SWRITE(0); __syncthreads();
#pragma unroll 1
            for (int t = 0; t < nt; ++t) {
                const int buf = t & 1;
                if (t + 1 < nt) MLA_SLOAD((t + 1) * 64);
                FA_SBAR();
                const int tt = t - 4 * qb;
                {
                    f32x16 p0, p1;
#pragma unroll
                    for (int r = 0; r < 16; ++r) { p0[r] = 0.f; p1[r] = 0.f; }
                    const LAS unsigned char* Ks = K_lds + buf * SHM_K;
                    bf16x8 kf[2][4], qx[2][2];
#define MLA_KREAD(g_) do { _Pragma("unroll") for (int e_ = 0; e_ < 2; ++e_) { const int d_ = 2 * (g_) + e_; \
                        kf[(g_) & 1][2 * e_] = *(const LAS bf16x8*)(Ks + ka[d_ & 3] + (d_ >> 2) * 128); kf[(g_) & 1][2 * e_ + 1] = *(const LAS bf16x8*)(Ks + ka[d_ & 3] + (d_ >> 2) * 128 + 32 * 384); \
                        if (d_ >= 8) qx[(g_) & 1][e_] = *(const LAS bf16x8*)(qrl + ((d_ - 8) * 64 + lane) * 16); } } while (0)
                    MLA_KREAD(0);
#pragma unroll
                    for (int g = 0; g < 6; ++g) {
                        if (g + 1 < 6) MLA_KREAD(g + 1);
                        FA_SBAR();
#pragma unroll
                        for (int e = 0; e < 2; ++e) { const int d0 = 2 * g + e; const bf16x8 qv = (d0 < 8) ? qr[d0 < 8 ? d0 : 0] : qx[g & 1][e];
                            p0 = __builtin_amdgcn_mfma_f32_32x32x16_bf16(kf[g & 1][2 * e], qv, p0, 0, 0, 0);
                            p1 = __builtin_amdgcn_mfma_f32_32x32x16_bf16(kf[g & 1][2 * e + 1], qv, p1, 0, 0, 0); }
                        FA_SBAR(); }
#undef MLA_KREAD
                    if (tt >= 0) { const int rrel = 32 * wid + r32 - 64 * tt;
#pragma unroll
                        for (int r = 0; r < 16; ++r) { const int kk = crow(r, hi); if (kk > rrel) p0[r] = -1e30f; if (32 + kk > rrel) p1[r] = -1e30f; } }
                    float mn, alpha; partialSM(p0, p1, m_reg, mn, alpha, C, THRS);
                    FA_RESC(alpha, o, al_l, r32, hi);
                    bf16x8 pa0, pa1, pa2, pa3; finishSM(p0, p1, alpha, l_reg, pa0, pa1, pa2, pa3); FA_SBAR();
                    pv_d0(o, vb0 + buf * SHM_V, pa0, pa1, pa2, pa3);
                }
                if (t + 1 < nt) MLA_SWRITE(buf ^ 1);
                __syncthreads();
            }
#undef MLA_SLOAD
#undef MLA_SWRITE
            if (hi == 0) li_l[r32] = l_reg;
            asm volatile("s_waitcnt lgkmcnt(0)" ::: "memory");
            float rli[16];
#pragma unroll
            for (int r = 0; r < 16; ++r) rli[r] = __builtin_amdgcn_rcpf(li_l[crow(r, hi)]);
            { int lane_ = lane; asm volatile("" : "+v"(lane_)); store_o_bf16(o, rli, Oabc + (tok0 + qb * 256 + wid * 32) * 3072 + 2048 + h * 128, 3072, lane_, lane_ & 31, lane_ >> 5); }
        }
    }
}


#define KSWZ256(row, colB) ((row) * 256 + ((colB) ^ (((row) & 7) << 4)))
constexpr int RSL_OFF = 132096 + 8192;
constexpr int XSCR_OFF = 132096;
__device__ __forceinline__ void cross_attn_phase(LAS unsigned char* lds_all, const bf16* XQ, const bf16* MKV, bf16* OX, int vcu, int G, int tid) {
    using namespace fa;
    asm volatile("" : "+v"(tid));
    const int wid = __builtin_amdgcn_readfirstlane(tid >> 6), lane = tid & 63, r32 = lane & 31, hi = lane >> 5;
    LAS unsigned char* lds = lds_all;
    LAS float* li_l = (LAS float*)(lds_all + XSCR_OFF) + wid * 64;
    const int sr = tid >> 4, ch = tid & 15;
    const int kst = KSWZ256(sr, ch * 16), vst = v_st(sr, ch * 8);
    const unsigned loff = (unsigned)((sr * 4096 + ch * 8) * 2);
    const unsigned qoff = (unsigned)(((wid * 32 + r32) * 2048 + hi * 8) * 2);
    const int vb0 = (int)(uintptr_t)lds + v_rd_base(lane);
    int ka[4];
#pragma unroll
    for (int j = 0; j < 4; ++j) ka[j] = r32 * 256 + (((j * 2 + hi) ^ (r32 & 7)) << 4);
    constexpr float SCALE = 0.04419417382415922f, C = SCALE * 1.4426950408889634f;
#pragma unroll 1
    for (int u = vcu; u < 256; u += G) {
        const int b = u >> 6, h = (u >> 4) & 3, qblk = u & 15;
        const char* Qu = (const char*)(XQ + ((size_t)b * SEQ + qblk * 256) * 2048 + h * 512);
        const char* Ku = (const char*)(MKV + (size_t)b * MEML * 4096 + h * 512);
        v4u st[8];
#define XS_LOAD(base) do { _Pragma("unroll") for (int i_ = 0; i_ < 8; ++i_) st[i_] = *(const v4u*)((base) + (size_t)i_ * 262144 + loff); } while (0)
#define XS_WRITE_K(bb) do { _Pragma("unroll") for (int i_ = 0; i_ < 8; ++i_) *(LAS v4u*)(lds + (bb) * 65536 + (i_ >> 1) * 16384 + (i_ & 1) * 8192 + kst) = st[i_]; } while (0)
#define XS_WRITE_V(bb) do { _Pragma("unroll") for (int i_ = 0; i_ < 8; ++i_) *(LAS v4u*)(lds + (bb) * 65536 + (i_ >> 1) * 16384 + (i_ & 1) * 8192 + vst) = st[i_]; } while (0)
        XS_LOAD(Ku); XS_WRITE_K(0); __syncthreads();
        f32x16 p[4][2];
#pragma unroll
        for (int t = 0; t < 4; ++t)
#pragma unroll
            for (int r = 0; r < 16; ++r) { p[t][0][r] = 0.f; p[t][1][r] = 0.f; }
#pragma unroll
        for (int dc = 0; dc < 4; ++dc) {
            if (dc < 3) XS_LOAD(Ku + (dc + 1) * 256); else XS_LOAD(Ku + 4096);
            const LAS unsigned char* Ks = lds + (dc & 1) * 65536;
#pragma unroll
            for (int d0 = 0; d0 < 8; ++d0) {
                const bf16x8 qf = *(const bf16x8*)(Qu + qoff + (dc * 128 + d0 * 16) * 2);
#pragma unroll
                for (int t = 0; t < 4; ++t) {
                    const bf16x8 b0 = *(const LAS bf16x8*)(Ks + t * 16384 + ka[d0 & 3] + (d0 >> 2) * 128); const bf16x8 b1 = *(const LAS bf16x8*)(Ks + t * 16384 + ka[d0 & 3] + (d0 >> 2) * 128 + 32 * 256);
                    p[t][0] = __builtin_amdgcn_mfma_f32_32x32x16_bf16(b0, qf, p[t][0], 0, 0, 0);
                    p[t][1] = __builtin_amdgcn_mfma_f32_32x32x16_bf16(b1, qf, p[t][1], 0, 0, 0); }
                FA_SBAR(); }
            if (dc < 3) XS_WRITE_K((dc + 1) & 1); else XS_WRITE_V(0);
            __syncthreads();
        }
        float mx = p[0][0][0];
#pragma unroll
        for (int t = 0; t < 4; ++t)
#pragma unroll
            for (int r = 0; r < 16; ++r) { mx = fmaxf(mx, p[t][0][r]); mx = fmaxf(mx, p[t][1][r]); }
        { auto rr = __builtin_amdgcn_permlane32_swap(__float_as_uint(mx), __float_as_uint(mx), false, false); mx = fmaxf(__uint_as_float(rr[0]), __uint_as_float(rr[1])); }
        const float mC = -mx * C; float ps = 0.f;
#pragma unroll
        for (int t = 0; t < 4; ++t)
#pragma unroll
            for (int r = 0; r < 16; ++r) { p[t][0][r] = __builtin_amdgcn_exp2f(fmaf(p[t][0][r], C, mC)); p[t][1][r] = __builtin_amdgcn_exp2f(fmaf(p[t][1][r], C, mC)); ps += p[t][0][r] + p[t][1][r]; }
        { auto rr = __builtin_amdgcn_permlane32_swap(__float_as_uint(ps), __float_as_uint(ps), false, false); ps = __uint_as_float(rr[0]) + __uint_as_float(rr[1]); }
        bf16x8 pa[4][4];
#pragma unroll
        for (int t = 0; t < 4; ++t) { FA_PK4(p[t][0], 0, pa[t][0]); FA_PK4(p[t][0], 8, pa[t][1]); FA_PK4(p[t][1], 0, pa[t][2]); FA_PK4(p[t][1], 8, pa[t][3]); }
        if (hi == 0) li_l[r32] = ps;
        asm volatile("s_waitcnt lgkmcnt(0)" ::: "memory");
        float rli[16];
#pragma unroll
        for (int r = 0; r < 16; ++r) rli[r] = __builtin_amdgcn_rcpf(li_l[crow(r, hi)]);
#pragma unroll
        for (int vc = 0; vc < 4; ++vc) {
            if (vc < 3) XS_LOAD(Ku + 4096 + (vc + 1) * 256);
            f32x16 o[4];
#pragma unroll
            for (int d = 0; d < 4; ++d)
#pragma unroll
                for (int r = 0; r < 16; ++r) o[d][r] = 0.f;
            const int vb = vb0 + (vc & 1) * 65536;
            pv_d0<0>(o, vb, pa[0][0], pa[0][1], pa[0][2], pa[0][3]); pv_d0<16384>(o, vb, pa[1][0], pa[1][1], pa[1][2], pa[1][3]);
            pv_d0<32768>(o, vb, pa[2][0], pa[2][1], pa[2][2], pa[2][3]); pv_d0<49152>(o, vb, pa[3][0], pa[3][1], pa[3][2], pa[3][3]);
            store_o_bf16(o, rli, OX + ((size_t)b * SEQ + qblk * 256 + wid * 32) * 2048 + h * 512 + vc * 128, 2048, lane, r32, hi);
            if (vc < 3) XS_WRITE_V((vc + 1) & 1);
            __syncthreads();
        }
#undef XS_LOAD
#undef XS_WRITE_K
#undef XS_WRITE_V
    }
}


constexpr int GL_CUM = 0, GL_QD = 32768, GL_KI = 49152, GL_KS = 32768, GL_V = 65536, GL_BLR = 98304;
__device__ __forceinline__ fa::s16x4 tr_read_dyn(int addr) { fa::s16x4 r; asm volatile("ds_read_b64_tr_b16 %0, %1" : "=&v"(r) : "v"(addr) : "memory"); return r; }
#define GL_PK(L, H) (fa::bf16x8){L[0], L[1], L[2], L[3], H[0], H[1], H[2], H[3]}
struct GlaPre { unsigned short b0, b1; };
__device__ __forceinline__ GlaPre gla_blr_load(const bf16* Z, size_t m0, int tid) {
    GlaPre p; p.b0 = *(const unsigned short*)(Z + (m0 + (tid >> 4)) * NABC + ZC_BLR + (tid & 15)); p.b1 = *(const unsigned short*)(Z + (m0 + 32 + (tid >> 4)) * NABC + ZC_BLR + (tid & 15)); return p; }
__device__ __forceinline__ void gla_cum(LAS unsigned char* lds, const GlaPre pre, const float (&wa)[16], const float ba, int tid) {
    LAS float* cum = (LAS float*)(lds + GL_CUM); LAS float* blr = (LAS float*)(lds + GL_BLR); LAS float* tot = blr + 1024;
    blr[tid] = __uint_as_float((unsigned)pre.b0 << 16); blr[tid + 512] = __uint_as_float((unsigned)pre.b1 << 16);
    const int k = tid & 127, q = tid >> 7;
    __syncthreads();
    float c[16]; float run = 0.f;
#pragma unroll
    for (int i2 = 0; i2 < 16; i2 += 4) {
        f32x4 bb[16];
#pragma unroll
        for (int e = 0; e < 16; ++e) bb[e] = *(const LAS f32x4*)(blr + (16 * q + i2 + (e >> 2)) * 16 + 4 * (e & 3));
        asm volatile("" : "+v"(bb[0]), "+v"(bb[1]), "+v"(bb[2]), "+v"(bb[3]), "+v"(bb[4]), "+v"(bb[5]), "+v"(bb[6]), "+v"(bb[7]), "+v"(bb[8]), "+v"(bb[9]), "+v"(bb[10]), "+v"(bb[11]), "+v"(bb[12]), "+v"(bb[13]), "+v"(bb[14]), "+v"(bb[15]) :: "memory");
#pragma unroll
        for (int ii = 0; ii < 4; ++ii) { float x = ba;
#pragma unroll
            for (int j4 = 0; j4 < 4; ++j4) { const f32x4 b4 = bb[ii * 4 + j4]; x += b4.x * wa[4 * j4] + b4.y * wa[4 * j4 + 1] + b4.z * wa[4 * j4 + 2] + b4.w * wa[4 * j4 + 3]; }
            const float ls = fminf(x, 0.f) - 0.6931471805599453f * __builtin_amdgcn_logf(1.0f + __builtin_amdgcn_exp2f(-1.4426950408889634f * fabsf(x)));
            run += ls * (1.0f / 16.0f); c[i2 + ii] = run; } }
    tot[q * 128 + k] = run;
    __syncthreads();
    float off = 0.f;
#pragma unroll
    for (int qq = 0; qq < 3; ++qq) off += (qq < q) ? tot[qq * 128 + k] : 0.f;
#pragma unroll
    for (int i = 0; i < 16; ++i) cum[(16 * q + i) * 128 + k] = c[i] + off;
    __syncthreads();
}
__device__ __forceinline__ void gla_alpha_load(float (&wa)[16], float& ba, const float* w_alpha, const float* b_alpha, int h, int tid) {
    const int k = tid & 127;
#pragma unroll
    for (int j = 0; j < 16; ++j) wa[j] = w_alpha[j * 512 + h * 128 + k];
    ba = b_alpha[h * 128 + k];
}
struct GlaV { v4u w[4]; };
__device__ __forceinline__ GlaV gla_load_v(const bf16* Z, size_t m0, int h, int tid) {
    GlaV v;
#pragma unroll
    for (int i = 0; i < 4; ++i) { const int piece = tid + 512 * i, t = piece >> 5, cc = (piece & 31) * 8; v.w[i] = *(const v4u*)(Z + (m0 + t) * NABC + ZC_BV + h * 256 + cc); }
    return v; }
__device__ __forceinline__ void gla_write_v(LAS unsigned char* lds, const GlaV& v, int tid) {
#pragma unroll
    for (int i = 0; i < 4; ++i) { const int piece = tid + 512 * i, t = piece >> 5, cc = (piece & 31) * 8; *(LAS v4u*)(lds + GL_V + (cc >> 7) * 16384 + fa::v_st(t, cc & 127)) = v.w[i]; }
}
__device__ __forceinline__ void gla_g1(LAS unsigned char* lds, const bf16* Z, bf16* ST, float* DEC, const GlaPre pre, const float (&wa)[16], const float ba, int item, int tid) {
    using namespace fa;
    asm volatile("" : "+v"(tid));
    const int wid = __builtin_amdgcn_readfirstlane(tid >> 6), lane = tid & 63, r32 = lane & 31, hf = lane >> 5;
    const int bh = item >> 6, n = item & 63, b = bh >> 2, h = bh & 3; const size_t m0 = (size_t)b * SEQ + 64 * n;
    v4u kraw[2];
#pragma unroll
    for (int i = 0; i < 2; ++i) { const int t = (tid >> 4) + 32 * i, kc = (tid & 15) * 8; kraw[i] = *(const v4u*)(Z + (m0 + t) * NABC + ZC_BK + h * 128 + kc); }
    const GlaV vraw = gla_load_v(Z, m0, h, tid);
    gla_cum(lds, pre, wa, ba, tid);
    const LAS float* cum = (const LAS float*)(lds + GL_CUM);
#pragma unroll
    for (int i = 0; i < 2; ++i) { const int t = (tid >> 4) + 32 * i, kc = (tid & 15) * 8;
        const v4u kw = kraw[i];
        const f32x4 c0 = *(const LAS f32x4*)(cum + t * 128 + kc), c1 = *(const LAS f32x4*)(cum + t * 128 + kc + 4), l0 = *(const LAS f32x4*)(cum + 63 * 128 + kc), l1 = *(const LAS f32x4*)(cum + 63 * 128 + kc + 4);
        v4u o; o.x = pk2(bflo(kw.x) * __expf(l0.x - c0.x), bfhi(kw.x) * __expf(l0.y - c0.y)); o.y = pk2(bflo(kw.y) * __expf(l0.z - c0.z), bfhi(kw.y) * __expf(l0.w - c0.w));
        o.z = pk2(bflo(kw.z) * __expf(l1.x - c1.x), bfhi(kw.z) * __expf(l1.y - c1.y)); o.w = pk2(bflo(kw.w) * __expf(l1.z - c1.z), bfhi(kw.w) * __expf(l1.w - c1.w));
        *(LAS v4u*)(lds + GL_KS + v_st(t, kc)) = o; }
    gla_write_v(lds, vraw, tid);
    if (tid < 128) DEC[(size_t)item * 128 + tid] = __expf(cum[63 * 128 + tid]);
    __syncthreads();
    f32x16 acc[4];
#pragma unroll
    for (int kt = 0; kt < 4; ++kt)
#pragma unroll
        for (int r = 0; r < 16; ++r) acc[kt][r] = 0.f;
    const int rb = v_rd_base(lane); const int vbV = (int)(uintptr_t)(lds + GL_V) + (wid >> 2) * 16384 + rb, vbK = (int)(uintptr_t)(lds + GL_KS) + rb;
#pragma unroll
    for (int ks = 0; ks < 4; ++ks) {
        s16x4 bl = tr_read_dyn(vbV + v_rd_off(wid & 3, ks, 0)), bhh = tr_read_dyn(vbV + v_rd_off(wid & 3, ks, 1));
        s16x4 al[4], ah[4];
#pragma unroll
        for (int kt = 0; kt < 4; ++kt) { al[kt] = tr_read_dyn(vbK + v_rd_off(kt, ks, 0)); ah[kt] = tr_read_dyn(vbK + v_rd_off(kt, ks, 1)); }
        asm volatile("s_waitcnt lgkmcnt(0)" : "+v"(bl), "+v"(bhh), "+v"(al[0]), "+v"(ah[0]), "+v"(al[1]), "+v"(ah[1]), "+v"(al[2]), "+v"(ah[2]), "+v"(al[3]), "+v"(ah[3]) :: "memory"); FA_SBAR();
#pragma unroll
        for (int kt = 0; kt < 4; ++kt) acc[kt] = __builtin_amdgcn_mfma_f32_32x32x16_bf16(GL_PK(al[kt], ah[kt]), GL_PK(bl, bhh), acc[kt], 0, 0, 0);
    }
    bf16* stp = ST + ((size_t)item * 256 + 32 * wid + r32) * 128 + 4 * hf;
#pragma unroll
    for (int kt = 0; kt < 4; ++kt)
#pragma unroll
        for (int g = 0; g < 4; ++g) { v2u w; w.x = pk2(acc[kt][4 * g], acc[kt][4 * g + 1]); w.y = pk2(acc[kt][4 * g + 2], acc[kt][4 * g + 3]); *(v2u*)(stp + 32 * kt + 8 * g) = w; }
    __syncthreads();
}
__device__ __forceinline__ void gla_g2(bf16* ST, const float* DEC, int gid) {
    const int bh = gid >> 13, e = gid & 8191, c = e >> 5, k4 = (e & 31) * 4;
    float s0 = 0.f, s1 = 0.f, s2 = 0.f, s3 = 0.f;
    bf16* p = ST + (((size_t)bh * 64) * 256 + c) * 128 + k4; const float* dp = DEC + (size_t)bh * 64 * 128 + k4;
#pragma unroll 8
    for (int n = 0; n < 64; ++n) {
        const v2u d = *(const v2u*)(p + (size_t)n * 256 * 128); const f32x4 dc = *(const f32x4*)(dp + n * 128);
        v2u w; w.x = pk2(s0, s1); w.y = pk2(s2, s3); *(v2u*)(p + (size_t)n * 256 * 128) = w;
        s0 = dc.x * s0 + bflo(d.x); s1 = dc.y * s1 + bfhi(d.x); s2 = dc.z * s2 + bflo(d.y); s3 = dc.w * s3 + bfhi(d.y); }
}
__device__ __forceinline__ void gla_g3(LAS unsigned char* lds, const bf16* Z, const bf16* ST, bf16* Oabc, const GlaPre pre, const float (&wa)[16], const float ba, const float* gla_norm, int item, int tid) {
    using namespace fa;
    asm volatile("" : "+v"(tid));
    const int wid = __builtin_amdgcn_readfirstlane(tid >> 6), lane = tid & 63, r32 = lane & 31, hf = lane >> 5;
    const int bh = item >> 6, n = item & 63, b = bh >> 2, h = bh & 3; const size_t m0 = (size_t)b * SEQ + 64 * n;
    v4u qraw[2], kraw[2];
#pragma unroll
    for (int i = 0; i < 2; ++i) { const int t = (tid >> 4) + 32 * i, kc = (tid & 15) * 8;
        qraw[i] = *(const v4u*)(Z + (m0 + t) * NABC + ZC_BQ + h * 128 + kc); kraw[i] = *(const v4u*)(Z + (m0 + t) * NABC + ZC_BK + h * 128 + kc); }
    const GlaV vraw = gla_load_v(Z, m0, h, tid);
    gla_cum(lds, pre, wa, ba, tid);
    const LAS float* cum = (const LAS float*)(lds + GL_CUM);
    const float qscale = 0.08838834764831845f;
#pragma unroll
    for (int i = 0; i < 2; ++i) { const int t = (tid >> 4) + 32 * i, kc = (tid & 15) * 8;
        const v4u qw = qraw[i], kw = kraw[i];
        const f32x4 c0 = *(const LAS f32x4*)(cum + t * 128 + kc), c1 = *(const LAS f32x4*)(cum + t * 128 + kc + 4);
        const float e[8] = {__expf(c0.x), __expf(c0.y), __expf(c0.z), __expf(c0.w), __expf(c1.x), __expf(c1.y), __expf(c1.z), __expf(c1.w)};
        const float ei[8] = {__expf(-c0.x), __expf(-c0.y), __expf(-c0.z), __expf(-c0.w), __expf(-c1.x), __expf(-c1.y), __expf(-c1.z), __expf(-c1.w)};
        v4u qo, ko;
        qo.x = pk2(bflo(qw.x) * qscale * e[0], bfhi(qw.x) * qscale * e[1]); qo.y = pk2(bflo(qw.y) * qscale * e[2], bfhi(qw.y) * qscale * e[3]);
        qo.z = pk2(bflo(qw.z) * qscale * e[4], bfhi(qw.z) * qscale * e[5]); qo.w = pk2(bflo(qw.w) * qscale * e[6], bfhi(qw.w) * qscale * e[7]);
        ko.x = pk2(bflo(kw.x) * ei[0], bfhi(kw.x) * ei[1]); ko.y = pk2(bflo(kw.y) * ei[2], bfhi(kw.y) * ei[3]);
        ko.z = pk2(bflo(kw.z) * ei[4], bfhi(kw.z) * ei[5]); ko.w = pk2(bflo(kw.w) * ei[6], bfhi(kw.w) * ei[7]);
        *(LAS v4u*)(lds + GL_QD + KSWZ256(t, kc * 2)) = qo; *(LAS v4u*)(lds + GL_KI + KSWZ256(t, kc * 2)) = ko; }
    gla_write_v(lds, vraw, tid);
    __syncthreads();
    const int ri = wid & 1, cq = wid >> 1;
    bf16x8 qf[8];
#pragma unroll
    for (int d0 = 0; d0 < 8; ++d0) qf[d0] = *(const LAS bf16x8*)(lds + GL_QD + KSWZ256(32 * ri + r32, (d0 * 16 + hf * 8) * 2));
    bf16x8 sfr[2][8];
#pragma unroll
    for (int dd = 0; dd < 2; ++dd) { const bf16* sp = ST + ((size_t)item * 256 + 64 * cq + 32 * dd + r32) * 128 + hf * 8;
#pragma unroll
        for (int d0 = 0; d0 < 8; ++d0) sfr[dd][d0] = *(const bf16x8*)(sp + d0 * 16); }
    f32x16 p0, p1;
#pragma unroll
    for (int r = 0; r < 16; ++r) { p0[r] = 0.f; p1[r] = 0.f; }
#pragma unroll
    for (int d0 = 0; d0 < 8; ++d0) {
        const bf16x8 a0 = *(const LAS bf16x8*)(lds + GL_KI + KSWZ256(r32, (d0 * 16 + hf * 8) * 2)), a1 = *(const LAS bf16x8*)(lds + GL_KI + KSWZ256(32 + r32, (d0 * 16 + hf * 8) * 2));
        p0 = __builtin_amdgcn_mfma_f32_32x32x16_bf16(a0, qf[d0], p0, 0, 0, 0);
        p1 = __builtin_amdgcn_mfma_f32_32x32x16_bf16(a1, qf[d0], p1, 0, 0, 0); }
    { const int irow = 32 * ri + r32;
#pragma unroll
      for (int r = 0; r < 16; ++r) { const int j = crow(r, hf); if (j > irow) p0[r] = 0.f; if (32 + j > irow) p1[r] = 0.f; } }
    bf16x8 pa0, pa1, pa2, pa3;
    FA_PK4(p0, 0, pa0); FA_PK4(p0, 8, pa1); FA_PK4(p1, 0, pa2); FA_PK4(p1, 8, pa3);
    f32x16 o[2];
#pragma unroll
    for (int r = 0; r < 16; ++r) { o[0][r] = 0.f; o[1][r] = 0.f; }
    const int vb = (int)(uintptr_t)(lds + GL_V) + (cq >> 1) * 16384 + v_rd_base(lane);
#pragma unroll
    for (int dd = 0; dd < 2; ++dd) { const int d0v = 2 * (cq & 1) + dd;
        s16x4 l0 = tr_read_dyn(vb + v_rd_off(d0v, 0, 0)), h0 = tr_read_dyn(vb + v_rd_off(d0v, 0, 1)), l1 = tr_read_dyn(vb + v_rd_off(d0v, 1, 0)), h1 = tr_read_dyn(vb + v_rd_off(d0v, 1, 1));
        s16x4 l2 = tr_read_dyn(vb + v_rd_off(d0v, 2, 0)), h2 = tr_read_dyn(vb + v_rd_off(d0v, 2, 1)), l3 = tr_read_dyn(vb + v_rd_off(d0v, 3, 0)), h3 = tr_read_dyn(vb + v_rd_off(d0v, 3, 1));
        asm volatile("s_waitcnt lgkmcnt(0)" : "+v"(l0), "+v"(h0), "+v"(l1), "+v"(h1), "+v"(l2), "+v"(h2), "+v"(l3), "+v"(h3) :: "memory"); FA_SBAR();
        o[dd] = __builtin_amdgcn_mfma_f32_32x32x16_bf16(pa0, GL_PK(l0, h0), o[dd], 0, 0, 0);
        o[dd] = __builtin_amdgcn_mfma_f32_32x32x16_bf16(pa1, GL_PK(l1, h1), o[dd], 0, 0, 0);
        o[dd] = __builtin_amdgcn_mfma_f32_32x32x16_bf16(pa2, GL_PK(l2, h2), o[dd], 0, 0, 0);
        o[dd] = __builtin_amdgcn_mfma_f32_32x32x16_bf16(pa3, GL_PK(l3, h3), o[dd], 0, 0, 0); }
#pragma unroll
    for (int dd = 0; dd < 2; ++dd) {
#pragma unroll
        for (int d0 = 0; d0 < 8; ++d0) o[dd] = __builtin_amdgcn_mfma_f32_32x32x16_bf16(qf[d0], sfr[dd][d0], o[dd], 0, 0, 0); }
    __syncthreads();
    LAS float* Ol = (LAS float*)lds;
#pragma unroll
    for (int dd = 0; dd < 2; ++dd)
#pragma unroll
        for (int r = 0; r < 16; ++r) Ol[(32 * ri + crow(r, hf)) * 256 + 64 * cq + 32 * dd + r32] = o[dd][r];
    __syncthreads();
    { const f32x4 gn = *(const f32x4*)(gla_norm + h * 256 + 4 * lane);
      v2u rw[8]; f32x4 ov[8]; float ss[8];
#pragma unroll
      for (int j = 0; j < 8; ++j) { const int t = wid + NWAVES * j; rw[j] = *(const v2u*)(Z + (m0 + t) * NABC + ZC_BR + h * 256 + 4 * lane); ov[j] = *(const LAS f32x4*)(Ol + t * 256 + 4 * lane); }
      asm volatile("" : "+v"(ov[0]), "+v"(ov[1]), "+v"(ov[2]), "+v"(ov[3]), "+v"(ov[4]), "+v"(ov[5]), "+v"(ov[6]), "+v"(ov[7]) :: "memory");
#pragma unroll
      for (int j = 0; j < 8; ++j) ss[j] = (ov[j].x * ov[j].x + ov[j].y * ov[j].y) + (ov[j].z * ov[j].z + ov[j].w * ov[j].w);
#pragma unroll
      for (int j = 0; j < 8; ++j) ss[j] = wave_sum(ss[j]);
#pragma unroll
      for (int j = 0; j < 8; ++j) { const int t = wid + NWAVES * j; const float rstd = 1.0f / sqrtf(ss[j] * (1.f / 256.f) + EPS);
          const float r0 = bflo(rw[j].x), r1 = bfhi(rw[j].x), r2 = bflo(rw[j].y), r3 = bfhi(rw[j].y);
          v2u w; w.x = pk2(ov[j].x * rstd * gn.x * (r0 * __builtin_amdgcn_rcpf(1.0f + __expf(-r0))), ov[j].y * rstd * gn.y * (r1 * __builtin_amdgcn_rcpf(1.0f + __expf(-r1))));
          w.y = pk2(ov[j].z * rstd * gn.z * (r2 * __builtin_amdgcn_rcpf(1.0f + __expf(-r2))), ov[j].w * rstd * gn.w * (r3 * __builtin_amdgcn_rcpf(1.0f + __expf(-r3))));
          *(v2u*)(Oabc + (m0 + t) * 3072 + 1024 + h * 256 + 4 * lane) = w; } }
    __syncthreads();
}


constexpr int ABIAS_OFF = XSCR_OFF, ASCR_OFF = XSCR_OFF + 12416;
template <int PASS>
__device__ __forceinline__ void attn_a_pass(LAS unsigned char* lds_all, const bf16* ZA, bf16* Oabc, float* ML, const float* rel_bias, int gw, int ngw, int xcd, int inx, int tid) {
    using namespace fa;
    asm volatile("" : "+v"(tid));
    const int wid = __builtin_amdgcn_readfirstlane(tid >> 6);
    constexpr float SCALE = 0.08838834764831845f, C = SCALE * 1.4426950408889634f, THRS = 8.0f / SCALE;
    constexpr int RSTR = (PASS == 1) ? 1 : 16;
    LAS float* tab = (LAS float*)(lds_all + ABIAS_OFF);
    const bool per_head = (ngw % 64 == 0);
    const int h_lo = per_head ? xcd : 0, h_hi = per_head ? h_lo + 1 : 8;
    const int wih = per_head ? (inx * 8 + wid) : gw, nwh = per_head ? (ngw >> 3) : ngw;
    LAS float* wsf = (LAS float*)(lds_all + ASCR_OFF) + wid * 64; LAS float* li_l = wsf; LAS float* al_l = wsf + 32;
    LAS unsigned char* Vl = lds_all + wid * 16384;
#pragma unroll 1
    for (int h = h_lo; h < h_hi; ++h) {
    __syncthreads();
    for (int i = wid * 64 + lane_id_now(); i < 3 * 512; i += NWAVES * 64) { const int g = i >> 9, d = (i & 511) - 192;
        tab[i] = (d >= 0 && d <= 128) ? rel_bias[t5_bucket(d << (2 * g)) * 8 + h] * (1.0f / SCALE) : -1e30f; }
    __syncthreads();
#pragma unroll 1
    for (int q = wih; q < 512; q += nwh) {
        const int lane = lane_id_now(), r32 = lane & 31, hf = lane >> 5;
    const int vb = (int)(uintptr_t)Vl + v_rd_base(lane);
        const int vkey = lane >> 4, vch = lane & 15, vstb = v_st(vkey, vch * 8);
        const int kst0 = vkey * 256 + ((vch * 16) ^ (vkey << 4));
        const int ka0 = r32 * 256 + ((hf ^ (r32 & 7)) << 4);
        int t0, b, c16 = 0;
        if (PASS == 1) { t0 = 32 * (q & 127); b = q >> 7; }
        else { const int l0 = 32 * (q & 7); c16 = (q >> 3) & 15; b = q >> 7; t0 = c16 + 16 * l0; }
        const bf16* Zb = ZA + (size_t)b * SEQ * NA + h * 128; const char* Zbc = (const char*)Zb;
        bf16* Ob = Oabc + ((size_t)b * SEQ + t0) * 3072 + h * 128;
        float* MLb = ML + ((size_t)b * SEQ + t0) * 16 + h * 2;
        bf16x8 qf[8];
        { const bf16* qp = Zb + (size_t)(t0 + RSTR * r32) * NA + ZA_Q + hf * 8;
#pragma unroll
          for (int d0 = 0; d0 < 8; ++d0) qf[d0] = *(const bf16x8*)(qp + d0 * 16); }
        float m_reg = -1e30f, l_reg = 0.f; f32x16 o[4];
        if (PASS != 2) {
#pragma unroll
            for (int d = 0; d < 4; ++d)
#pragma unroll
                for (int r = 0; r < 16; ++r) o[d][r] = 0.f;
        } else {
            const float2 ml = *(const float2*)(MLb + (size_t)(RSTR * r32) * 16); m_reg = ml.x; l_reg = ml.y;
            if (hf == 0) li_l[r32] = l_reg;
            asm volatile("s_waitcnt lgkmcnt(0)" ::: "memory");
            unsigned short ob[4][16];
#pragma unroll
            for (int r = 0; r < 16; ++r) {
                const char* rowp = (const char*)(Ob + (size_t)(RSTR * ((r & 3) + 8 * (r >> 2))) * 3072);
                const unsigned lo = (unsigned)((RSTR * 4 * hf * 3072 + r32) * 2);
#pragma unroll
                for (int d = 0; d < 4; ++d) ob[d][r] = *(const unsigned short*)(rowp + lo + 64 * d); }
#pragma unroll
            for (int d = 0; d < 4; ++d)
                asm volatile("" : "+v"(ob[d][0]), "+v"(ob[d][1]), "+v"(ob[d][2]), "+v"(ob[d][3]), "+v"(ob[d][4]), "+v"(ob[d][5]), "+v"(ob[d][6]), "+v"(ob[d][7]), "+v"(ob[d][8]), "+v"(ob[d][9]), "+v"(ob[d][10]), "+v"(ob[d][11]), "+v"(ob[d][12]), "+v"(ob[d][13]), "+v"(ob[d][14]), "+v"(ob[d][15]) :: "memory");
#pragma unroll
            for (int r = 0; r < 16; ++r) { const float lr = li_l[crow(r, hf)];
#pragma unroll
                for (int d = 0; d < 4; ++d) o[d][r] = __uint_as_float((unsigned)ob[d][r] << 16) * lr; }
        }
#pragma unroll 1
        for (int g = (PASS == 2 ? 1 : 0); g < (PASS == 1 ? 1 : 3); ++g) {
            const int sh = 2 * g, sigma = RSTR >> sh, cls = c16 & ((1 << sh) - 1), base = ((t0 - cls) >> sh) - 128, ntile = (31 * sigma + 192) >> 6;
            const LAS float* tg = tab + g * 512;
            v4u kc[16];
#define AA_LOADKC(tile_) do { _Pragma("unroll") for (int i_ = 0; i_ < 16; ++i_) { int tk = cls + ((base + (tile_) * 64 + 4 * i_ + vkey) << sh); tk = tk < 0 ? 0 : (tk > SEQ - 1 ? SEQ - 1 : tk); \
                    kc[i_] = *(const v4u*)(Zbc + (unsigned)tk * (NA * 2) + (ZA_K + vch * 8) * 2); } } while (0)
#define AA_WRITEKC() do { _Pragma("unroll") for (int i_ = 0; i_ < 16; ++i_) *(LAS v4u*)(Vl + i_ * 1024 + ((i_ & 1) ? (kst0 ^ 64) : kst0)) = kc[i_]; } while (0)
            AA_LOADKC(0); AA_WRITEKC();
#pragma unroll 1
            for (int tile = 0; tile < ntile; ++tile) {
#define AA_LOADV(vv_, i0_) do { _Pragma("unroll") for (int i_ = 0; i_ < 8; ++i_) { int tk = cls + ((base + tile * 64 + 4 * ((i0_) + i_) + vkey) << sh); tk = tk < 0 ? 0 : (tk > SEQ - 1 ? SEQ - 1 : tk); \
                    vv_[i_] = *(const v4u*)(Zbc + (unsigned)tk * (NA * 2) + (ZA_V + vch * 8) * 2); } } while (0)
#define AA_WRITEV(vv_, i0_) do { _Pragma("unroll") for (int i_ = 0; i_ < 8; ++i_) { const int i = (i0_) + i_; *(LAS v4u*)(Vl + vstb + ((i & 1) + 2 * (i >> 2)) * 2048 + ((i >> 1) & 1) * 256) = vv_[i_]; } } while (0)
                v4u va[8];
                AA_LOADV(va, 0);
                FA_SBAR();
                f32x16 p0, p1;
#pragma unroll
                for (int r = 0; r < 16; ++r) { p0[r] = 0.f; p1[r] = 0.f; }
#pragma unroll
                for (int d0 = 0; d0 < 8; ++d0) { const bf16x8 b0 = *(const LAS bf16x8*)(Vl + (ka0 ^ (32 * (d0 & 3))) + (d0 >> 2) * 128), b1 = *(const LAS bf16x8*)(Vl + (ka0 ^ (32 * (d0 & 3))) + (d0 >> 2) * 128 + 8192);
                    p0 = __builtin_amdgcn_mfma_f32_32x32x16_bf16(b0, qf[d0], p0, 0, 0, 0); p1 = __builtin_amdgcn_mfma_f32_32x32x16_bf16(b1, qf[d0], p1, 0, 0, 0); }
                asm volatile("s_waitcnt lgkmcnt(0)" ::: "memory"); FA_SBAR();
                AA_WRITEV(va, 0);
                v4u vbq[8];
                AA_LOADV(vbq, 8);
                FA_SBAR();
                { const int dq = sigma * r32 + 128 - tile * 64, sb = base + tile * 64;
                  const LAS float* tl = tg + (dq + 192 - 4 * hf - 59);
                  float tb0[16], tb1[16];
#pragma unroll
                  for (int r = 0; r < 16; ++r) { const int rc = (r & 3) + 8 * (r >> 2); tb0[r] = tl[59 - rc]; tb1[r] = tl[27 - rc]; }
                  asm volatile("" : "+v"(tb0[0]), "+v"(tb0[1]), "+v"(tb0[2]), "+v"(tb0[3]), "+v"(tb0[4]), "+v"(tb0[5]), "+v"(tb0[6]), "+v"(tb0[7]), "+v"(tb0[8]), "+v"(tb0[9]), "+v"(tb0[10]), "+v"(tb0[11]), "+v"(tb0[12]), "+v"(tb0[13]), "+v"(tb0[14]), "+v"(tb0[15]) :: "memory");
                  asm volatile("" : "+v"(tb1[0]), "+v"(tb1[1]), "+v"(tb1[2]), "+v"(tb1[3]), "+v"(tb1[4]), "+v"(tb1[5]), "+v"(tb1[6]), "+v"(tb1[7]), "+v"(tb1[8]), "+v"(tb1[9]), "+v"(tb1[10]), "+v"(tb1[11]), "+v"(tb1[12]), "+v"(tb1[13]), "+v"(tb1[14]), "+v"(tb1[15]) :: "memory");
#pragma unroll
                  for (int r = 0; r < 16; ++r) { p0[r] += tb0[r]; p1[r] += tb1[r]; }
                  if (sb < 0) {
#pragma unroll
                      for (int r = 0; r < 16; ++r) { const int s = crow(r, hf); if (sb + s < 0) p0[r] = -1e30f; if (sb + s + 32 < 0) p1[r] = -1e30f; } } }
                float mn, alpha; partialSM(p0, p1, m_reg, mn, alpha, C, THRS);
                FA_RESC(alpha, o, al_l, r32, hf);
                bf16x8 pa0, pa1, pa2, pa3; finishSM(p0, p1, alpha, l_reg, pa0, pa1, pa2, pa3); FA_SBAR();
                AA_WRITEV(vbq, 8);
                asm volatile("s_waitcnt lgkmcnt(0)" ::: "memory"); FA_SBAR();
                { const int tn = (tile + 1 < ntile) ? tile + 1 : tile; AA_LOADKC(tn); }
                FA_SBAR();
                pv_d0(o, vb, pa0, pa1, pa2, pa3);
                FA_SBAR();
                if (tile + 1 < ntile) AA_WRITEKC();
            }
#undef AA_LOADKC
#undef AA_WRITEKC
#undef AA_LOADV
#undef AA_WRITEV
        }
        if (hf == 0) li_l[r32] = l_reg;
        asm volatile("s_waitcnt lgkmcnt(0)" ::: "memory");
        float rli[16];
#pragma unroll
        for (int r = 0; r < 16; ++r) rli[r] = __builtin_amdgcn_rcpf(li_l[crow(r, hf)]);
        store_o_bf16(o, rli, Ob, RSTR * 3072, lane, r32, hf);
        if (PASS == 1 && hf == 0) *(float2*)(MLb + (size_t)r32 * 16) = make_float2(m_reg, l_reg);
    }
    }
    __syncthreads();
}

__device__ __forceinline__ void group_barrier(unsigned* cnt, const unsigned target, const bool release, const bool thread0) {
    asm volatile("s_waitcnt vmcnt(0)" ::: "memory");
    __syncthreads();
    if (thread0) {
        asm volatile("" : "+s"(cnt));
        if (release) { __builtin_amdgcn_fence(__ATOMIC_RELEASE, "agent"); asm volatile("s_waitcnt vmcnt(0)" ::: "memory"); }
        (void)xb_add(cnt, 1u);
        for (unsigned sp = 0; xb_ld(cnt) < target && sp < XB_SPIN_CAP; ++sp) __builtin_amdgcn_s_sleep(1);
        __builtin_amdgcn_fence(__ATOMIC_ACQUIRE, "agent");
        asm volatile("s_waitcnt vmcnt(0)" ::: "memory");
    }
    __syncthreads();
}

__global__ void __launch_bounds__(NWAVES * 64, 2) fwd_kernel(Args args) {
    extern __shared__ __attribute__((aligned(16))) unsigned char lds_raw[];
    LAS unsigned char* lds = (LAS unsigned char*)lds_raw;
    volatile LAS unsigned* MISC = (volatile LAS unsigned*)(lds + MISC_OFF);
    const int tid0 = threadIdx.x;
    const int wave0 = __builtin_amdgcn_readfirstlane(tid0 >> 6);
    const int G = gridDim.x, bx = blockIdx.x;
    const int vcu = (G % 8 == 0) ? (bx % 8) * (G / 8) + bx / 8 : bx;
    const int ngw = G * NWAVES;
#define PHASE_LOCALS unsigned long long wsu_ = (unsigned long long)ws0; asm volatile("" : "+s"(wsu_)); unsigned char* ws = (unsigned char*)(GAS unsigned char*)wsu_; unsigned long long xou_ = (unsigned long long)xo0; asm volatile("" : "+s"(xou_)); float* xo = (float*)(GAS float*)xou_; BODY_LOCALS
    unsigned char* const ws0 = args.ws;
    for (int u = tid0; u < (LDS_BYTES - LDSCTL_OFF) / 4; u += NWAVES * 64) ((LAS unsigned*)(lds + LDSCTL_OFF))[u] = 0u;
    __syncthreads();
    LAS unsigned long long* PTAB = (LAS unsigned long long*)(lds + PTAB_OFF);
    if (tid0 == 0) {
#define PT(k) PTAB[k] = (unsigned long long)args.in[k];
        PT(0) PT(1) PT(2) PT(3) PT(4) PT(5) PT(6) PT(7) PT(8) PT(9) PT(10) PT(11) PT(12) PT(13) PT(14) PT(15) PT(16) PT(17) PT(18) PT(19) PT(20) PT(21) PT(22) PT(23) PT(24) PT(25) PT(26)
#undef PT
    }
    __syncthreads();
#if MK_ONE_LAUNCH
    { const XcdBarrier bar0 = xcd_barrier_post((unsigned*)(ws0 + WS_CTL) + CW_BAR, MISC + 8);
      unsigned* xp = (unsigned*)(ws0 + WS_CTL) + CW_XID + bx; unsigned xv = bar0.x + 1u; asm volatile("" : "+s"(xp), "+s"(xv));
      if (tid0 == 0) *xp = xv; }
#define GRID_BAR() do { XcdBarrier bar_; bar_.bar = (unsigned*)(ws0 + WS_CTL) + CW_BAR; bar_.x = xb_xcc_id(); bar_.st = MISC + 8; xcd_barrier(bar_, wave0 == 0 && lane_id_now() == 0); } while (0)
#define GROUP_SEAM(k, idx) do { if (IN(k) && IN((k) + 1)) { const bool g4_ = (G == 256); \
        group_barrier((unsigned*)(ws0 + WS_CTL) + CW_GRP + (g4_ ? 32 * (bx & 63) : 0), (g4_ ? 4u : (unsigned)G) * (unsigned)(5 * l + (idx) + 1), MISC[16] == 0u, wave0 == 0 && lane_id_now() == 0); } } while (0)
#else
#define GRID_BAR() do { } while (0)
#define GROUP_SEAM(k, idx) do { } while (0)
#endif
#if !MK_ONE_LAUNCH
    const int lo = args.ph_lo, hi = args.ph_hi;
#endif
#if MK_ONE_LAUNCH
#define IN(k) true
#else
#define IN(k) (lo <= (k) && (k) < hi)
#endif
#define SEAM(k) do { if (IN(k) && IN((k) + 1)) GRID_BAR(); } while (0)

    float* const xo0 = args.out;
#define INP(k) ldptr(PTAB, (k))
#define WSP(off) ((bf16*)(ws + (off)))
    LAS unsigned char* ring = lds + RING_OFF;
#define BODY_LOCALS int tid = wave0 * 64 + lane_id_now(); const int lane = tid & 63; const int wave = __builtin_amdgcn_readfirstlane(tid >> 6); const int gw = vcu * NWAVES + wave; (void)lane; (void)gw; (void)wave;

#define PANEL_RS(S_, same_) bool same_ = true; { int pm_c_ = -1; pg8::Unit u_; for (int i_ = 0; S_.next(i_, u_); ++i_) { if (u_.br == 3) continue; if (pm_c_ < 0) pm_c_ = u_.pm; else if (u_.pm != pm_c_) same_ = false; } \
        if (same_ && pm_c_ >= 0) { const f32x4* p_ = (const f32x4*)((const float*)(ws + WS_SS) + ((size_t)pm_c_ * 256 + (tid >> 1)) * 32 + (tid & 1) * 16); float s_ = 0.f; \
            _Pragma("unroll") for (int j_ = 0; j_ < 4; ++j_) { const f32x4 v_ = p_[j_]; s_ += (v_[0] + v_[1]) + (v_[2] + v_[3]); } \
            s_ += lane_xor1(s_); if ((tid & 1) == 0) ((LAS float*)(lds + RSL_OFF))[tid >> 1] = 1.0f / sqrtf(s_ * (1.f / 2048.f) + EPS); } \
        __syncthreads(); }
#define RS_FROM_SS() do { const float* ss_ = (const float*)(ws + WS_SS); float* rs_ = (float*)(ws + WS_RS); \
        for (int m_ = 2 * gw + (lane >> 5); m_ < M; m_ += 2 * ngw) { float s_ = ss_[(size_t)m_ * 32 + (lane & 31)]; \
            s_ += __shfl_xor(s_, 1); s_ += __shfl_xor(s_, 2); s_ += __shfl_xor(s_, 4); s_ += __shfl_xor(s_, 8); s_ += __shfl_xor(s_, 16); \
            if ((lane & 31) == 0) rs_[m_] = 1.0f / sqrtf(s_ * (1.f / 2048.f) + EPS); } } while (0)
    for (int l = 0; l < 2; ++l) {
        const int P = l * PH_PER_LAYER;

        if (((PHASE_MASK >> 0) & 1) && IN(P + 0)) for (int rep_ = 0; rep_ < 1 + ((PHASE_TWICE >> 0) & 1); ++rep_) { PHASE_LOCALS
            LAS float* scr = (LAS float*)(ring + wave * 16384);
            const float* w_in = INP(4) + (size_t)l * D * DIN_SRC;
            constexpr int TOT = 32 * 160 + 32 * 32 + 32 * 34 + 32 * 1 + 32 * 192 + 8 * 48 + 8 * 64 + 3 * 16 * 64 + 32 * 64 + 32 * 128 + 32 * 64 + 2 * 32 * 176 + 88 * 64;
#ifndef REP0
#define REP0 1
#endif
#pragma unroll 1
            for (int rep0 = 0; rep0 < REP0; ++rep0)
            for (int it = gw; it < TOT; it += ngw) {
                int r = it;
                if (seg_item<MAP_LIN>(r, w_in, D, DIN_SRC, 0, 5120, WSP(WS_WIN), D, 0, 0, scr, lane, INP(3) + l * D)) continue;
                if (seg_item<MAP_LIN>(r, w_in, D, DIN_SRC, 5136, 1024, WSP(WS_WIN), D, 5120, 0, scr, lane, INP(3) + l * D)) continue;
                if (seg_item<MAP_LIN>(r, w_in, D, DIN_SRC, 6160, 1088, WSP(WS_WIN), D, 6144, 0, scr, lane, INP(3) + l * D)) continue;
                if (seg_item<MAP_LIN>(r, w_in, D, DIN_SRC, 5120, 16, WSP(WS_WIN), D, 7232, 0, scr, lane, INP(3) + l * D)) continue;
                if (seg_item8(r, w_in, D, DIN_SRC, 7248, 6144, ws + WS_W8, scr, lane, INP(3) + l * D)) continue;
                if (seg_item<MAP_LIN>(r, INP(10) + (size_t)l * 512 * 1536, 512, 1536, 0, 1536, WSP(WS_WQB), 512, 0, 0, scr, lane)) continue;
                if (seg_item<MAP_LIN>(r, INP(12) + (size_t)l * 512 * 2048, 512, 2048, 0, 2048, WSP(WS_WKVB), 512, 0, 0, scr, lane)) continue;
                if (seg_item<MAP_LIN>(r, INP(13) + (size_t)l * 1024 * 2048, 1024, 2048, 0, 2048, WSP(WS_WUP), 3072, 0, 0, scr, lane)) continue;
                if (seg_item<MAP_LIN>(r, INP(14) + (size_t)l * 1024 * 2048, 1024, 2048, 0, 2048, WSP(WS_WUP), 3072, 0, 1024, scr, lane)) continue;
                if (seg_item<MAP_LIN>(r, INP(15) + (size_t)l * 1024 * 2048, 1024, 2048, 0, 2048, WSP(WS_WUP), 3072, 0, 2048, scr, lane)) continue;
                if (seg_item<MAP_LIN>(r, INP(16) + (size_t)l * D * D, D, D, 0, D, WSP(WS_WO), D, 0, 0, scr, lane)) continue;
                if (seg_item<MAP_LIN>(r, INP(20) + (size_t)l * D * 4096, D, 4096, 0, 4096, WSP(WS_WXKV), D, 0, 0, scr, lane)) continue;
                if (seg_item<MAP_LIN>(r, INP(21) + (size_t)l * D * D, D, D, 0, D, WSP(WS_WXO), D, 0, 0, scr, lane)) continue;
                if (seg_item<MAP_GATE>(r, INP(23) + (size_t)l * D * DFF, D, DFF, 0, DFF, WSP(WS_WFF), LDW, 0, 0, scr, lane, INP(22) + l * D)) continue;
                if (seg_item<MAP_UP>(r, INP(24) + (size_t)l * D * DFF, D, DFF, 0, DFF, WSP(WS_WFF), LDW, 0, 0, scr, lane, INP(22) + l * D)) continue;
                seg_item<MAP_LIN>(r, INP(25) + (size_t)l * DFF * D, DFF, D, 0, D, WSP(WS_WDN), LDACT, 0, 0, scr, lane);
            }
            { const float* wq = INP(19) + (size_t)l * D * D; const float* gq = INP(17) + l * D;
              for (int i = gw * 64 + lane; i < D * D / 8; i += ngw * 64) { const f32x4 a = *(const f32x4*)(wq + (size_t)i * 8), bq = *(const f32x4*)(wq + (size_t)i * 8 + 4); const float gg = gq[i >> 8];
                  v4u o; o.x = pk2(a.x * gg, a.y * gg); o.y = pk2(a.z * gg, a.w * gg); o.z = pk2(bq.x * gg, bq.y * gg); o.w = pk2(bq.z * gg, bq.w * gg); ((v4u*)WSP(WS_WXQ))[i] = o; } }
            { unsigned zz = 0u; asm volatile("" : "+v"(zz)); for (int i = gw * 64 + lane; i < 176 * D / 8; i += ngw * 64) ((v4u*)(WSP(WS_WIN) + (size_t)7248 * D))[i] = (v4u){zz, zz, zz, zz}; }
            if (l == 0) { for (int m = gw; m < M; m += ngw) gain_row_bf16(INP(0) + (size_t)m * D, INP(3), WSP(WS_H) + (size_t)m * D, (float*)(ws + WS_SS) + (size_t)m * 32, ws + WS_H8 + (size_t)m * 2048, lane); }
            for (int m = gw; m < MROWS; m += ngw) rms_row_bf16(INP(1) + (size_t)m * D, INP(18) + l * D, WSP(WS_MEMN) + (size_t)m * D, lane);
            if (l == 0) for (int i = gw * 64 + lane; i < SEQ * 32; i += ngw * 64) { const int pos = i >> 5, f = i & 31; const float inv = powf(10000.0f, -(float)(2 * f) / 64.0f); const float ang = (float)pos * inv;
                ((float*)(ws + WS_ROPE))[i] = cosf(ang); ((float*)(ws + WS_ROPE) + SEQ * 32)[i] = sinf(ang); }
        }
        SEAM(P + 0);
        if (((PHASE_MASK >> 1) & 1) && IN(P + 1)) for (int rep_ = 0; rep_ < 1 + ((PHASE_TWICE >> 1) & 1); ++rep_) { PHASE_LOCALS
            pg8::Gemm g{WSP(WS_H), WSP(WS_WIN), D, D, D};
            pg8::WinOrder S{G, bx, (long)WS_MEMN - (long)WS_H, (long)WS_WXKV - (long)WS_WIN};
            PANEL_RS(S, same)
            pg8::Gemm g8{(const bf16*)(ws + WS_H8), (const bf16*)(ws + WS_W8) - (size_t)29 * 256 * 1024, 1024, 1024, 1024}; pg8::GateOrder S8{G, bx};
            if (same) { pg8::EpiWin<true> E{WSP(WS_ZA), WSP(WS_ZABC), WSP(WS_ZG), WSP(WS_MEMKV), nullptr, INP(5) + (size_t)l * 3 * D, (const LAS float*)(lds + RSL_OFF)};
                        pg8::gemm_phase<pg8::EpiWin<true>, pg8::WinOrder, true>(ring, g, S, E, tid);
                        E.gsc = F8_GSC; pg8::gemm_phase<pg8::EpiWin<true>, pg8::GateOrder, true, true>(ring, g8, S8, E, tid); }
            else      { pg8::EpiWin<false> E{WSP(WS_ZA), WSP(WS_ZABC), WSP(WS_ZG), WSP(WS_MEMKV), (const float*)(ws + WS_SS), INP(5) + (size_t)l * 3 * D, nullptr};
                        pg8::gemm_phase<pg8::EpiWin<false>, pg8::WinOrder, true>(ring, g, S, E, tid);
                        E.gsc = F8_GSC; pg8::gemm_phase<pg8::EpiWin<false>, pg8::GateOrder, true, true>(ring, g8, S8, E, tid); }
        }
        SEAM(P + 1);
        if (((PHASE_MASK >> 2) & 1) && IN(P + 2)) for (int rep_ = 0; rep_ < 1 + ((PHASE_TWICE >> 2) & 1); ++rep_) { PHASE_LOCALS
            { BODY_LOCALS
              for (int it = vcu; it < 1024; it += G) { float wa[16], ba; gla_alpha_load(wa, ba, INP(6) + (size_t)l * 16 * 512, INP(7) + l * 512, (it >> 6) & 3, tid);
                  const GlaPre cur = gla_blr_load(WSP(WS_ZABC), (size_t)(it >> 8) * SEQ + 64 * (it & 63), tid);
                  gla_g1(ring, WSP(WS_ZABC), ((bf16*)xo), (float*)(ws + WS_GLADEC), cur, wa, ba, it, tid); } }
            { BODY_LOCALS attn_a_pass<1>(ring, WSP(WS_ZA), WSP(WS_OABC), (float*)(ws + WS_AML), INP(2), gw, ngw, bx & 7, bx >> 3, tid); }
            if (rep_ == 0) { BODY_LOCALS mla_prep(WSP(WS_ZABC), INP(9) + l * 512, INP(11) + l * 512, ((float*)(ws + WS_ROPE)), ((float*)(ws + WS_ROPE) + SEQ * 32), gw, ngw, lane); }
        }
        SEAM(P + 2);
        if (((PHASE_MASK >> 3) & 1) && IN(P + 3)) for (int rep_ = 0; rep_ < 1 + ((PHASE_TWICE >> 3) & 1); ++rep_) { PHASE_LOCALS
            { BODY_LOCALS attn_a_pass<2>(ring, WSP(WS_ZA), WSP(WS_OABC), (float*)(ws + WS_AML), INP(2), gw, ngw, bx & 7, bx >> 3, tid); }
            { BODY_LOCALS for (int gid = vcu * (NWAVES * 64) + tid; gid < 16 * 8192; gid += G * NWAVES * 64) gla_g2(((bf16*)xo), (const float*)(ws + WS_GLADEC), gid); }
#define MLAKV_D (((bf16*)xo) + (size_t)32 * 1024 * 1024)
            { BODY_LOCALS pg8::Gemm g{WSP(WS_ZABC) + ZC_CQA, WSP(WS_WQB), NABC, 512, 512};
              pg8::UpOrder S{G, bx, (long)(ZC_CKVA - ZC_CQA) * 2, (long)WS_WKVB - (long)WS_WQB};
              pg8::EpiUp E{WSP(WS_MLAQ), MLAKV_D};
              pg8::gemm_phase<pg8::EpiUp, pg8::UpOrder, true>(ring, g, S, E, tid); }
        }
        SEAM(P + 3);
        if (((PHASE_MASK >> 4) & 1) && IN(P + 4)) for (int rep_ = 0; rep_ < 1 + ((PHASE_TWICE >> 4) & 1); ++rep_) { PHASE_LOCALS
            { BODY_LOCALS
              for (int it = vcu; it < 1024; it += G) { float wa[16], ba; gla_alpha_load(wa, ba, INP(6) + (size_t)l * 16 * 512, INP(7) + l * 512, (it >> 6) & 3, tid);
                  const GlaPre cur = gla_blr_load(WSP(WS_ZABC), (size_t)(it >> 8) * SEQ + 64 * (it & 63), tid);
                  gla_g3(ring, WSP(WS_ZABC), ((bf16*)xo), WSP(WS_OABC), cur, wa, ba, INP(8) + l * 1024, it, tid); } }
        }
        if (((PHASE_MASK >> 5) & 1) && IN(P + 5)) for (int rep_ = 0; rep_ < 1 + ((PHASE_TWICE >> 5) & 1); ++rep_) { PHASE_LOCALS
            { BODY_LOCALS mla_attn_phase(ring, WSP(WS_MLAQ), MLAKV_D, WSP(WS_ZABC), WSP(WS_OABC), ((float*)(ws + WS_ROPE)), ((float*)(ws + WS_ROPE) + SEQ * 32), vcu, G, tid); }
            __syncthreads();
            { BODY_LOCALS pg8::Gemm g2{WSP(WS_MEMKV), WSP(WS_WXQ), 4096, D, 512}; pg8::KwOrder S2{G, bx}; pg8::EpiXW E2{WSP(WS_KW), 0};
              pg8::gemm_phase<pg8::EpiXW, pg8::KwOrder, true>(ring, g2, S2, E2, tid); }
            { BODY_LOCALS pg8::Gemm g3{WSP(WS_WXO), WSP(WS_MEMKV), D, 4096, 512}; pg8::VwOrder S3{G, (bx + 128) % G}; pg8::EpiXW E3{WSP(WS_VW), 1};
              pg8::gemm_phase<pg8::EpiXW, pg8::VwOrder, true>(ring, g3, S3, E3, tid); } }
        SEAM(P + 5);
#if MK_ONE_LAUNCH
        if (l == 0) {
            if (wave0 == 0 && lane_id_now() == 0) { unsigned* xid = (unsigned*)(ws0 + WS_CTL) + CW_XID + (bx & 63); asm volatile("" : "+s"(xid));
                const unsigned x0 = xb_ld(xid), x1 = xb_ld(xid + 64), x2 = xb_ld(xid + 128), x3 = xb_ld(xid + 192);
                MISC[16] = (G == 256 && x0 != 0u && x0 == x1 && x0 == x2 && x0 == x3) ? 1u : 0u; }
            __syncthreads(); }
#endif
        if (((PHASE_MASK >> 6) & 1) && IN(P + 6)) for (int rep_ = 0; rep_ < 1 + ((PHASE_TWICE >> 6) & 1); ++rep_) { PHASE_LOCALS
            pg8::Gemm g{WSP(WS_OABC), WSP(WS_WUP), 3072, 3072, 1024}; pg8::StaticOrder S; S.init(M, D, G, bx, 3, 1024);
            pg8::EpiMerge E{WSP(WS_MERGED), WSP(WS_ZG)};
            pg8::gemm_phase<pg8::EpiMerge, pg8::StaticOrder, true>(ring, g, S, E, tid);
        }
        GROUP_SEAM(P + 6, 0);
        if (((PHASE_MASK >> 7) & 1) && IN(P + 7)) for (int rep_ = 0; rep_ < 1 + ((PHASE_TWICE >> 7) & 1); ++rep_) { PHASE_LOCALS
            pg8::Gemm g{WSP(WS_MERGED), WSP(WS_WO), D, D, D}; pg8::StaticOrder S; S.init(M, D, G, bx);
            pg8::EpiResB E{WSP(WS_H), (float*)(ws + WS_SS)};
            pg8::gemm_phase<pg8::EpiResB, pg8::StaticOrder, false>(ring, g, S, E, tid);
        }
        GROUP_SEAM(P + 7, 1);
        if (((PHASE_MASK >> 9) & 1) && IN(P + 9)) for (int rep_ = 0; rep_ < 1 + ((PHASE_TWICE >> 9) & 1); ++rep_) { PHASE_LOCALS
            pg8::Gemm g{WSP(WS_H), WSP(WS_KW), D, D, D}; pg8::BatchOrder S; S.init(M, 1024, G, bx); S.bstride = (long)1024 * 2048 * 2;
            PANEL_RS(S, same)
            if (same) { pg8::EpiSoftmaxP<true> E{WSP(WS_P), nullptr, (PG8_LAS float*)(lds + XSCR_OFF), (const LAS float*)(lds + RSL_OFF)};
                        pg8::gemm_phase<pg8::EpiSoftmaxP<true>, pg8::BatchOrder, true>(ring, g, S, E, tid); }
            else      { pg8::EpiSoftmaxP<false> E{WSP(WS_P), (const float*)(ws + WS_SS), (PG8_LAS float*)(lds + XSCR_OFF), nullptr};
                        pg8::gemm_phase<pg8::EpiSoftmaxP<false>, pg8::BatchOrder, true>(ring, g, S, E, tid); }
        }
        GROUP_SEAM(P + 9, 2);
        if (((PHASE_MASK >> 11) & 1) && IN(P + 11)) for (int rep_ = 0; rep_ < 1 + ((PHASE_TWICE >> 11) & 1); ++rep_) { PHASE_LOCALS
            pg8::Gemm g{WSP(WS_P), WSP(WS_VW), pg8::LDP, 1024, 1024}; pg8::BatchOrder S; S.init(M, D, G, bx); S.bstride = (long)2048 * 1024 * 2;
            pg8::EpiResB E{WSP(WS_H), (float*)(ws + WS_SS)};
            pg8::gemm_phase<pg8::EpiResB, pg8::BatchOrder, false>(ring, g, S, E, tid);
        }
        GROUP_SEAM(P + 11, 3);
        if (((PHASE_MASK >> 13) & 1) && IN(P + 13)) for (int rep_ = 0; rep_ < 1 + ((PHASE_TWICE >> 13) & 1); ++rep_) { PHASE_LOCALS
            pg8::Gemm g{WSP(WS_H), WSP(WS_WFF), D, LDW, D}; pg8::StaticOrder S; S.init(M, NFF2, G, bx);
            PANEL_RS(S, same)
            if (same) { pg8::EpiSwiGLURS<true> E{WSP(WS_ACT), NG, nullptr, (const LAS float*)(lds + RSL_OFF)};
                        pg8::gemm_phase<pg8::EpiSwiGLURS<true>, pg8::StaticOrder, false>(ring, g, S, E, tid); }
            else      { pg8::EpiSwiGLURS<false> E{WSP(WS_ACT), NG, (const float*)(ws + WS_SS), nullptr};
                        pg8::gemm_phase<pg8::EpiSwiGLURS<false>, pg8::StaticOrder, false>(ring, g, S, E, tid); }
        }
        GROUP_SEAM(P + 13, 4);
        if (((PHASE_MASK >> 14) & 1) && IN(P + 14)) for (int rep_ = 0; rep_ < 1 + ((PHASE_TWICE >> 14) & 1); ++rep_) { PHASE_LOCALS
            pg8::Gemm g{WSP(WS_ACT), WSP(WS_WDN), NG  , LDACT, DFF}; pg8::StaticOrder S; S.init(M, D, G, bx);
            pg8::EpiResB E{WSP(WS_H), (float*)(ws + WS_SS), (l == 0) ? (ws + WS_H8) : nullptr}; pg8::gemm_phase<pg8::EpiResB, pg8::StaticOrder, false>(ring, g, S, E, tid);
        }
        if (l == 0) SEAM(P + 14); else GROUP_SEAM(P + 14, 5);
    }
    if (IN(2 * PH_PER_LAYER)) { PHASE_LOCALS
        const float* gfin = INP(26); f32x4 gv[8];
#pragma unroll
        for (int j = 0; j < 4; ++j) { gv[2 * j] = *(const f32x4*)(gfin + 8 * (lane + 64 * j)); gv[2 * j + 1] = *(const f32x4*)(gfin + 8 * (lane + 64 * j) + 4); }
        const bool g4 = (G == 256) && MK_ONE_LAUNCH;
        int m = g4 ? (256 * (8 * (bx & 7) + ((bx >> 3) & 7)) + 64 * (bx >> 6) + 8 * wave) : gw;
        const int step = g4 ? 1 : ngw, cnt = g4 ? 8 : (M - gw + ngw - 1) / ngw;
        for (int i = 0; i < cnt; ++i, m += step) final_row(WSP(WS_H) + (size_t)m * D, (const float*)(ws + WS_SS) + (size_t)m * 32, gv, xo + (size_t)m * D, lane); }
#undef IN
#undef SEAM
}

extern "C" void kernel_launch(void* const* d_in, const int* in_sizes, int n_in, void* d_out, int out_size, void* d_ws, size_t ws_size, hipStream_t stream) {
    static int grid = 0;
    if (grid == 0) {
        if (n_in != 27 || out_size != M * D || ws_size < WS_END) { fprintf(stderr, "kernel_launch: unexpected shapes (n_in %d out %d ws %zu)\n", n_in, out_size, ws_size); grid = -1; return; }
        int dev = 0, cus = 0, per_cu = 0;
        if (hipGetDevice(&dev) != hipSuccess || hipDeviceGetAttribute(&cus, hipDeviceAttributeMultiprocessorCount, dev) != hipSuccess) { grid = -1; return; }
        if (hipFuncSetAttribute((const void*)fwd_kernel, hipFuncAttributeMaxDynamicSharedMemorySize, LDS_BYTES) != hipSuccess) { grid = -1; return; }
        if (hipOccupancyMaxActiveBlocksPerMultiprocessor(&per_cu, (const void*)fwd_kernel, NWAVES * 64, LDS_BYTES) != hipSuccess || per_cu < 1)
            fprintf(stderr, "kernel_launch: occupancy query reports %d workgroups per CU\n", per_cu);
        (void)hipGetLastError();
        grid = cus;
    }
    if (grid < 0) return;
    if (hipMemsetAsync((char*)d_ws + WS_CTL, 0, CTL_ZERO_BYTES, stream) != hipSuccess) return;
    Args a{};
    for (int i = 0; i < 27; ++i) a.in[i] = (const float*)d_in[i];
    a.out = (float*)d_out; a.ws = (unsigned char*)d_ws;
#if MK_ONE_LAUNCH
    a.ph_lo = 0; a.ph_hi = N_PHASES;
    hipLaunchKernelGGL(fwd_kernel, dim3(grid), dim3(NWAVES * 64), LDS_BYTES, stream, a);
#else
    for (int p = 0; p < N_PHASES; ++p) { a.ph_lo = p; a.ph_hi = p + 1; hipLaunchKernelGGL(fwd_kernel, dim3(grid), dim3(NWAVES * 64), LDS_BYTES, stream, a); }
#endif
}
```

```cpp
#include <hip/hip_runtime.h>
#include <cstdio>
#include <cstdint>

#ifndef A_SINGLE
#define A_SINGLE 0
#endif
#ifndef GLA_NAIVE
#define GLA_NAIVE 0
#endif
#ifndef PHASE_TWICE
#define PHASE_TWICE 0
#endif
#ifndef PHASE_MASK
#define PHASE_MASK 0x7fff
#endif
#ifndef MK_ONE_LAUNCH
#define MK_ONE_LAUNCH 1
#endif

template <int CTRL> __device__ __forceinline__ float dpp_f(float v) { return __uint_as_float((unsigned)__builtin_amdgcn_update_dpp(0, (int)__float_as_uint(v), CTRL, 0xF, 0xF, true)); }
__device__ __forceinline__ float lane_xor1(float v) { return dpp_f<0xB1>(v); }
__device__ __forceinline__ float sum_xor16(float v) { auto r = __builtin_amdgcn_permlane16_swap(__float_as_uint(v), __float_as_uint(v), false, false); return __uint_as_float(r[0]) + __uint_as_float(r[1]); }
__device__ __forceinline__ float sum_xor32(float v) { auto r = __builtin_amdgcn_permlane32_swap(__float_as_uint(v), __float_as_uint(v), false, false); return __uint_as_float(r[0]) + __uint_as_float(r[1]); }
__device__ __forceinline__ float max_xor16(float v) { auto r = __builtin_amdgcn_permlane16_swap(__float_as_uint(v), __float_as_uint(v), false, false); return fmaxf(__uint_as_float(r[0]), __uint_as_float(r[1])); }
__device__ __forceinline__ float max_xor32(float v) { auto r = __builtin_amdgcn_permlane32_swap(__float_as_uint(v), __float_as_uint(v), false, false); return fmaxf(__uint_as_float(r[0]), __uint_as_float(r[1])); }
__device__ __forceinline__ float wave_sum(float v) { v += dpp_f<0xB1>(v); v += dpp_f<0x4E>(v); v += dpp_f<0x141>(v); v += dpp_f<0x140>(v); return sum_xor32(sum_xor16(v)); }
__device__ __forceinline__ float wave_max(float v) { v = fmaxf(v, dpp_f<0xB1>(v)); v = fmaxf(v, dpp_f<0x4E>(v)); v = fmaxf(v, dpp_f<0x141>(v)); v = fmaxf(v, dpp_f<0x140>(v)); return max_xor32(max_xor16(v)); }

namespace pg8 {
#define PG8_LAS __attribute__((address_space(3)))
typedef unsigned short bf16_t;
typedef short bf16x8 __attribute__((ext_vector_type(8)));
typedef float f32x4 __attribute__((ext_vector_type(4)));
typedef int i32x4 __attribute__((ext_vector_type(4)));
typedef int i32x8 __attribute__((ext_vector_type(8)));
typedef unsigned u32x4 __attribute__((ext_vector_type(4)));
typedef unsigned u32x2 __attribute__((ext_vector_type(2)));
constexpr int BM = 256, BK = 64, HALF = 128, HTB = HALF * BK * 2, STAGE_BYTES = 8 * HTB, NXCD = 8, WGM = 8;

__host__ __device__ __forceinline__ int lds_byte(int r, int c) { const int st = (r >> 4) * 2 + (c >> 5), rr = r & 15, cc = c & 31, ob = rr * 64 + cc * 2; return st * 1024 + (ob ^ (((ob >> 9) & 1) << 5)); }
__host__ __device__ __forceinline__ void stage_rc(int b, int& R, int& C) { const int st = b / 1024, sb = b % 1024, swz = sb ^ (((sb >> 9) & 1) << 5); R = (st >> 1) * 16 + swz / 64; C = (st & 1) * 32 + (swz % 64) / 2; }
__host__ __device__ __forceinline__ int perm32(int rho) { const int n = rho >> 4, i = rho & 15; return 8 * (i >> 2) + 4 * n + (i & 3); }

struct Unit { int pm, pn, ka, kb, br; long aoff, boff; };
struct Gemm { const bf16_t* A; const bf16_t* Bt; int lda, ldb, K; };

__device__ __forceinline__ void map_tile(int L, int nM, int nN, int& pm, int& pn) {
    const int nwg = nM * nN; int wgid = L; { const int q = nwg / NXCD, r = nwg % NXCD, xcd = wgid % NXCD, off = wgid / NXCD; wgid = (xcd < r ? xcd * (q + 1) : r * (q + 1) + (xcd - r) * q) + off; }
    const int nig = WGM * nN, gid = wgid / nig, fm = gid * WGM, gsz = (nM - fm) < WGM ? (nM - fm) : WGM;
    pm = fm + ((wgid % nig) % gsz); pn = (wgid % nig) / gsz;
}
struct StaticOrder {
    int nM, nN, nwg, G, c, nbr, kbr;
    __device__ __forceinline__ void init(int M, int N, int G_, int c_, int nbr_ = 1, int kbr_ = 0) { nM = M / BM; nN = N / BM; nwg = nM * nN; G = G_; c = c_; nbr = nbr_; kbr = kbr_; }
    __device__ __forceinline__ bool next(int i, Unit& u) const {
        const int it = i / nbr, br = i - it * nbr;
        const long L = (long)it * G + c; if (L >= nwg) return false;
        map_tile((int)L, nM, nN, u.pm, u.pn); u.br = br; u.ka = br * kbr; u.kb = br * kbr; u.aoff = 0; u.boff = 0; return true;
    }
    __device__ __forceinline__ void a_ready(const Unit&) const {}
    __device__ __forceinline__ void done(const Unit&) const {}
};


struct WinOrder {
    int G, c; long aoff3, boff3;
    __device__ __forceinline__ bool next(int i, Unit& u) const {
        const int L = i * G + c; u.ka = 0; u.kb = 0;
        if (L < 64 * 29) { map_tile(L, 64, 29, u.pm, u.pn); u.br = (u.pn < 12) ? 0 : 1; u.aoff = 0; u.boff = 0; return true; }
        const int j = L - 64 * 29; if (j >= 64) return false;
        u.pm = j >> 4; u.pn = j & 15; u.br = 3; u.aoff = aoff3; u.boff = boff3; return true;
    }
    __device__ __forceinline__ void a_ready(const Unit&) const {}
    __device__ __forceinline__ void done(const Unit&) const {}
};
struct GateOrder {
    int G, c;
    __device__ __forceinline__ bool next(int i, Unit& u) const {
        u.ka = 0; u.kb = 0; u.br = 2; u.aoff = 0; u.boff = 0;
        if (G == 256) {
            const int j = c >> 6, cnt = (j < 2) ? 5 : 7, base = (j == 0) ? 0 : ((j == 1) ? 5 : ((j == 2) ? 10 : 17));
            if (i >= cnt) return false;
            u.pm = 8 * (c & 7) + ((c >> 3) & 7); u.pn = 29 + base + i; return true; }
        const int L = i * G + c; if (L >= 64 * 24) return false;
        map_tile(L, 64, 24, u.pm, u.pn); u.pn += 29; return true; }
    __device__ __forceinline__ void a_ready(const Unit&) const {}
    __device__ __forceinline__ void done(const Unit&) const {}
};
struct UpOrder {
    int G, c; long aoff1, boff1;
    __device__ __forceinline__ bool next(int i, Unit& u) const {
        const int L = i * G + c; u.ka = 0; u.kb = 0;
        if (L < 64 * 6) { map_tile(L, 64, 6, u.pm, u.pn); u.br = 0; u.aoff = 0; u.boff = 0; return true; }
        const int j = L - 64 * 6; if (j >= 64 * 8) return false;
        map_tile(j, 64, 8, u.pm, u.pn); u.br = 1; u.aoff = aoff1; u.boff = boff1; return true;
    }
    __device__ __forceinline__ void a_ready(const Unit&) const {}
    __device__ __forceinline__ void done(const Unit&) const {}
};
__device__ __forceinline__ unsigned cvt_pk_bf16(float lo, float hi) { unsigned r; asm volatile("v_cvt_pk_bf16_f32 %0, %1, %2" : "=v"(r) : "v"(lo), "v"(hi)); return r; }
__device__ __forceinline__ float bf_lo(unsigned w) { return __uint_as_float(w << 16); }
__device__ __forceinline__ float bf_hi(unsigned w) { return __uint_as_float(w & 0xffff0000u); }
__device__ __forceinline__ float fast_sigmoid(float x) { return __builtin_amdgcn_rcpf(1.0f + __builtin_amdgcn_exp2f(-1.44269504089f * x)); }

__device__ __forceinline__ float row_rstd(const float* SS, size_t row) {
    const f32x4* p = (const f32x4*)(SS + row * 32); float s = 0.f;
#pragma unroll
    for (int j = 0; j < 8; ++j) { const f32x4 v = p[j]; s += (v[0] + v[1]) + (v[2] + v[3]); }
    return 1.0f / sqrtf(s * (1.0f / 2048.0f) + 1e-6f);
}
struct EpiBf16 {
    static constexpr bool PERM = true;
    bf16_t* O; int ldc;
    __device__ __forceinline__ void operator()(const f32x4 (&acc)[2][2][4][2], const Unit& u, int wr, int wc, int fr, int fq) const {
        const int row0 = u.pm * BM + wr * 64 + fr, col0 = u.pn * BM + wc * 32 + 8 * fq;
        float zf = 0.f; asm volatile("" : "+v"(zf));
#pragma unroll
        for (int ai = 0; ai < 2; ++ai)
#pragma unroll
            for (int m = 0; m < 4; ++m) { bf16_t* rowp = O + (size_t)(row0 + ai * HALF + m * 16) * ldc + col0;
#pragma unroll
                for (int bj = 0; bj < 2; ++bj) { const f32x4 v0 = acc[ai][bj][m][0] + zf, v1 = acc[ai][bj][m][1] + zf;
                    u32x4 w; w.x = cvt_pk_bf16(v0[0], v0[1]); w.y = cvt_pk_bf16(v0[2], v0[3]); w.z = cvt_pk_bf16(v1[0], v1[1]); w.w = cvt_pk_bf16(v1[2], v1[3]);
                    *(u32x4*)(rowp + bj * HALF) = w; } }
    }
};
struct EpiRes {
    static constexpr bool PERM = false;
    const float* base; float* out; int ldc;
    __device__ __forceinline__ void operator()(const f32x4 (&acc)[2][2][4][2], const Unit& u, int wr, int wc, int fr, int fq) const {
        const int row0 = u.pm * BM + wr * 64 + fr, col0 = u.pn * BM + wc * 32 + 4 * fq;
#pragma unroll
        for (int ai = 0; ai < 2; ++ai)
#pragma unroll
            for (int m = 0; m < 4; ++m) { const size_t off = (size_t)(row0 + ai * HALF + m * 16) * ldc + col0;
#pragma unroll
                for (int bj = 0; bj < 2; ++bj)
#pragma unroll
                    for (int n = 0; n < 2; ++n) { const f32x4 bs = *(const f32x4*)(base + off + bj * HALF + n * 16); *(f32x4*)(out + off + bj * HALF + n * 16) = bs + acc[ai][bj][m][n]; }
                if (m & 1) asm volatile("" ::: "memory"); }
    }
};
struct EpiGateRS {
    static constexpr bool PERM = true;
    bf16_t* O; int ldc; const float* RS; const float* bias;
    __device__ __forceinline__ void operator()(const f32x4 (&acc)[2][2][4][2], const Unit& u, int wr, int wc, int fr, int fq) const {
        const int row0 = u.pm * BM + wr * 64 + fr, col0 = u.pn * BM + wc * 32 + 8 * fq;
        f32x4 bg[2][2];
#pragma unroll
        for (int bj = 0; bj < 2; ++bj) { bg[bj][0] = *(const f32x4*)(bias + col0 + bj * HALF); bg[bj][1] = *(const f32x4*)(bias + col0 + bj * HALF + 4); }
#pragma unroll
        for (int ai = 0; ai < 2; ++ai)
#pragma unroll
            for (int m = 0; m < 4; ++m) { const size_t row = (size_t)(row0 + ai * HALF + m * 16); const float rs = RS[row]; bf16_t* rowp = O + row * ldc + col0;
#pragma unroll
                for (int bj = 0; bj < 2; ++bj) { const f32x4 a0 = acc[ai][bj][m][0] * rs + bg[bj][0], a1 = acc[ai][bj][m][1] * rs + bg[bj][1];
                    u32x4 w; w.x = cvt_pk_bf16(fast_sigmoid(a0[0]), fast_sigmoid(a0[1])); w.y = cvt_pk_bf16(fast_sigmoid(a0[2]), fast_sigmoid(a0[3]));
                    w.z = cvt_pk_bf16(fast_sigmoid(a1[0]), fast_sigmoid(a1[1])); w.w = cvt_pk_bf16(fast_sigmoid(a1[2]), fast_sigmoid(a1[3]));
                    *(u32x4*)(rowp + bj * HALF) = w; } }
    }
};
template <bool LRS> struct EpiWin {
    static constexpr bool PERM = true;
    bf16_t* za; bf16_t* zbc; bf16_t* zg; bf16_t* memkv; const float* RS; const float* bgate; const PG8_LAS float* rsl; float gsc = 1.0f;
    __device__ __forceinline__ void operator()(const f32x4 (&acc)[2][2][4][2], const Unit& u, int wr, int wc, int fr, int fq) const {
        const int row0 = u.pm * BM + wr * 64 + fr, cw = wc * 32 + 8 * fq;
        bf16_t* O; int ldc, colb;
        if (u.br == 0) { O = za; ldc = 3072; colb = u.pn * BM; } else if (u.br == 1) { O = zbc; ldc = 4352; colb = (u.pn - 12) * BM; } else if (u.br == 2) { O = zg; ldc = 6144; colb = (u.pn - 29) * BM; } else { O = memkv; ldc = 4096; colb = u.pn * BM; }
        const bool gate = (u.br == 2), scaled = (u.br != 3);
        f32x4 bg[2][2];
#pragma unroll
        for (int bj = 0; bj < 2; ++bj) { bg[bj][0] = gate ? *(const f32x4*)(bgate + colb + cw + bj * HALF) : (f32x4){0.f, 0.f, 0.f, 0.f}; bg[bj][1] = gate ? *(const f32x4*)(bgate + colb + cw + bj * HALF + 4) : (f32x4){0.f, 0.f, 0.f, 0.f}; }
#pragma unroll
        for (int ai = 0; ai < 2; ++ai)
#pragma unroll
            for (int m = 0; m < 4; ++m) { const size_t row = (size_t)(row0 + ai * HALF + m * 16); const float rs = scaled ? (LRS ? rsl[wr * 64 + fr + ai * HALF + m * 16] : row_rstd(RS, row)) : 1.0f; bf16_t* rowp = O + row * ldc + colb + cw;
#pragma unroll
                for (int bj = 0; bj < 2; ++bj) { const float rg = gate ? rs * gsc : rs; f32x4 a0 = acc[ai][bj][m][0] * rg + bg[bj][0], a1 = acc[ai][bj][m][1] * rg + bg[bj][1];
                    if (gate) {
#pragma unroll
                        for (int e = 0; e < 4; ++e) { a0[e] = fast_sigmoid(a0[e]); a1[e] = fast_sigmoid(a1[e]); } }
                    u32x4 w; w.x = cvt_pk_bf16(a0[0], a0[1]); w.y = cvt_pk_bf16(a0[2], a0[3]); w.z = cvt_pk_bf16(a1[0], a1[1]); w.w = cvt_pk_bf16(a1[2], a1[3]);
                    *(u32x4*)(rowp + bj * HALF) = w; } }
    }
};
struct EpiUp {
    static constexpr bool PERM = true;
    bf16_t* q; bf16_t* kv;
    __device__ __forceinline__ void operator()(const f32x4 (&acc)[2][2][4][2], const Unit& u, int wr, int wc, int fr, int fq) const {
        const int row0 = u.pm * BM + wr * 64 + fr, col0 = u.pn * BM + wc * 32 + 8 * fq;
        bf16_t* O = (u.br == 0) ? q : kv; const int ldc = (u.br == 0) ? 1536 : 2048;
        float zf = 0.f; asm volatile("" : "+v"(zf));
#pragma unroll
        for (int ai = 0; ai < 2; ++ai)
#pragma unroll
            for (int m = 0; m < 4; ++m) { bf16_t* rowp = O + (size_t)(row0 + ai * HALF + m * 16) * ldc + col0;
#pragma unroll
                for (int bj = 0; bj < 2; ++bj) { const f32x4 v0 = acc[ai][bj][m][0] + zf, v1 = acc[ai][bj][m][1] + zf;
                    u32x4 w; w.x = cvt_pk_bf16(v0[0], v0[1]); w.y = cvt_pk_bf16(v0[2], v0[3]); w.z = cvt_pk_bf16(v1[0], v1[1]); w.w = cvt_pk_bf16(v1[2], v1[3]);
                    *(u32x4*)(rowp + bj * HALF) = w; } }
    }
};
struct KwOrder { int G, c0;
    __device__ __forceinline__ bool next(int i, Unit& u) const { const int c = i * G + c0; if (c >= 128) return false; const int b = c >> 5, h = (c >> 3) & 3; u.pm = 0; u.pn = c & 7; u.ka = 512 * h; u.kb = 512 * h; u.br = (b << 2) | h;
        u.aoff = (long)b * 256 * 4096 * 2; u.boff = 0; return true; }
    __device__ __forceinline__ void a_ready(const Unit&) const {} __device__ __forceinline__ void done(const Unit&) const {} };
struct VwOrder { int G, c0;
    __device__ __forceinline__ bool next(int i, Unit& u) const { const int c = i * G + c0; if (c >= 128) return false; const int b = c >> 5, h = (c >> 3) & 3; u.pm = c & 7; u.pn = 0; u.ka = 512 * h; u.kb = 2048 + 512 * h; u.br = (b << 2) | h;
        u.aoff = 0; u.boff = (long)b * 256 * 4096 * 2; return true; }
    __device__ __forceinline__ void a_ready(const Unit&) const {} __device__ __forceinline__ void done(const Unit&) const {} };
struct EpiXW {
    static constexpr bool PERM = true;
    bf16_t* O; int mode;
    __device__ __forceinline__ void operator()(const f32x4 (&acc)[2][2][4][2], const Unit& u, int wr, int wc, int fr, int fq) const {
        const int b = u.br >> 2, h = u.br & 3; const int cw = wc * 32 + 8 * fq, rw = wr * 64 + fr;
        bf16_t* base; int ldc;
        if (mode == 0) { ldc = 2048; base = O + ((size_t)b * 1024 + 256 * h + rw) * 2048 + u.pn * BM + cw; }
        else { ldc = 1024; base = O + ((size_t)b * 2048 + u.pm * BM + rw) * 1024 + 256 * h + cw; }
        float zf = 0.f; asm volatile("" : "+v"(zf));
#pragma unroll
        for (int ai = 0; ai < 2; ++ai)
#pragma unroll
            for (int m = 0; m < 4; ++m) { bf16_t* rowp = base + (size_t)(ai * HALF + m * 16) * ldc;
#pragma unroll
                for (int bj = 0; bj < 2; ++bj) { const f32x4 v0 = acc[ai][bj][m][0] + zf, v1 = acc[ai][bj][m][1] + zf;
                    u32x4 w; w.x = cvt_pk_bf16(v0[0], v0[1]); w.y = cvt_pk_bf16(v0[2], v0[3]); w.z = cvt_pk_bf16(v1[0], v1[1]); w.w = cvt_pk_bf16(v1[2], v1[3]);
                    *(u32x4*)(rowp + bj * HALF) = w; } }
    }
};
struct BatchOrder : StaticOrder { long bstride;
    __device__ __forceinline__ bool next(int i, Unit& u) const { if (!StaticOrder::next(i, u)) return false; u.boff = (long)(u.pm >> 4) * bstride; return true; } };
constexpr int LDP = 1024;
template <bool LRS> struct EpiSoftmaxP {
    static constexpr bool PERM = true;
    bf16_t* P; const float* RS; PG8_LAS float* xch; const PG8_LAS float* rsl;
    __device__ __forceinline__ void operator()(const f32x4 (&acc)[2][2][4][2], const Unit& u, int wr, int wc, int fr, int fq) const {
        constexpr float C = 0.04419417382415922f * 1.4426950408889634f;
        PG8_LAS float* xm = xch; PG8_LAS float* xs = xch + 1024;
        f32x4 v[2][4][2][2]; float mx[2][4];
#pragma unroll
        for (int ai = 0; ai < 2; ++ai)
#pragma unroll
            for (int m = 0; m < 4; ++m) { const float rs = (LRS ? rsl[ai * HALF + wr * 64 + m * 16 + fr] : row_rstd(RS, (size_t)(u.pm * BM + ai * HALF + wr * 64 + m * 16 + fr))) * C; float mm = -3.0e38f;
#pragma unroll
                for (int bj = 0; bj < 2; ++bj)
#pragma unroll
                    for (int n = 0; n < 2; ++n) { const f32x4 x = acc[ai][bj][m][n] * rs; v[ai][m][bj][n] = x; mm = fmaxf(mm, fmaxf(fmaxf(x[0], x[1]), fmaxf(x[2], x[3]))); }
                mm = max_xor32(max_xor16(mm)); mx[ai][m] = mm;
                if (fq == 0) xm[wc * 256 + ai * HALF + wr * 64 + m * 16 + fr] = mm; }
        asm volatile("s_waitcnt lgkmcnt(0)" ::: "memory"); __builtin_amdgcn_s_barrier(); asm volatile("" ::: "memory");
        float sm[2][4];
#pragma unroll
        for (int ai = 0; ai < 2; ++ai)
#pragma unroll
            for (int m = 0; m < 4; ++m) { const int r = ai * HALF + wr * 64 + m * 16 + fr; const float mm = fmaxf(fmaxf(xm[r], xm[256 + r]), fmaxf(xm[512 + r], xm[768 + r])); float s = 0.f;
#pragma unroll
                for (int bj = 0; bj < 2; ++bj)
#pragma unroll
                    for (int n = 0; n < 2; ++n) { f32x4 x = v[ai][m][bj][n];
#pragma unroll
                        for (int e = 0; e < 4; ++e) { x[e] = __builtin_amdgcn_exp2f(x[e] - mm); s += x[e]; }
                        v[ai][m][bj][n] = x; }
                s = sum_xor32(sum_xor16(s)); sm[ai][m] = s;
                if (fq == 0) xs[wc * 256 + r] = s; }
        asm volatile("s_waitcnt lgkmcnt(0)" ::: "memory"); __builtin_amdgcn_s_barrier(); asm volatile("" ::: "memory");
        const int row0 = u.pm * BM + wr * 64 + fr, col0 = u.pn * BM + wc * 32 + 8 * fq;
#pragma unroll
        for (int ai = 0; ai < 2; ++ai)
#pragma unroll
            for (int m = 0; m < 4; ++m) { const int r = ai * HALF + wr * 64 + m * 16 + fr; const float inv = __builtin_amdgcn_rcpf((xs[r] + xs[256 + r]) + (xs[512 + r] + xs[768 + r]));
                bf16_t* rowp = P + (size_t)(row0 + ai * HALF + m * 16) * LDP + col0;
#pragma unroll
                for (int bj = 0; bj < 2; ++bj) { const f32x4 v0 = v[ai][m][bj][0] * inv, v1 = v[ai][m][bj][1] * inv;
                    u32x4 w; w.x = cvt_pk_bf16(v0[0], v0[1]); w.y = cvt_pk_bf16(v0[2], v0[3]); w.z = cvt_pk_bf16(v1[0], v1[1]); w.w = cvt_pk_bf16(v1[2], v1[3]);
                    *(u32x4*)(rowp + bj * HALF) = w; } }
        asm volatile("s_waitcnt lgkmcnt(0)" ::: "memory"); __builtin_amdgcn_s_barrier(); asm volatile("" ::: "memory");
        (void)mx; (void)sm;
    }
};
struct EpiMerge {
    static constexpr bool PERM = true, CHAIN = true;
    bf16_t* O; const bf16_t* zg;
    __device__ __forceinline__ void operator()(f32x4 (&acc)[2][2][4][2], const Unit& u, int wr, int wc, int fr, int fq) const {
        const int row0 = u.pm * BM + wr * 64 + fr, col0 = u.pn * BM + wc * 32 + 8 * fq, gc0 = u.br * 2048 + col0;
        const bool more = (u.br < 2);
        u32x4 z[2][2][2], zn[2][2][2];
#define MG_LOAD(buf_, q_) do { _Pragma("unroll") for (int mm = 0; mm < 2; ++mm) { const size_t row = (size_t)(row0 + ((q_) >> 1) * HALF + (2 * ((q_) & 1) + mm) * 16); \
            _Pragma("unroll") for (int bj = 0; bj < 2; ++bj) { z[buf_][mm][bj] = *(const u32x4*)(zg + row * 6144 + gc0 + bj * HALF); \
                zn[buf_][mm][bj] = more ? *(const u32x4*)(zg + row * 6144 + gc0 + 2048 + bj * HALF) : (u32x4){0x3f803f80u, 0x3f803f80u, 0x3f803f80u, 0x3f803f80u}; } } } while (0)
#define MG_APPLY(buf_, q_) do { _Pragma("unroll") for (int mm = 0; mm < 2; ++mm) { const int ai = (q_) >> 1, m = 2 * ((q_) & 1) + mm; bf16_t* rowp = O + (size_t)(row0 + ai * HALF + m * 16) * 2048 + col0; \
            _Pragma("unroll") for (int bj = 0; bj < 2; ++bj) { const u32x4 a = z[buf_][mm][bj], b = zn[buf_][mm][bj]; float f[8]; \
                f[0] = bf_lo(a.x); f[1] = bf_hi(a.x); f[2] = bf_lo(a.y); f[3] = bf_hi(a.y); f[4] = bf_lo(a.z); f[5] = bf_hi(a.z); f[6] = bf_lo(a.w); f[7] = bf_hi(a.w); \
                const float d[8] = {bf_lo(b.x), bf_hi(b.x), bf_lo(b.y), bf_hi(b.y), bf_lo(b.z), bf_hi(b.z), bf_lo(b.w), bf_hi(b.w)}; \
                _Pragma("unroll") for (int e = 0; e < 8; ++e) { const float ge = (u.br == 0) ? f[e] : fmaxf(f[e], 1e-20f); f[e] = more ? ge * __builtin_amdgcn_rcpf(fmaxf(d[e], 1e-20f)) : ge; } \
                f32x4 a0 = acc[ai][bj][m][0], a1 = acc[ai][bj][m][1]; \
                a0[0] *= f[0]; a0[1] *= f[1]; a0[2] *= f[2]; a0[3] *= f[3]; a1[0] *= f[4]; a1[1] *= f[5]; a1[2] *= f[6]; a1[3] *= f[7]; \
                acc[ai][bj][m][0] = a0; acc[ai][bj][m][1] = a1; \
                if (!more) { u32x4 w; w.x = cvt_pk_bf16(a0[0], a0[1]); w.y = cvt_pk_bf16(a0[2], a0[3]); w.z = cvt_pk_bf16(a1[0], a1[1]); w.w = cvt_pk_bf16(a1[2], a1[3]); *(u32x4*)(rowp + bj * HALF) = w; } } } } while (0)
        MG_LOAD(0, 0);
        MG_LOAD(1, 1); asm volatile("" ::: "memory"); MG_APPLY(0, 0);
        MG_LOAD(0, 2); asm volatile("" ::: "memory"); MG_APPLY(1, 1);
        MG_LOAD(1, 3); asm volatile("" ::: "memory"); MG_APPLY(0, 2);
        asm volatile("" ::: "memory"); MG_APPLY(1, 3);
#undef MG_LOAD
#undef MG_APPLY
    }
};
struct EpiSwiGLU {
    static constexpr bool PERM = false;
    bf16_t* O; int ldc;
    __device__ __forceinline__ void operator()(const f32x4 (&acc)[2][2][4][2], const Unit& u, int wr, int wc, int fr, int fq) const {
        const int row0 = u.pm * BM + wr * 64 + fr;
#pragma unroll
        for (int ai = 0; ai < 2; ++ai)
#pragma unroll
            for (int m = 0; m < 4; ++m) { bf16_t* rowp = O + (size_t)(row0 + ai * HALF + m * 16) * ldc;
#pragma unroll
                for (int bj = 0; bj < 2; ++bj) { const int G = 8 * u.pn + 4 * bj + wc; const f32x4 g = acc[ai][bj][m][0], up = acc[ai][bj][m][1];
                    float o[4];
#pragma unroll
                    for (int e = 0; e < 4; ++e) o[e] = g[e] * fast_sigmoid(g[e]) * up[e];
                    u32x2 w; w.x = cvt_pk_bf16(o[0], o[1]); w.y = cvt_pk_bf16(o[2], o[3]);
                    *(u32x2*)(rowp + 16 * G + 4 * fq) = w; } }
    }
};


struct EpiBf16RS {
    static constexpr bool PERM = true;
    bf16_t* O; int ldc; const float* SS;
    __device__ __forceinline__ void operator()(const f32x4 (&acc)[2][2][4][2], const Unit& u, int wr, int wc, int fr, int fq) const {
        const int row0 = u.pm * BM + wr * 64 + fr, col0 = u.pn * BM + wc * 32 + 8 * fq;
#pragma unroll
        for (int ai = 0; ai < 2; ++ai)
#pragma unroll
            for (int m = 0; m < 4; ++m) { const size_t row = (size_t)(row0 + ai * HALF + m * 16); const float rs = row_rstd(SS, row); bf16_t* rowp = O + row * ldc + col0;
#pragma unroll
                for (int bj = 0; bj < 2; ++bj) { const f32x4 v0 = acc[ai][bj][m][0] * rs, v1 = acc[ai][bj][m][1] * rs;
                    u32x4 w; w.x = cvt_pk_bf16(v0[0], v0[1]); w.y = cvt_pk_bf16(v0[2], v0[3]); w.z = cvt_pk_bf16(v1[0], v1[1]); w.w = cvt_pk_bf16(v1[2], v1[3]);
                    *(u32x4*)(rowp + bj * HALF) = w; } }
    }
};
struct EpiResN {
    static constexpr bool PERM = false;
    const float* base; float* out; int ldc; bf16_t* xb; const float* gnext; float* SS;
    __device__ __forceinline__ void operator()(const f32x4 (&acc)[2][2][4][2], const Unit& u, int wr, int wc, int fr, int fq) const {
        const int row0 = u.pm * BM + wr * 64 + fr, col0 = u.pn * BM + wc * 32 + 4 * fq;
        f32x4 gv[2][2];
#pragma unroll
        for (int bj = 0; bj < 2; ++bj)
#pragma unroll
            for (int n = 0; n < 2; ++n) gv[bj][n] = *(const f32x4*)(gnext + col0 + bj * HALF + n * 16);
#pragma unroll
        for (int ai = 0; ai < 2; ++ai)
#pragma unroll
            for (int m = 0; m < 4; ++m) { const size_t row = (size_t)(row0 + ai * HALF + m * 16); const size_t off = row * ldc + col0; float ss = 0.f;
#pragma unroll
                for (int bj = 0; bj < 2; ++bj)
#pragma unroll
                    for (int n = 0; n < 2; ++n) { const f32x4 bs = *(const f32x4*)(base + off + bj * HALF + n * 16); const f32x4 x = bs + acc[ai][bj][m][n];
                        *(f32x4*)(out + off + bj * HALF + n * 16) = x; ss += (x[0] * x[0] + x[1] * x[1]) + (x[2] * x[2] + x[3] * x[3]);
                        const f32x4 xg = x * gv[bj][n]; u32x2 w; w.x = cvt_pk_bf16(xg[0], xg[1]); w.y = cvt_pk_bf16(xg[2], xg[3]);
                        *(u32x2*)(xb + off + bj * HALF + n * 16) = w; }
                ss = sum_xor32(sum_xor16(ss));
                if (fq == 0) SS[row * 32 + u.pn * 4 + wc] = ss;
                if (m & 1) asm volatile("" ::: "memory"); }
    }
};
constexpr float F8_SA_ = 2.0f;
__device__ __forceinline__ unsigned pk4_fp8_(float a, float b, float c, float d) { int w = __builtin_amdgcn_cvt_pk_fp8_f32(a, b, 0, false); w = __builtin_amdgcn_cvt_pk_fp8_f32(c, d, w, true); return (unsigned)w; }
struct EpiResB {
    static constexpr bool PERM = true;
    bf16_t* xb; float* SS; unsigned char* h8 = nullptr;
    __device__ __forceinline__ void operator()(const f32x4 (&acc)[2][2][4][2], const Unit& u, int wr, int wc, int fr, int fq) const {
        const int row0 = u.pm * BM + wr * 64 + fr, col0 = u.pn * BM + wc * 32 + 8 * fq;
#pragma unroll
        for (int ai = 0; ai < 2; ++ai) {
            u32x4 old[4][2];
#pragma unroll
            for (int m = 0; m < 4; ++m)
#pragma unroll
                for (int bj = 0; bj < 2; ++bj) old[m][bj] = *(const u32x4*)(xb + (size_t)(row0 + ai * HALF + m * 16) * 2048 + col0 + bj * HALF);
#pragma unroll
            for (int m = 0; m < 4; ++m) { const size_t row = (size_t)(row0 + ai * HALF + m * 16); bf16_t* rowp = xb + row * 2048 + col0; float ss = 0.f;
#pragma unroll
                for (int bj = 0; bj < 2; ++bj) { const u32x4 oo = old[m][bj]; const f32x4 a0 = acc[ai][bj][m][0], a1 = acc[ai][bj][m][1];
                    const float x0 = a0[0] + bf_lo(oo.x), x1 = a0[1] + bf_hi(oo.x), x2 = a0[2] + bf_lo(oo.y), x3 = a0[3] + bf_hi(oo.y), x4 = a1[0] + bf_lo(oo.z), x5 = a1[1] + bf_hi(oo.z), x6 = a1[2] + bf_lo(oo.w), x7 = a1[3] + bf_hi(oo.w);
                    ss += (x0 * x0 + x1 * x1) + (x2 * x2 + x3 * x3) + (x4 * x4 + x5 * x5) + (x6 * x6 + x7 * x7);
                    u32x4 w; w.x = cvt_pk_bf16(x0, x1); w.y = cvt_pk_bf16(x2, x3); w.z = cvt_pk_bf16(x4, x5); w.w = cvt_pk_bf16(x6, x7);
                    *(u32x4*)(rowp + bj * HALF) = w;
                    if (h8) { u32x2 q; q.x = pk4_fp8_(x0 * F8_SA_, x1 * F8_SA_, x2 * F8_SA_, x3 * F8_SA_); q.y = pk4_fp8_(x4 * F8_SA_, x5 * F8_SA_, x6 * F8_SA_, x7 * F8_SA_);
                        *(u32x2*)(h8 + row * 2048 + col0 + bj * HALF) = q; } }
                ss = sum_xor32(sum_xor16(ss));
                if (fq == 0) SS[row * 32 + u.pn * 4 + wc] = ss; }
            asm volatile("" ::: "memory"); }
    }
};
struct EpiResF {
    static constexpr bool PERM = false;
    const bf16_t* xb; float* out;
    __device__ __forceinline__ void operator()(const f32x4 (&acc)[2][2][4][2], const Unit& u, int wr, int wc, int fr, int fq) const {
        const int row0 = u.pm * BM + wr * 64 + fr, col0 = u.pn * BM + wc * 32 + 4 * fq;
#pragma unroll
        for (int ai = 0; ai < 2; ++ai) {
            u32x2 old[16];
#pragma unroll
            for (int e = 0; e < 16; ++e) old[e] = *(const u32x2*)(xb + (size_t)(row0 + ai * HALF + (e >> 2) * 16) * 2048 + col0 + ((e >> 1) & 1) * HALF + (e & 1) * 16);
            asm volatile("" : "+v"(old[0]), "+v"(old[1]), "+v"(old[2]), "+v"(old[3]), "+v"(old[4]), "+v"(old[5]), "+v"(old[6]), "+v"(old[7]), "+v"(old[8]), "+v"(old[9]), "+v"(old[10]), "+v"(old[11]), "+v"(old[12]), "+v"(old[13]), "+v"(old[14]), "+v"(old[15]) :: "memory");
#pragma unroll
            for (int m = 0; m < 4; ++m) { const size_t off = (size_t)(row0 + ai * HALF + m * 16) * 2048 + col0;
#pragma unroll
                for (int bj = 0; bj < 2; ++bj)
#pragma unroll
                    for (int n = 0; n < 2; ++n) { const u32x2 oo = old[m * 4 + bj * 2 + n]; const f32x4 a = acc[ai][bj][m][n];
                        *(f32x4*)(out + off + bj * HALF + n * 16) = (f32x4){a[0] + bf_lo(oo.x), a[1] + bf_hi(oo.x), a[2] + bf_lo(oo.y), a[3] + bf_hi(oo.y)}; }
                if (m & 1) asm volatile("" ::: "memory"); } }
    }
};
template <bool LRS> struct EpiSwiGLURS {
    static constexpr bool PERM = false;
    bf16_t* O; int ldc; const float* SS; const PG8_LAS float* rsl;
    __device__ __forceinline__ void operator()(const f32x4 (&acc)[2][2][4][2], const Unit& u, int wr, int wc, int fr, int fq) const {
        const int row0 = u.pm * BM + wr * 64 + fr;
#pragma unroll
        for (int ai = 0; ai < 2; ++ai)
#pragma unroll
            for (int mp = 0; mp < 4; mp += 2) {
                float rs2[2];
#pragma unroll
                for (int q = 0; q < 2; ++q) rs2[q] = LRS ? rsl[wr * 64 + fr + ai * HALF + (mp + q) * 16] : row_rstd(SS, (size_t)(row0 + ai * HALF + (mp + q) * 16));
                bf16_t* rowp = O + (size_t)(row0 + ai * HALF + (mp + (fq & 1)) * 16) * ldc + 8 * (fq >> 1);
#pragma unroll
                for (int bj = 0; bj < 2; ++bj) { const int Gq = 8 * u.pn + 4 * bj + wc; unsigned px[2], py[2];
#pragma unroll
                    for (int q = 0; q < 2; ++q) { const f32x4 g = acc[ai][bj][mp + q][0] * rs2[q], up = acc[ai][bj][mp + q][1] * rs2[q];
                        float o[4];
#pragma unroll
                        for (int e = 0; e < 4; ++e) o[e] = g[e] * fast_sigmoid(g[e]) * up[e];
                        px[q] = cvt_pk_bf16(o[0], o[1]); py[q] = cvt_pk_bf16(o[2], o[3]); }
                    const auto r0 = __builtin_amdgcn_permlane16_swap(px[0], px[1], false, false), r1 = __builtin_amdgcn_permlane16_swap(py[0], py[1], false, false);
                    u32x4 w; w.x = r0[0]; w.y = r1[0]; w.z = r0[1]; w.w = r1[1];
                    *(u32x4*)(rowp + 16 * Gq) = w; } }
    }
};
template <class E, class = void> struct epi_chain { static constexpr bool value = false; };
template <class E> struct epi_chain<E, decltype((void)E::CHAIN)> { static constexpr bool value = E::CHAIN; };
template <class Epi, class Sched, bool ALIGN_EPI, bool F8 = false>
__device__ __forceinline__ void gemm_phase(PG8_LAS unsigned char* lds, const Gemm g, const Sched& S, const Epi& E, int tid) {
    asm volatile("" : "+v"(tid));
    const int wid = __builtin_amdgcn_readfirstlane(tid >> 6), lane = tid & 63, wr = wid >> 2, wc = wid & 3, fr = lane & 15, fq = lane >> 4;
    const int nt = g.K / BK;
    unsigned voffA[2], voffB[2];
#pragma unroll
    for (int i = 0; i < 2; ++i) { int R, C; stage_rc(tid * 16 + i * 8192, R, C); const int Rb = Epi::PERM ? ((R & ~31) + perm32(R & 31)) : R;
        voffA[i] = (unsigned)(R * g.lda + C) * 2u; voffB[i] = (unsigned)(Rb * g.ldb + C) * 2u; }
    const size_t kstep = (size_t)(BK * 2);
    const size_t hstepA = (size_t)HALF * g.lda * 2, hstepB = (size_t)HALF * g.ldb * 2;
    const unsigned ldsw = (unsigned)wid * 1024u;
    const int aoff = lds_byte(wr * 64 + fr, fq * 8), boff = lds_byte(wc * 32 + fr, fq * 8);
#define PG8_SA(b, h) (((b) * 2 + (h)) * HTB)
#define PG8_SB(b, h) ((4 + (b) * 2 + (h)) * HTB)
#define PG8_STAGE(bufoff, gbase, voff) do { _Pragma("unroll") for (int _i = 0; _i < 2; ++_i) \
        __builtin_amdgcn_global_load_lds((const unsigned*)((const char*)(gbase) + (voff)[_i]), (PG8_LAS unsigned*)(lds + (bufoff) + ldsw + _i * 8192), 16, 0, 0); } while (0)
#define PG8_CAT8(lo_, hi_) __builtin_shufflevector(lo_, hi_, 0, 1, 2, 3, 4, 5, 6, 7)
#define PG8_LDA(dst, b, h) do { if constexpr (F8) { _Pragma("unroll") for (int m = 0; m < 4; ++m) dst##8[m] = PG8_CAT8(*(const PG8_LAS i32x4*)(lds + PG8_SA(b, h) + aoff + m * 2048), *(const PG8_LAS i32x4*)(lds + PG8_SA(b, h) + aoff + m * 2048 + 1024)); } \
        else { _Pragma("unroll") for (int m = 0; m < 4; ++m) _Pragma("unroll") for (int k = 0; k < 2; ++k) dst[m][k] = *(const PG8_LAS bf16x8*)(lds + PG8_SA(b, h) + aoff + m * 2048 + k * 1024); } } while (0)
#define PG8_LDB(dst, b, h) do { if constexpr (F8) { _Pragma("unroll") for (int n = 0; n < 2; ++n) dst##8[n] = PG8_CAT8(*(const PG8_LAS i32x4*)(lds + PG8_SB(b, h) + boff + n * 2048), *(const PG8_LAS i32x4*)(lds + PG8_SB(b, h) + boff + n * 2048 + 1024)); } \
        else { _Pragma("unroll") for (int n = 0; n < 2; ++n) _Pragma("unroll") for (int k = 0; k < 2; ++k) dst[n][k] = *(const PG8_LAS bf16x8*)(lds + PG8_SB(b, h) + boff + n * 2048 + k * 1024); } } while (0)
#define PG8_MMA(ai, bj, At, Bt) do { __builtin_amdgcn_s_setprio(1); _Pragma("unroll") for (int m = 0; m < 4; ++m) _Pragma("unroll") for (int n = 0; n < 2; ++n) { \
        if constexpr (F8) asm volatile("v_mfma_f32_16x16x128_f8f6f4 %0, %1, %2, %0" : "+v"(acc[ai][bj][m][n]) : "v"(Bt##8[n]), "v"(At##8[m]));   \
        else { _Pragma("unroll") for (int k = 0; k < 2; ++k) acc[ai][bj][m][n] = __builtin_amdgcn_mfma_f32_16x16x32_bf16(Bt[n][k], At[m][k], acc[ai][bj][m][n], 0, 0, 0); } } \
        __builtin_amdgcn_s_setprio(0); } while (0)
#define PG8_WAIT_V(n) asm volatile("s_waitcnt vmcnt(" #n ")" ::: "memory")
#define PG8_WAIT_L(n) asm volatile("s_waitcnt lgkmcnt(" #n ")" ::: "memory")
#define PG8_BAR __builtin_amdgcn_s_barrier()
#define PG8_SCHED __builtin_amdgcn_sched_barrier(0)
    Unit cur, nxt; int ui = 0;
    if (!S.next(0, cur)) return;
    f32x4 acc[2][2][4][2];
#pragma unroll
    for (int a = 0; a < 2; ++a)
#pragma unroll
        for (int b = 0; b < 2; ++b)
#pragma unroll
            for (int m = 0; m < 4; ++m)
#pragma unroll
                for (int n = 0; n < 2; ++n) acc[a][b][m][n] = (f32x4){0.f, 0.f, 0.f, 0.f};
    bf16x8 At[4][2], B0[2][2], B1[2][2]; i32x8 At8[4], B08[2], B18[2];
    const char* cA = (const char*)g.A + cur.aoff + (size_t)cur.pm * 2 * hstepA + (size_t)cur.ka * 2; const char* cB = (const char*)g.Bt + cur.boff + (size_t)cur.pn * 2 * hstepB + (size_t)cur.kb * 2;
    S.a_ready(cur);
    PG8_STAGE(PG8_SB(0, 0), cB, voffB); PG8_STAGE(PG8_SB(0, 1), cB + hstepB, voffB); PG8_STAGE(PG8_SA(0, 0), cA, voffA); PG8_STAGE(PG8_SA(0, 1), cA + hstepA, voffA);
    if (wr == 1) PG8_BAR;
    PG8_WAIT_V(2); PG8_BAR;
    PG8_STAGE(PG8_SB(1, 0), cB + kstep, voffB); PG8_STAGE(PG8_SA(1, 0), cA + kstep, voffA); PG8_STAGE(PG8_SB(1, 1), cB + hstepB + kstep, voffB);
    PG8_WAIT_V(6); PG8_BAR;
    for (;;) {
        const bool has_next = S.next(ui + 1, nxt);
        const char* nA = has_next ? (const char*)g.A + nxt.aoff + (size_t)nxt.pm * 2 * hstepA + (size_t)nxt.ka * 2 : cA; const char* nB = has_next ? (const char*)g.Bt + nxt.boff + (size_t)nxt.pn * 2 * hstepB + (size_t)nxt.kb * 2 : cB;
        asm volatile(".p2align 8" :::);
        for (int t = 0; t < nt; t += 2) {
            const bool last = (t == nt - 2);
            const char* a1 = cA + (size_t)(t + 1) * kstep;
            const char* a2 = last ? nA : cA + (size_t)(t + 2) * kstep; const char* b2 = last ? nB : cB + (size_t)(t + 2) * kstep;
            const char* a3 = a2 + kstep; const char* b3 = b2 + kstep;
            if (last && has_next) S.a_ready(nxt);
            PG8_LDB(B0, 0, 0); PG8_LDB(B1, 0, 1); PG8_SCHED; PG8_LDA(At, 0, 0); PG8_STAGE(PG8_SA(1, 1), a1 + hstepA, voffA);
            PG8_WAIT_V(8); PG8_WAIT_L(0); PG8_BAR; PG8_MMA(0, 0, At, B0); PG8_MMA(0, 1, At, B1); PG8_BAR; PG8_SCHED;
            PG8_LDA(At, 0, 1); PG8_STAGE(PG8_SB(0, 0), b2, voffB); PG8_STAGE(PG8_SB(0, 1), b2 + hstepB, voffB); PG8_STAGE(PG8_SA(0, 0), a2, voffA);
            PG8_WAIT_V(8); PG8_WAIT_L(0); PG8_BAR; PG8_MMA(1, 0, At, B0); PG8_MMA(1, 1, At, B1); PG8_BAR; PG8_SCHED;
            PG8_LDB(B0, 1, 0); PG8_LDB(B1, 1, 1); PG8_SCHED; PG8_LDA(At, 1, 0); PG8_STAGE(PG8_SA(0, 1), a2 + hstepA, voffA);
            PG8_WAIT_V(8); PG8_WAIT_L(0); PG8_BAR; PG8_MMA(0, 0, At, B0); PG8_MMA(0, 1, At, B1); PG8_BAR; PG8_SCHED;
            PG8_LDA(At, 1, 1); PG8_STAGE(PG8_SB(1, 0), b3, voffB); PG8_STAGE(PG8_SB(1, 1), b3 + hstepB, voffB); PG8_STAGE(PG8_SA(1, 0), a3, voffA);
            PG8_WAIT_V(8); PG8_WAIT_L(0); PG8_BAR; PG8_MMA(1, 0, At, B0); PG8_MMA(1, 1, At, B1); PG8_BAR; PG8_SCHED;
        }
        if constexpr (ALIGN_EPI) { if (wr == 0) PG8_BAR; }
        if constexpr (F8) asm volatile("s_nop 15\n\ts_nop 15" ::: "memory");
        E(acc, cur, wr, wc, fr, fq); S.done(cur);
        if (!has_next) break;
        if (!(epi_chain<Epi>::value && nxt.br != 0))
#pragma unroll
        for (int a = 0; a < 2; ++a)
#pragma unroll
            for (int b = 0; b < 2; ++b)
#pragma unroll
                for (int m = 0; m < 4; ++m)
#pragma unroll
                    for (int n = 0; n < 2; ++n) acc[a][b][m][n] = (f32x4){0.f, 0.f, 0.f, 0.f};
        cur = nxt; cA = nA; cB = nB; ++ui;
        if constexpr (ALIGN_EPI) { if (wr == 1) PG8_BAR; }
    }
    PG8_WAIT_V(0);
    if constexpr (!ALIGN_EPI) { if (wr == 0) PG8_BAR; }
    PG8_BAR;
#undef PG8_SA
#undef PG8_SB
#undef PG8_STAGE
#undef PG8_LDA
#undef PG8_LDB
#undef PG8_MMA
#undef PG8_WAIT_V
#undef PG8_WAIT_L
#undef PG8_BAR
#undef PG8_SCHED
}
}

constexpr int NWAVES = 8;
constexpr int NB = 4, SEQ = 4096, M = NB * SEQ, D = 2048, MEML = 256, MROWS = NB * MEML;
constexpr int NA = 3072, NABC = 4352  , NG = 6144, NIN = NA + NABC + NG, DFF = 5632, NFF2 = 2 * DFF, DIN_SRC = 13392, LDW = D + 64  , LDACT = DFF + 64  ;
constexpr int ZA_Q = 0, ZA_K = 1024, ZA_V = 2048;
constexpr int ZC_BQ = 0, ZC_BK = 512, ZC_BV = 1024, ZC_BR = 2048, ZC_CQA = 3072, ZC_CKVA = 3584, ZC_CKR = 4096, ZC_BLR = 4160;
constexpr float EPS = 1e-6f;
constexpr int PH_PER_LAYER = 15, N_PHASES = 2 * PH_PER_LAYER + 1;

constexpr size_t MiB = 1u << 20;
constexpr size_t WS_CTL = 0, CTL_ZERO_BYTES = 32768;
constexpr size_t WS_ROPE = 1 * MiB;
constexpr size_t WS_WIN = 2 * MiB, WS_WQB = 55 * MiB, WS_WKVB = 57 * MiB, WS_WUP = 59 * MiB, WS_WO = 71 * MiB, WS_WXQ = 79 * MiB, WS_WXKV = 87 * MiB, WS_WXO = 103 * MiB, WS_WFF = 111 * MiB, WS_WDN = 158 * MiB;
constexpr size_t WS_H = 182 * MiB;
constexpr size_t WS_ZA = 246 * MiB, WS_MLAKV = 246 * MiB, WS_ZABC = 342 * MiB  , WS_GLAST = 182 * MiB  , WS_GLADEC = 826 * MiB, WS_AML = 826 * MiB + 512 * 1024  ;
constexpr size_t WS_MERGED = 246 * MiB, WS_XQ = 246 * MiB, WS_OX = 310 * MiB;
constexpr size_t WS_P = 342 * MiB  , WS_KW = 310 * MiB  , WS_VW = 326 * MiB  ;
constexpr size_t WS_ZG = 478 * MiB;
constexpr size_t WS_ACT = 478 * MiB;
constexpr size_t WS_OABC = 670 * MiB;
constexpr size_t WS_MLAQ = 766 * MiB;
constexpr size_t WS_MEMKV = 814 * MiB;
constexpr size_t WS_MEMN = 822 * MiB;
constexpr size_t WS_SS = 828 * MiB;
constexpr size_t WS_RS = 830 * MiB;
constexpr size_t WS_END = 831 * MiB;
static_assert(WS_WFF + (size_t)NFF2 * LDW * 2 <= WS_WDN && WS_WIN + (size_t)NIN * D * 2 <= WS_WQB && WS_WDN + (size_t)D * LDACT * 2 <= WS_H && WS_ZA + (size_t)M * NA * 2 <= WS_ZABC && WS_ZABC + (size_t)M * NABC * 2 <= WS_ZG && WS_ZG + (size_t)M * NG * 2 <= WS_OABC && WS_ACT + (size_t)M * LDACT * 2 <= WS_OABC, "ws map");
constexpr size_t WS_W8 = WS_WIN + (size_t)7424 * D * 2, WS_H8 = WS_MLAQ;
static_assert(pg8::F8_SA_ == 2.0f, "fp8 stream scale");
constexpr float F8_SA = 2.0f, F8_SW = 256.0f, F8_GSC = 1.0f / (F8_SA * F8_SW);
constexpr int CW_BAR = 4096, CW_XID = 128  , CW_GRP = 512  ;

constexpr int RING_OFF = 0, RING_BYTES = 131072;
constexpr int LDSCTL_OFF = RING_BYTES, MISC_OFF = LDSCTL_OFF + 320;
constexpr int PTAB_OFF = MISC_OFF + 128;
constexpr int LDS_BYTES = 147456;

#define GAS __attribute__((address_space(1)))
#define LAS __attribute__((address_space(3)))
typedef unsigned short bf16;
typedef unsigned v4u __attribute__((ext_vector_type(4)));
typedef unsigned v2u __attribute__((ext_vector_type(2)));
typedef float f32x4 __attribute__((ext_vector_type(4)));
typedef GAS unsigned gu32;
#define LDS_WAIT() asm volatile("s_waitcnt lgkmcnt(0)" ::: "memory")
__device__ __forceinline__ unsigned f2bf(float f) { unsigned u = __builtin_bit_cast(unsigned, f); return (u + 0x7fffu + ((u >> 16) & 1u)) >> 16; }
__device__ __forceinline__ unsigned pk2(float lo, float hi) { return f2bf(lo) | (f2bf(hi) << 16); }
__device__ __forceinline__ float bf2f(bf16 b) { return __uint_as_float(((unsigned)b) << 16); }
__device__ __forceinline__ float bflo(unsigned w) { return __uint_as_float(w << 16); }
__device__ __forceinline__ float bfhi(unsigned w) { return __uint_as_float(w & 0xffff0000u); }

__device__ __forceinline__ int lane_id_now() { int l; asm volatile("v_mbcnt_lo_u32_b32 %0, -1, 0\n\tv_mbcnt_hi_u32_b32 %0, -1, %0" : "=&v"(l)); return l; }
#define XB_TMO      128
#define XB_XCNT(j)  (256  + 64 * (j))
#define XB_XSUB(j)  (1280 + 64 * (j))
#define XB_XGEN(j)  (2304 + 64 * (j))
#define XB_TOP      3328
#define XB_TOPGEN   3392
#define XCD_BAR_WORDS 3456
#define XB_SPIN_CAP (1u << 22)
__device__ __forceinline__ unsigned xb_ld(unsigned* p)              { return __hip_atomic_load(p, __ATOMIC_RELAXED, __HIP_MEMORY_SCOPE_AGENT); }
__device__ __forceinline__ unsigned xb_add(unsigned* p, unsigned v) { return __hip_atomic_fetch_add(p, v, __ATOMIC_RELAXED, __HIP_MEMORY_SCOPE_AGENT); }
__device__ __forceinline__ unsigned xb_xcc_id() { return (unsigned)__builtin_amdgcn_s_getreg((3 << 11) | 20) & 0xFu; }
#define XB_SPIN(cond, bar) do { unsigned _sp = 0; while (cond) { __builtin_amdgcn_s_sleep(1); \
    if ((++_sp & 255u) == 0u) { if (xb_ld(&(bar)[XB_TMO])) break; if (_sp > XB_SPIN_CAP) { atomicAdd(&(bar)[XB_TMO], 1u); break; } } } } while (0)
struct XcdBarrier { unsigned* bar; unsigned x; volatile LAS unsigned* st; };
__device__ __forceinline__ XcdBarrier xcd_barrier_post(unsigned* bar, volatile LAS unsigned* st) {
    XcdBarrier b; b.bar = bar; b.x = xb_xcc_id(); b.st = st;
    if (threadIdx.x == 0) (void)xb_add(&bar[XB_XCNT(b.x)], 1u);
    return b;
}
__device__ __forceinline__ void xcd_barrier_complete(unsigned* bar, unsigned x, unsigned& nloc, unsigned& nx) {
    const unsigned G = gridDim.x * gridDim.y * gridDim.z;
    unsigned sum, cnt, mine, sp = 0u;
    for (;;) {
        sum = 0u; cnt = 0u; mine = 0u;
#pragma unroll
        for (unsigned j = 0; j < 16; ++j) { const unsigned c = xb_ld(&bar[XB_XCNT(j)]); sum += c; cnt += (c > 0u) ? 1u : 0u; mine = (j == x) ? c : mine; }
        if (sum == G) break;
        __builtin_amdgcn_s_sleep(1);
        if ((++sp & 255u) == 0u) { if (xb_ld(&bar[XB_TMO])) break; if (sp > XB_SPIN_CAP) { atomicAdd(&bar[XB_TMO], 1u); break; } }
    }
    nloc = mine > 0u ? mine : 1u; nx = cnt > 0u ? cnt : 1u;
}
__device__ __forceinline__ void xcd_barrier(const XcdBarrier& b, const bool thread0) {
    asm volatile("s_waitcnt vmcnt(0)" ::: "memory");
    __syncthreads();
    if (thread0) {
        unsigned* bar = b.bar; asm volatile("" : "+s"(bar));
        __builtin_amdgcn_s_waitcnt(0);
        unsigned nloc = b.st[0], nx = b.st[1];
        if (nloc == 0u) { xcd_barrier_complete(bar, b.x, nloc, nx); b.st[0] = nloc; b.st[1] = nx; }
        const unsigned old = xb_add(&bar[XB_XSUB(b.x)], 1u);
        const unsigned gen = old / nloc;
        if (old + 1u == (gen + 1u) * nloc) {
            __builtin_amdgcn_fence(__ATOMIC_RELEASE, "agent");
            asm volatile("s_waitcnt vmcnt(0)" ::: "memory");
            const unsigned og = xb_add(&bar[XB_TOP], 1u);
            const unsigned tg = og / nx;
            if (og + 1u == (tg + 1u) * nx) xb_add(&bar[XB_TOPGEN], 1u);
            else XB_SPIN(xb_ld(&bar[XB_TOPGEN]) == tg, bar);
            __builtin_amdgcn_fence(__ATOMIC_ACQUIRE, "agent");
            xb_add(&bar[XB_XGEN(b.x)], 1u);
            asm volatile("s_waitcnt vmcnt(0)" ::: "memory");
        } else {
            XB_SPIN(xb_ld(&bar[XB_XGEN(b.x)]) == gen, bar);
            __builtin_amdgcn_fence(__ATOMIC_ACQUIRE, "agent");
            asm volatile("s_waitcnt vmcnt(0)" ::: "memory");
        }
    }
    __syncthreads();
}

__device__ __forceinline__ float dot8(v4u k, const LAS float* q) {
    const f32x4 q0 = *(const LAS f32x4*)q, q1 = *(const LAS f32x4*)(q + 4);
    float s = bflo(k.x) * q0.x; s += bfhi(k.x) * q0.y; s += bflo(k.y) * q0.z; s += bfhi(k.y) * q0.w;
    s += bflo(k.z) * q1.x; s += bfhi(k.z) * q1.y; s += bflo(k.w) * q1.z; s += bfhi(k.w) * q1.w; return s;
}

enum { MAP_LIN = 0, MAP_GATE = 1, MAP_UP = 2 };
__device__ __forceinline__ unsigned pk4_fp8(float a, float b, float c, float d) { int w = __builtin_amdgcn_cvt_pk_fp8_f32(a, b, 0, false); w = __builtin_amdgcn_cvt_pk_fp8_f32(c, d, w, true); return (unsigned)w; }
__device__ __forceinline__ void transpose_item8(const float* W, int ldw, int k0, int n0, int ncnt, unsigned char* W8, int nbase, LAS float* scr, int lane, const float* gk) {
    { const int kr = lane >> 3, c4 = (lane & 7) * 4;
      const float* wp = W + (size_t)(k0 + kr) * ldw + n0 + c4;
      f32x4 v[8]; float gj[8];
#pragma unroll
      for (int j = 0; j < 8; ++j) gj[j] = gk[k0 + 8 * j + kr] * F8_SW;
#pragma unroll
      for (int j = 0; j < 8; ++j) v[j] = (c4 < ncnt) ? *(const f32x4*)(wp + (size_t)(8 * j) * ldw) : (f32x4){0.f, 0.f, 0.f, 0.f};
      asm volatile("" : "+v"(v[0]), "+v"(v[1]), "+v"(v[2]), "+v"(v[3]), "+v"(v[4]), "+v"(v[5]), "+v"(v[6]), "+v"(v[7]) :: "memory");
#pragma unroll
      for (int j = 0; j < 8; ++j) { v[j] = v[j] * gj[j]; LAS float* d = scr + (8 * j + kr) * 33 + c4; d[0] = v[j].x; d[1] = v[j].y; d[2] = v[j].z; d[3] = v[j].w; } }
    LDS_WAIT(); asm volatile("" ::: "memory");
    const int c = lane & 7;
#pragma unroll
    for (int j = 0; j < 4; ++j) { const int n = (lane >> 3) + 8 * j; const LAS float* sp = scr + (8 * c) * 33 + n;
        v2u o; o.x = pk4_fp8(sp[0 * 33], sp[1 * 33], sp[2 * 33], sp[3 * 33]); o.y = pk4_fp8(sp[4 * 33], sp[5 * 33], sp[6 * 33], sp[7 * 33]);
        if (n < ncnt) *(v2u*)(W8 + (size_t)(n0 + n - nbase) * 2048 + k0 + 8 * c) = o; }
    LDS_WAIT(); asm volatile("" ::: "memory");
}
__device__ __forceinline__ bool seg_item8(int& r, const float* W, int K, int ldw, int ns, int ncols, unsigned char* W8, LAS float* scr, int lane, const float* gk) {
    const int nblk = (ncols + 31) / 32, cnt = (K / 64) * nblk;
    if (r >= cnt) { r -= cnt; return false; }
    const int kb = r / nblk, nb = r - kb * nblk, n0 = ns + 32 * nb, nc = (ncols - 32 * nb) < 32 ? (ncols - 32 * nb) : 32;
    transpose_item8(W, ldw, 64 * kb, n0, nc, W8, ns, scr, lane, gk);
    return true;
}
template <int MAPK>
__device__ __forceinline__ void transpose_item(const float* W, int ldw, int k0, int n0, int ncnt, bf16* WT, int ldd, int dcol0, int moff, LAS float* scr, int lane, const float* gk) {
    { const int kr = lane >> 3, c4 = (lane & 7) * 4;
      const float* wp = W + (size_t)(k0 + kr) * ldw + n0 + c4;
      f32x4 v[8]; float gj[8];
#pragma unroll
      for (int j = 0; j < 8; ++j) gj[j] = 1.0f;
      if (gk) {
#pragma unroll
          for (int j = 0; j < 8; ++j) gj[j] = gk[k0 + 8 * j + kr]; }
#pragma unroll
      for (int j = 0; j < 8; ++j) v[j] = (c4 < ncnt) ? *(const f32x4*)(wp + (size_t)(8 * j) * ldw) : (f32x4){0.f, 0.f, 0.f, 0.f};
      asm volatile("" : "+v"(v[0]), "+v"(v[1]), "+v"(v[2]), "+v"(v[3]), "+v"(v[4]), "+v"(v[5]), "+v"(v[6]), "+v"(v[7]) :: "memory");
#pragma unroll
      for (int j = 0; j < 8; ++j) v[j] = v[j] * gj[j];
#pragma unroll
      for (int j = 0; j < 8; ++j) { LAS float* d = scr + (8 * j + kr) * 33 + c4; d[0] = v[j].x; d[1] = v[j].y; d[2] = v[j].z; d[3] = v[j].w; } }
    LDS_WAIT(); asm volatile("" ::: "memory");
    const int c = lane & 7;
#pragma unroll
    for (int j = 0; j < 4; ++j) { const int n = (lane >> 3) + 8 * j; const LAS float* s = scr + (8 * c) * 33 + n;
        v4u o; o.x = pk2(s[0 * 33], s[1 * 33]); o.y = pk2(s[2 * 33], s[3 * 33]); o.z = pk2(s[4 * 33], s[5 * 33]); o.w = pk2(s[6 * 33], s[7 * 33]);
        const int sn = n0 + n - moff;
        int drow;
        if (MAPK == MAP_LIN) drow = sn; else if (MAPK == MAP_GATE) drow = 32 * (sn >> 4) + (sn & 15); else drow = 32 * (sn >> 4) + 16 + (sn & 15);
        if (n < ncnt) *(v4u*)(WT + (size_t)drow * ldd + dcol0 + k0 + 8 * c) = o; }
    LDS_WAIT(); asm volatile("" ::: "memory");
}
template <int MAPK>
__device__ __forceinline__ bool seg_item(int& r, const float* W, int K, int ldw, int ns, int ncols, bf16* WT, int ldd, int drow0, int dcol0, LAS float* scr, int lane, const float* gk = nullptr) {
    const int nblk = (ncols + 31) / 32, cnt = (K / 64) * nblk;
    if (r >= cnt) { r -= cnt; return false; }
    const int kb = r / nblk, nb = r - kb * nblk, n0 = ns + 32 * nb, nc = (ncols - 32 * nb) < 32 ? (ncols - 32 * nb) : 32;
    transpose_item<MAPK>(W, ldw, 64 * kb, n0, nc, WT, ldd, dcol0, (MAPK == MAP_LIN) ? (ns - drow0) : ns, scr, lane, gk);
    return true;
}

__device__ __forceinline__ void rms_row_bf16(const float* xrow, const float* g, bf16* orow, int lane) {
    const f32x4* xr = (const f32x4*)xrow + lane; const f32x4* gr = (const f32x4*)g + lane;
    f32x4 v[8]; float s = 0.f;
#pragma unroll
    for (int j = 0; j < 8; ++j) { v[j] = xr[64 * j]; s += (v[j].x * v[j].x + v[j].y * v[j].y) + (v[j].z * v[j].z + v[j].w * v[j].w); }
    const float rstd = 1.0f / sqrtf(wave_sum(s) * (1.f / 2048.f) + EPS);
    v2u* o8 = (v2u*)orow + lane;
#pragma unroll
    for (int j = 0; j < 8; ++j) { const f32x4 gg = gr[64 * j]; v2u w; w.x = pk2(v[j].x * rstd * gg.x, v[j].y * rstd * gg.y); w.y = pk2(v[j].z * rstd * gg.z, v[j].w * rstd * gg.w); o8[64 * j] = w; }
}

__device__ __forceinline__ void gain_row_bf16(const float* xrow, const float* g, bf16* orow, float* ssrow, unsigned char* h8row, int lane) {
    const f32x4* xr = (const f32x4*)xrow + lane; const f32x4* gr = (const f32x4*)g + lane;
    f32x4 v[8]; float s = 0.f;
#pragma unroll
    for (int j = 0; j < 8; ++j) { v[j] = xr[64 * j]; s += (v[j].x * v[j].x + v[j].y * v[j].y) + (v[j].z * v[j].z + v[j].w * v[j].w); }
    s = wave_sum(s);
    v2u* o8 = (v2u*)orow + lane;
#pragma unroll
    for (int j = 0; j < 8; ++j) { (void)gr; v2u w; w.x = pk2(v[j].x, v[j].y); w.y = pk2(v[j].z, v[j].w); o8[64 * j] = w;
        ((unsigned*)h8row)[lane + 64 * j] = pk4_fp8(v[j].x * F8_SA, v[j].y * F8_SA, v[j].z * F8_SA, v[j].w * F8_SA); }
    if (lane < 32) ssrow[lane] = (lane == 0) ? s : 0.f;
}
__device__ __forceinline__ void final_row(const bf16* hrow, const float* ss, const f32x4 (&gv)[8], float* orow, int lane) {
    v4u h[4];
#pragma unroll
    for (int j = 0; j < 4; ++j) h[j] = *(const v4u*)(hrow + 8 * (lane + 64 * j));
    const float s = wave_sum((lane < 32) ? ss[lane & 31] : 0.f);
    const float rstd = 1.0f / sqrtf(s * (1.f / 2048.f) + EPS);
#pragma unroll
    for (int j = 0; j < 4; ++j) { float* op = orow + 8 * (lane + 64 * j);
        *(f32x4*)op = (f32x4){bflo(h[j].x) * rstd * gv[2 * j].x, bfhi(h[j].x) * rstd * gv[2 * j].y, bflo(h[j].y) * rstd * gv[2 * j].z, bfhi(h[j].y) * rstd * gv[2 * j].w};
        *(f32x4*)(op + 4) = (f32x4){bflo(h[j].z) * rstd * gv[2 * j + 1].x, bfhi(h[j].z) * rstd * gv[2 * j + 1].y, bflo(h[j].w) * rstd * gv[2 * j + 1].z, bfhi(h[j].w) * rstd * gv[2 * j + 1].w}; }
}
__device__ __forceinline__ void rms_row_f32_inplace(float* xrow, const float* g, int lane) {
    f32x4* xr = (f32x4*)xrow + lane; const f32x4* gr = (const f32x4*)g + lane;
    f32x4 v[8]; float s = 0.f;
#pragma unroll
    for (int j = 0; j < 8; ++j) { v[j] = xr[64 * j]; s += (v[j].x * v[j].x + v[j].y * v[j].y) + (v[j].z * v[j].z + v[j].w * v[j].w); }
    const float rstd = 1.0f / sqrtf(wave_sum(s) * (1.f / 2048.f) + EPS);
#pragma unroll
    for (int j = 0; j < 8; ++j) { const f32x4 gg = gr[64 * j]; xr[64 * j] = (f32x4){v[j].x * rstd * gg.x, v[j].y * rstd * gg.y, v[j].z * rstd * gg.z, v[j].w * rstd * gg.w}; }
}

__device__ __forceinline__ const float* ldptr(LAS unsigned long long* tab, int k) {
    unsigned ta = (unsigned)(uintptr_t)(tab + k); asm volatile("" : "+s"(ta));
    const unsigned long long v = *(LAS unsigned long long*)ta; const unsigned lo = __builtin_amdgcn_readfirstlane((unsigned)v), hi = __builtin_amdgcn_readfirstlane((unsigned)(v >> 32));
    return (const float*)(const GAS float*)(((unsigned long long)hi << 32) | lo);
}
struct Args { const float* in[27]; float* out; unsigned char* ws; int ph_lo, ph_hi; };

__device__ __forceinline__ int t5_bucket(int dist) {
    if (dist < 16) return dist;
    const float n = (float)dist;
    int large = 16 + (int)(logf(n / 16.0f) / 4.852030263919617f * 16.0f);
    return large < 31 ? large : 31;
}

__device__ __forceinline__ void naive_attn_a(LAS unsigned char* lds, const bf16* Z, bf16* Oabc, const float* rel_bias, int gw, int ngw, int wave, int lane, int tid) {
    LAS float* bias = (LAS float*)lds;
    for (int i = tid; i < 3 * 129 * 8; i += NWAVES * 64) { const int h = i & 7, gd = i >> 3, g = gd / 129, d = gd - g * 129; const int dil = (g == 0) ? 1 : (g == 1 ? 4 : 16);
        bias[i] = rel_bias[t5_bucket(d * dil) * 8 + h]; }
    __syncthreads();
    LAS float* qs = (LAS float*)(lds + 16384 + wave * 1024);
    LAS float* ps = qs + 128;
    const float scale = 0.08838834764831845f;
    for (int item = gw; item < M * 8; item += ngw) {
        const int h = item & 7, mt = item >> 3, b = mt >> 12, t = mt & 4095;
        { const unsigned w = *(const unsigned*)(Z + (size_t)mt * NA + ZA_Q + h * 128 + 2 * lane); qs[2 * lane] = bflo(w) * scale; qs[2 * lane + 1] = bfhi(w) * scale; }
        LDS_WAIT();
        float m_run = -1e30f, l_run = 0.f, o0 = 0.f, o1 = 0.f;
        for (int g = 0; g < 3; ++g) {
            const int dil = (g == 0) ? 1 : (g == 1 ? 4 : 16);
            const int dmax = (t / dil) < 128 ? (t / dil) : 128;
            for (int d0 = 0; d0 <= dmax; d0 += 64) {
                const int d = d0 + lane; const bool valid = d <= dmax; const int tk = valid ? t - d * dil : t;
                const v4u* kp = (const v4u*)(Z + (size_t)(b * SEQ + tk) * NA + ZA_K + h * 128);
                float s = 0.f;
#pragma unroll
                for (int c = 0; c < 16; ++c) s += dot8(kp[c], qs + 8 * c);
                s = valid ? s + bias[(g * 129 + (valid ? d : 0)) * 8 + h] : -1e30f;
                const float m_new = fmaxf(m_run, wave_max(s)); const float alpha = __expf(m_run - m_new); const float p = valid ? __expf(s - m_new) : 0.f;
                l_run = l_run * alpha + wave_sum(p); o0 *= alpha; o1 *= alpha; m_run = m_new;
                ps[lane] = p; LDS_WAIT();
                const int nk = (dmax - d0 + 1) < 64 ? (dmax - d0 + 1) : 64;
                for (int jj = 0; jj < nk; ++jj) { const float pj = ps[jj]; const int tkj = t - (d0 + jj) * dil;
                    const unsigned w = *(const unsigned*)(Z + (size_t)(b * SEQ + tkj) * NA + ZA_V + h * 128 + 2 * lane); o0 += pj * bflo(w); o1 += pj * bfhi(w); }
                LDS_WAIT();
            }
        }
        const float inv = 1.0f / l_run;
        *(unsigned*)(Oabc + (size_t)mt * 3072 + h * 128 + 2 * lane) = pk2(o0 * inv, o1 * inv);
    }
}

__device__ __forceinline__ void mla_prep(bf16* Z, const float* qg, const float* kvg, const float* ropec, const float* ropes, int gw, int ngw, int lane) {
    const f32x4 gq0 = *(const f32x4*)(qg + 8 * lane), gq1 = *(const f32x4*)(qg + 8 * lane + 4), gk0 = *(const f32x4*)(kvg + 8 * lane), gk1 = *(const f32x4*)(kvg + 8 * lane + 4);
    for (int mt0 = gw; mt0 < M; mt0 += 4 * ngw) {
        v4u w[4][2]; float ss[4][2]; float x1[4], x2[4]; int mts[4];
#pragma unroll
        for (int j = 0; j < 4; ++j) { const int mt = (mt0 + j * ngw < M) ? mt0 + j * ngw : mt0; mts[j] = mt; bf16* zr = Z + (size_t)mt * NABC;
            w[j][0] = *(const v4u*)(zr + ZC_CQA + 8 * lane); w[j][1] = *(const v4u*)(zr + ZC_CKVA + 8 * lane);
            x1[j] = bf2f(zr[ZC_CKR + (lane & 31)]); x2[j] = bf2f(zr[ZC_CKR + 32 + (lane & 31)]);
#pragma unroll
            for (int q = 0; q < 2; ++q) { const v4u a = w[j][q]; const float v0 = bflo(a.x), v1 = bfhi(a.x), v2 = bflo(a.y), v3 = bfhi(a.y), v4 = bflo(a.z), v5 = bfhi(a.z), v6 = bflo(a.w), v7 = bfhi(a.w);
                ss[j][q] = (v0 * v0 + v1 * v1) + (v2 * v2 + v3 * v3) + (v4 * v4 + v5 * v5) + (v6 * v6 + v7 * v7); } }
#pragma unroll
        for (int j = 0; j < 4; ++j) { ss[j][0] = wave_sum(ss[j][0]); ss[j][1] = wave_sum(ss[j][1]); }
#pragma unroll
        for (int j = 0; j < 4; ++j) { if (j > 0 && mt0 + j * ngw >= M) continue; const int mt = mts[j]; bf16* zr = Z + (size_t)mt * NABC; const int s_pos = mt & 4095;
#pragma unroll
            for (int q = 0; q < 2; ++q) { const float rstd = 1.0f / sqrtf(ss[j][q] * (1.f / 512.f) + EPS); const v4u a = w[j][q]; const f32x4 g0 = q ? gk0 : gq0, g1 = q ? gk1 : gq1;
                v4u o; o.x = pk2(bflo(a.x) * rstd * g0.x, bfhi(a.x) * rstd * g0.y); o.y = pk2(bflo(a.y) * rstd * g0.z, bfhi(a.y) * rstd * g0.w);
                o.z = pk2(bflo(a.z) * rstd * g1.x, bfhi(a.z) * rstd * g1.y); o.w = pk2(bflo(a.w) * rstd * g1.z, bfhi(a.w) * rstd * g1.w);
                *(v4u*)(zr + (q ? ZC_CKVA : ZC_CQA) + 8 * lane) = o; }
            const float c = ropec[s_pos * 32 + (lane & 31)], sn = ropes[s_pos * 32 + (lane & 31)];
            const float r = (lane < 32) ? (x1[j] * c - x2[j] * sn) : (x1[j] * sn + x2[j] * c);
            zr[ZC_CKR + lane] = (bf16)f2bf(r); }
    }
}

__device__ __forceinline__ void naive_attn_mla(LAS unsigned char* lds, const bf16* Q, const bf16* KV, const bf16* Z, bf16* Oabc, const float* ropec, const float* ropes, int gw, int ngw, int wave, int lane) {
    LAS float* qs = (LAS float*)(lds + wave * 4096);
    LAS float* ps = qs + 768;
    const float scale = 0.07216878364870322f;
    const int nitems = NB * 8 * (SEQ / 4);
    for (int item = gw; item < nitems; item += ngw) {
        const int qg = item % (SEQ / 4), bh = item / (SEQ / 4), b = bh >> 3, h = bh & 7, i0 = 4 * qg;
#pragma unroll
        for (int r = 0; r < 4; ++r) {
            const bf16* qp = Q + (size_t)(b * SEQ + i0 + r) * 1536 + h * 192;
            qs[r * 192 + lane] = bf2f(qp[lane]) * scale; qs[r * 192 + 64 + lane] = bf2f(qp[64 + lane]) * scale;
            const float x1 = bf2f(qp[128 + (lane & 31)]), x2 = bf2f(qp[160 + (lane & 31)]);
            const float c = ropec[(i0 + r) * 32 + (lane & 31)], sn = ropes[(i0 + r) * 32 + (lane & 31)];
            qs[r * 192 + 128 + lane] = ((lane < 32) ? (x1 * c - x2 * sn) : (x1 * sn + x2 * c)) * scale;
        }
        LDS_WAIT();
        float m_run[4], l_run[4], o0[4], o1[4];
#pragma unroll
        for (int r = 0; r < 4; ++r) { m_run[r] = -1e30f; l_run[r] = 0.f; o0[r] = 0.f; o1[r] = 0.f; }
        const int jlast = i0 + 3;
        for (int j0 = 0; j0 <= jlast; j0 += 64) {
            const int j = j0 + lane, jc = j <= jlast ? j : jlast;
            const v4u* kn = (const v4u*)(KV + (size_t)(b * SEQ + jc) * 2048 + h * 256);
            const v4u* kr = (const v4u*)(Z + (size_t)(b * SEQ + jc) * NABC + ZC_CKR);
            float s[4] = {0.f, 0.f, 0.f, 0.f};
#pragma unroll 4
            for (int c = 0; c < 16; ++c) { const v4u kk = kn[c];
#pragma unroll
                for (int r = 0; r < 4; ++r) s[r] += dot8(kk, qs + r * 192 + 8 * c); }
#pragma unroll 4
            for (int c = 0; c < 8; ++c) { const v4u kk = kr[c];
#pragma unroll
                for (int r = 0; r < 4; ++r) s[r] += dot8(kk, qs + r * 192 + 128 + 8 * c); }
#pragma unroll
            for (int r = 0; r < 4; ++r) { const bool valid = j <= i0 + r; const float sv = valid ? s[r] : -1e30f;
                const float m_new = fmaxf(m_run[r], wave_max(sv)); const float alpha = __expf(m_run[r] - m_new); const float p = valid ? __expf(sv - m_new) : 0.f;
                l_run[r] = l_run[r] * alpha + wave_sum(p); o0[r] *= alpha; o1[r] *= alpha; m_run[r] = m_new; ps[r * 64 + lane] = p; }
            LDS_WAIT();
            const int nk = (jlast - j0 + 1) < 64 ? (jlast - j0 + 1) : 64;
            for (int jj = 0; jj < nk; ++jj) {
                const unsigned w = *(const unsigned*)(KV + (size_t)(b * SEQ + j0 + jj) * 2048 + h * 256 + 128 + 2 * lane); const float v0 = bflo(w), v1 = bfhi(w);
#pragma unroll
                for (int r = 0; r < 4; ++r) { const float pj = ps[r * 64 + jj]; o0[r] += pj * v0; o1[r] += pj * v1; } }
            LDS_WAIT();
        }
#pragma unroll
        for (int r = 0; r < 4; ++r) { const float inv = 1.0f / l_run[r]; *(unsigned*)(Oabc + (size_t)(b * SEQ + i0 + r) * 3072 + 2048 + h * 128 + 2 * lane) = pk2(o0[r] * inv, o1[r] * inv); }
    }
}

__device__ __forceinline__ void naive_attn_cross(LAS unsigned char* lds, const bf16* XQ, const bf16* MKV, bf16* OX, int gw, int ngw, int wave, int lane) {
    LAS float* qs = (LAS float*)(lds + wave * 12288);
    LAS float* ps = qs + 2048;
    const float scale = 0.04419417382415922f;
    const int nitems = (M / 4) * 4;
    for (int item = gw; item < nitems; item += ngw) {
        const int h = item & 3, m0 = (item >> 2) * 4, b = m0 >> 12;
#pragma unroll
        for (int r = 0; r < 4; ++r) { const v4u w = *(const v4u*)(XQ + (size_t)(m0 + r) * 2048 + h * 512 + 8 * lane); LAS float* q = qs + r * 512 + 8 * lane;
            q[0] = bflo(w.x) * scale; q[1] = bfhi(w.x) * scale; q[2] = bflo(w.y) * scale; q[3] = bfhi(w.y) * scale; q[4] = bflo(w.z) * scale; q[5] = bfhi(w.z) * scale; q[6] = bflo(w.w) * scale; q[7] = bfhi(w.w) * scale; }
        LDS_WAIT();
        float m_run[4], l_run[4], o[4][8];
#pragma unroll
        for (int r = 0; r < 4; ++r) { m_run[r] = -1e30f; l_run[r] = 0.f;
#pragma unroll
            for (int e = 0; e < 8; ++e) o[r][e] = 0.f; }
        for (int j0 = 0; j0 < MEML; j0 += 64) {
            const v4u* kp = (const v4u*)(MKV + (size_t)(b * MEML + j0 + lane) * 4096 + h * 512);
            float s[4] = {0.f, 0.f, 0.f, 0.f};
#pragma unroll 4
            for (int c = 0; c < 64; ++c) { const v4u kk = kp[c];
#pragma unroll
                for (int r = 0; r < 4; ++r) s[r] += dot8(kk, qs + r * 512 + 8 * c); }
#pragma unroll
            for (int r = 0; r < 4; ++r) { const float m_new = fmaxf(m_run[r], wave_max(s[r])); const float alpha = __expf(m_run[r] - m_new); const float p = __expf(s[r] - m_new);
                l_run[r] = l_run[r] * alpha + wave_sum(p); m_run[r] = m_new; ps[r * 64 + lane] = p;
#pragma unroll
                for (int e = 0; e < 8; ++e) o[r][e] *= alpha; }
            LDS_WAIT();
            for (int jj = 0; jj < 64; ++jj) {
                const v4u w = *(const v4u*)(MKV + (size_t)(b * MEML + j0 + jj) * 4096 + 2048 + h * 512 + 8 * lane);
                const float v[8] = {bflo(w.x), bfhi(w.x), bflo(w.y), bfhi(w.y), bflo(w.z), bfhi(w.z), bflo(w.w), bfhi(w.w)};
#pragma unroll
                for (int r = 0; r < 4; ++r) { const float pj = ps[r * 64 + jj];
#pragma unroll
                    for (int e = 0; e < 8; ++e) o[r][e] += pj * v[e]; } }
            LDS_WAIT();
        }
#pragma unroll
        for (int r = 0; r < 4; ++r) { const float inv = 1.0f / l_run[r]; v4u w; w.x = pk2(o[r][0] * inv, o[r][1] * inv); w.y = pk2(o[r][2] * inv, o[r][3] * inv); w.z = pk2(o[r][4] * inv, o[r][5] * inv); w.w = pk2(o[r][6] * inv, o[r][7] * inv);
            *(v4u*)(OX + (size_t)(m0 + r) * 2048 + h * 512 + 8 * lane) = w; }
    }
}

__device__ __forceinline__ void naive_gla(LAS unsigned char* lds, const bf16* Z, bf16* Oabc, const float* w_alpha, const float* b_alpha, const float* gla_norm, int bh, int tid, int wave, int lane) {
    constexpr int CH = 16;
    LAS float* qs = (LAS float*)lds;
    LAS float* ks = qs + CH * 128;
    LAS float* as = ks + CH * 128;
    LAS float* vs = as + CH * 128;
    LAS float* op = vs + CH * 256;
    const int b = bh >> 2, h = bh & 3, c = tid & 255, half = tid >> 8, kcol = tid & 127;
    float wa[16];
#pragma unroll
    for (int j = 0; j < 16; ++j) wa[j] = w_alpha[j * 512 + h * 128 + kcol];
    const float ba = b_alpha[h * 128 + kcol];
    float S[64];
#pragma unroll
    for (int k = 0; k < 64; ++k) S[k] = 0.f;
    const float qscale = 0.08838834764831845f;
    for (int t0 = 0; t0 < SEQ; t0 += CH) {
        const size_t m0 = (size_t)b * SEQ + t0;
        for (int idx = tid; idx < CH * 128; idx += NWAVES * 64) { const int t = idx >> 7; const bf16* zr = Z + (m0 + t) * NABC;
            qs[idx] = bf2f(zr[ZC_BQ + h * 128 + kcol]) * qscale; ks[idx] = bf2f(zr[ZC_BK + h * 128 + kcol]);
            float x = ba;
#pragma unroll
            for (int j = 0; j < 16; ++j) x += bf2f(zr[ZC_BLR + j]) * wa[j];
            const float ls = fminf(x, 0.f) - log1pf(__expf(-fabsf(x)));
            as[idx] = __expf(ls * (1.0f / 16.0f)); }
        for (int idx = tid; idx < CH * 256; idx += NWAVES * 64) { const int t = idx >> 8; vs[idx] = bf2f(Z[(m0 + t) * NABC + ZC_BV + h * 256 + (idx & 255)]); }
        __syncthreads();
        for (int t = 0; t < CH; ++t) {
            const float v = vs[t * 256 + c]; float acc = 0.f;
            const LAS f32x4* a4 = (const LAS f32x4*)(as + t * 128 + half * 64); const LAS f32x4* k4 = (const LAS f32x4*)(ks + t * 128 + half * 64); const LAS f32x4* q4 = (const LAS f32x4*)(qs + t * 128 + half * 64);
#pragma unroll
            for (int k = 0; k < 16; ++k) { const f32x4 a = a4[k], kk = k4[k], q = q4[k];
                S[4 * k + 0] = a.x * S[4 * k + 0] + kk.x * v; acc += q.x * S[4 * k + 0];
                S[4 * k + 1] = a.y * S[4 * k + 1] + kk.y * v; acc += q.y * S[4 * k + 1];
                S[4 * k + 2] = a.z * S[4 * k + 2] + kk.z * v; acc += q.z * S[4 * k + 2];
                S[4 * k + 3] = a.w * S[4 * k + 3] + kk.w * v; acc += q.w * S[4 * k + 3];
                if ((k & 3) == 3) asm volatile("" ::: "memory"); }
            op[(half * CH + t) * 256 + c] = acc;
        }
        __syncthreads();
        for (int t = wave; t < CH; t += NWAVES) {
            float o[4]; float ss = 0.f;
#pragma unroll
            for (int i = 0; i < 4; ++i) { o[i] = op[t * 256 + lane + 64 * i] + op[(CH + t) * 256 + lane + 64 * i]; ss += o[i] * o[i]; }
            const float rstd = 1.0f / sqrtf(wave_sum(ss) * (1.f / 256.f) + EPS);
#pragma unroll
            for (int i = 0; i < 4; ++i) { const int cc = lane + 64 * i; const float r = bf2f(Z[(m0 + t) * NABC + ZC_BR + h * 256 + cc]);
                const float y = o[i] * rstd * gla_norm[h * 256 + cc] * (r / (1.0f + __expf(-r)));
                Oabc[(m0 + t) * 3072 + 1024 + h * 256 + cc] = (bf16)f2bf(y); }
        }
        __syncthreads();
    }
}


namespace fa {
using bf16x8 = __attribute__((ext_vector_type(8))) short;
using s16x4  = __attribute__((ext_vector_type(4))) short;
using f32x16 = __attribute__((ext_vector_type(16))) float;
using u32x4  = __attribute__((ext_vector_type(4))) unsigned;
#define FA_SBAR() __builtin_amdgcn_sched_barrier(0)
__device__ __forceinline__ int crow(int r, int hi) { return (r & 3) + 8 * (r >> 2) + 4 * hi; }
__device__ __forceinline__ unsigned cvtpk(float lo, float hi) { unsigned r; asm volatile("v_cvt_pk_bf16_f32 %0, %1, %2" : "=v"(r) : "v"(lo), "v"(hi)); return r; }
__device__ __forceinline__ void partialSM(f32x16& p0, f32x16& p1, float& m_reg, float& mn, float& alpha, const float C, const float thr) {
  float pmax = p0[0];
#pragma unroll
  for (int r = 1; r < 16; ++r) pmax = fmaxf(pmax, p0[r]);
#pragma unroll
  for (int r = 0; r < 16; ++r) pmax = fmaxf(pmax, p1[r]);
  { auto rr = __builtin_amdgcn_permlane32_swap(__float_as_uint(pmax), __float_as_uint(pmax), false, false);
    pmax = fmaxf(__uint_as_float(rr[0]), __uint_as_float(rr[1])); }
  if (__builtin_expect(__all(pmax - m_reg <= thr), 1)) { mn = m_reg; alpha = 1.f; }
  else { mn = fmaxf(m_reg, pmax); alpha = __builtin_amdgcn_exp2f((m_reg - mn) * C); m_reg = mn; }
  const float mnC = -mn * C;
#pragma unroll
  for (int r = 0; r < 16; ++r) p0[r] = fmaf(p0[r], C, mnC);
#pragma unroll
  for (int r = 0; r < 16; ++r) p1[r] = fmaf(p1[r], C, mnC);
#pragma unroll
  for (int r = 0; r < 16; ++r) p0[r] = __builtin_amdgcn_exp2f(p0[r]);
}
#define FA_PK4(P, BASE, OUT) do { unsigned a0 = fa::cvtpk(P[BASE + 0], P[BASE + 1]), a1 = fa::cvtpk(P[BASE + 2], P[BASE + 3]);   \
    unsigned b0 = fa::cvtpk(P[BASE + 4], P[BASE + 5]), b1 = fa::cvtpk(P[BASE + 6], P[BASE + 7]);                              \
    auto r0 = __builtin_amdgcn_permlane32_swap(a0, b0, false, false); auto r1 = __builtin_amdgcn_permlane32_swap(a1, b1, false, false); \
    fa::u32x4 w = {r0[0], r1[0], r0[1], r1[1]}; OUT = *reinterpret_cast<fa::bf16x8*>(&w); } while (0)
__device__ __forceinline__ void finishSM(f32x16& p0, f32x16& p1, float alpha, float& l_reg, bf16x8& pa0, bf16x8& pa1, bf16x8& pa2, bf16x8& pa3) {
#pragma unroll
  for (int r = 0; r < 16; ++r) p1[r] = __builtin_amdgcn_exp2f(p1[r]);
  float ps = 0;
#pragma unroll
  for (int r = 0; r < 16; ++r) ps += p0[r];
#pragma unroll
  for (int r = 0; r < 16; ++r) ps += p1[r];
  { auto rr = __builtin_amdgcn_permlane32_swap(__float_as_uint(ps), __float_as_uint(ps), false, false);
    ps = __uint_as_float(rr[0]) + __uint_as_float(rr[1]); }
  l_reg = l_reg * alpha + ps;
  FA_PK4(p0, 0, pa0); FA_PK4(p0, 8, pa1); FA_PK4(p1, 0, pa2); FA_PK4(p1, 8, pa3);
}
__device__ __forceinline__ int v_st(int k, int c) { const int kk = (k & ~0xC) | ((k & 4) << 1) | ((k & 8) >> 1); return ((kk >> 3) * 4 + (c >> 5)) * 512 + ((kk & 7) * 32 + (c & 31)) * 2; }
__device__ __forceinline__ int v_rd_base(int lane) { return ((lane & 3) << 3) | (((lane >> 2) & 3) << 6) | (((lane >> 4) & 1) << 5) | (((lane >> 5) & 1) << 8); }
constexpr int v_rd_off(int d0, int ks, int half) { return d0 * 512 + ks * 4096 + half * 2048; }
template <int OFF> __device__ __forceinline__ s16x4 tr_read(int vb) {
  s16x4 r; asm volatile("ds_read_b64_tr_b16 %0, %1 offset:%2" : "=&v"(r) : "v"(vb), "i"(OFF) : "memory"); return r;
}
template <int D0, int BASE = 0> __device__ __forceinline__ void pv_one(f32x16& od, int vb, bf16x8 pa0, bf16x8 pa1, bf16x8 pa2, bf16x8 pa3) {
  s16x4 l0 = tr_read<BASE + v_rd_off(D0, 0, 0)>(vb), h0 = tr_read<BASE + v_rd_off(D0, 0, 1)>(vb), l1 = tr_read<BASE + v_rd_off(D0, 1, 0)>(vb), h1 = tr_read<BASE + v_rd_off(D0, 1, 1)>(vb);
  s16x4 l2 = tr_read<BASE + v_rd_off(D0, 2, 0)>(vb), h2 = tr_read<BASE + v_rd_off(D0, 2, 1)>(vb), l3 = tr_read<BASE + v_rd_off(D0, 3, 0)>(vb), h3 = tr_read<BASE + v_rd_off(D0, 3, 1)>(vb);
  asm volatile("s_waitcnt lgkmcnt(0)" : "+v"(l0), "+v"(h0), "+v"(l1), "+v"(h1), "+v"(l2), "+v"(h2), "+v"(l3), "+v"(h3) :: "memory"); FA_SBAR();
#define FA_PK(L, H) (bf16x8){L[0], L[1], L[2], L[3], H[0], H[1], H[2], H[3]}
  od = __builtin_amdgcn_mfma_f32_32x32x16_bf16(pa0, FA_PK(l0, h0), od, 0, 0, 0);
  od = __builtin_amdgcn_mfma_f32_32x32x16_bf16(pa1, FA_PK(l1, h1), od, 0, 0, 0);
  od = __builtin_amdgcn_mfma_f32_32x32x16_bf16(pa2, FA_PK(l2, h2), od, 0, 0, 0);
  od = __builtin_amdgcn_mfma_f32_32x32x16_bf16(pa3, FA_PK(l3, h3), od, 0, 0, 0);
#undef FA_PK
}
template <int BASE = 0> __device__ __forceinline__ void pv_d0(f32x16* o, int vb, bf16x8 pa0, bf16x8 pa1, bf16x8 pa2, bf16x8 pa3) {
  pv_one<0, BASE>(o[0], vb, pa0, pa1, pa2, pa3); pv_one<1, BASE>(o[1], vb, pa0, pa1, pa2, pa3); pv_one<2, BASE>(o[2], vb, pa0, pa1, pa2, pa3); pv_one<3, BASE>(o[3], vb, pa0, pa1, pa2, pa3);
}
#define FA_RESC(a, o, al_l, r32, hi) do { if (__any((a) < 1.f)) { if ((hi) == 0) (al_l)[r32] = (a); asm volatile("s_waitcnt lgkmcnt(0)" ::: "memory"); \
    _Pragma("unroll") for (int d_ = 0; d_ < 4; ++d_) _Pragma("unroll") for (int r_ = 0; r_ < 16; ++r_) (o)[d_][r_] *= (al_l)[fa::crow(r_, hi)]; } } while (0)
__device__ __forceinline__ void store_o_bf16(const f32x16* o, const float* rli, bf16* Ow, int ldo, int lane, int r32, int hi) {
  const unsigned loff = (unsigned)((((lane & 1) + 4 * hi) * ldo + (r32 & ~1)) * 2);
#pragma unroll
  for (int r = 0; r < 16; r += 2) {
    char* rowp = (char*)(Ow + (size_t)((r & 3) + 8 * (r >> 2)) * ldo);
#pragma unroll
    for (int d0 = 0; d0 < 4; ++d0) {
      const float a = o[d0][r] * rli[r], b = o[d0][r + 1] * rli[r + 1];
      const float send = (lane & 1) ? a : b; const float recv = lane_xor1(send);
      const unsigned w = cvtpk((lane & 1) ? recv : a, (lane & 1) ? b : recv);
      *(unsigned*)(rowp + loff + d0 * 64) = w; } }
}
}

#define KSWZ192(row, colB) ((row) * 384 + ((colB) ^ (((row) & 7) << 4)))
__device__ __forceinline__ void mla_attn_phase(LAS unsigned char* lds, const bf16* Q, const bf16* KV, const bf16* Z, bf16* Oabc, const float* ropec, const float* ropes, int vcu, int G, int tid) {
    using namespace fa;
    asm volatile("" : "+v"(tid));
    const int wid = __builtin_amdgcn_readfirstlane(tid >> 6), lane = tid & 63, r32 = lane & 31, hi = lane >> 5;
    constexpr int SHM_K = 64 * 384, SHM_V = 16384;
    LAS unsigned char* K_lds = lds; LAS unsigned char* V_lds = lds + 2 * SHM_K;
    LAS float* wsf = (LAS float*)(lds + 2 * SHM_K + 2 * SHM_V) + wid * 64; LAS float* li_l = wsf; LAS float* al_l = wsf + 32;
    LAS unsigned char* qrl = lds + 86016 + wid * 4096;
    const int sr = tid >> 4, sc = (tid & 15) * 8, vst0 = v_st(sr, sc);
    const int kr_row = tid >> 3, kr_c = (tid & 7) * 8;
    const int kst0 = KSWZ192(sr, sc * 2), kst2 = KSWZ192(kr_row, 256 + kr_c * 2);
    const int vb0 = (int)(uintptr_t)V_lds + v_rd_base(lane);
    int ka[4];
#pragma unroll
    for (int j = 0; j < 4; ++j) ka[j] = r32 * 384 + (((j * 2 + hi) ^ (r32 & 7)) << 4);
    constexpr float SCALE = 0.07216878364870322f, C = SCALE * 1.4426950408889634f, THRS = 8.0f / SCALE;
    const unsigned qoff = (unsigned)(((wid * 32 + r32) * 1536 + hi * 8) * 2), roff = (unsigned)(((wid * 32 + r32) * 32 + hi * 8) * 4);
    const unsigned kvoff = (unsigned)((sr * 2048 + sc) * 2), zoff = (unsigned)((kr_row * NABC + ZC_CKR + kr_c) * 2);
#pragma unroll 1
    for (int pi = vcu; pi < 256; pi += G) {
        const int bh = pi >> 3, b = bh >> 3, h = bh & 7;
        const size_t tok0 = (size_t)b * SEQ;
#pragma unroll 1
        for (int half = 0; half < 2; ++half) {
            const int qb = half ? 15 - (pi & 7) : (pi & 7);
            bf16x8 qr[8];
            { bf16x8 qrope[4]; unsigned qoff_ = qoff, roff_ = roff; asm volatile("" : "+v"(qoff_), "+v"(roff_));
              const char* Qu = (const char*)(Q + (tok0 + qb * 256) * 1536 + h * 192);
              const char* cu = (const char*)(ropec + (size_t)(qb * 256) * 32); const char* su = (const char*)(ropes + (size_t)(qb * 256) * 32);
#pragma unroll
              for (int d0 = 0; d0 < 8; ++d0) qr[d0] = *(const bf16x8*)(Qu + qoff_ + d0 * 32);
#pragma unroll
              for (int d0 = 0; d0 < 4; ++d0) qrope[d0] = *(const bf16x8*)(Qu + qoff_ + (8 + d0) * 32);
#pragma unroll
              for (int pr = 0; pr < 2; ++pr) {
                  const f32x4 c0 = *(const f32x4*)(cu + roff_ + pr * 64), c1 = *(const f32x4*)(cu + roff_ + pr * 64 + 16), s0 = *(const f32x4*)(su + roff_ + pr * 64), s1 = *(const f32x4*)(su + roff_ + pr * 64 + 16);
                  const float cc[8] = {c0.x, c0.y, c0.z, c0.w, c1.x, c1.y, c1.z, c1.w}, ss[8] = {s0.x, s0.y, s0.z, s0.w, s1.x, s1.y, s1.z, s1.w};
                  bf16x8 xa = qrope[pr], xb = qrope[2 + pr];
#pragma unroll
                  for (int e = 0; e < 8; ++e) { const float x1 = bf2f((bf16)xa[e]), x2 = bf2f((bf16)xb[e]);
                      xa[e] = (short)f2bf(x1 * cc[e] - x2 * ss[e]); xb[e] = (short)f2bf(x1 * ss[e] + x2 * cc[e]); }
                  *(LAS bf16x8*)(qrl + (pr * 64 + lane) * 16) = xa; *(LAS bf16x8*)(qrl + ((2 + pr) * 64 + lane) * 16) = xb; } }
            v4u vs0, vs1, ks0, ks1, krr;
            const char* KVu = (const char*)(KV + tok0 * 2048 + h * 256); const char* Zu = (const char*)(Z + tok0 * NABC);
#define MLA_SLOAD(k0) do { const char* kvp = KVu + (size_t)(k0) * 4096; const char* zp = Zu + (size_t)(k0) * (NABC * 2); \
            ks0 = *(const v4u*)(kvp + kvoff); vs0 = *(const v4u*)(kvp + kvoff + 256); ks1 = *(const v4u*)(kvp + 32 * 4096 + kvoff); vs1 = *(const v4u*)(kvp + 32 * 4096 + kvoff + 256); \
            krr = *(const v4u*)(zp + zoff); } while (0)
#define MLA_SWRITE(bb) do { *(LAS v4u*)(V_lds + (bb) * SHM_V + vst0) = vs0; *(LAS v4u*)(V_lds + (bb) * SHM_V + vst0 + 8192) = vs1; \
            *(LAS v4u*)(K_lds + (bb) * SHM_K + kst0) = ks0; *(LAS v4u*)(K_lds + (bb) * SHM_K + kst0 + 32 * 384) = ks1; \
            *(LAS v4u*)(K_lds + (bb) * SHM_K + kst2) = krr; } while (0)
            const int nt = 4 * qb + 4;
            float m_reg = -1e30f, l_reg = 0.f; f32x16 o[4];
#pragma unroll
            for (int d = 0; d < 4; ++d)
#pragma unroll
                for (int r = 0; r < 16; ++r) o[d][r] = 0.f;
            MLA_SLOAD(0); MLA_SWRITE(0); __syncthreads();
#pragma unroll 1
            for (int t = 0; t < nt; ++t) {
                const int buf = t & 1;
                if (t + 1 < nt) MLA_SLOAD((t + 1) * 64);
                FA_SBAR();
                const int tt = t - 4 * qb;
                {
                    f32x16 p0, p1;
#pragma unroll
                    for (int r = 0; r < 16; ++r) { p0[r] = 0.f; p1[r] = 0.f; }
                    const LAS unsigned char* Ks = K_lds + buf * SHM_K;
                    bf16x8 kf[2][4], qx[2][2];
#define MLA_KREAD(g_) do { _Pragma("unroll") for (int e_ = 0; e_ < 2; ++e_) { const int d_ = 2 * (g_) + e_; \
                        kf[(g_) & 1][2 * e_] = *(const LAS bf16x8*)(Ks + ka[d_ & 3] + (d_ >> 2) * 128); kf[(g_) & 1][2 * e_ + 1] = *(const LAS bf16x8*)(Ks + ka[d_ & 3] + (d_ >> 2) * 128 + 32 * 384); \
                        if (d_ >= 8) qx[(g_) & 1][e_] = *(const LAS bf16x8*)(qrl + ((d_ - 8) * 64 + lane) * 16); } } while (0)
                    MLA_KREAD(0);
#pragma unroll
                    for (int g = 0; g < 6; ++g) {
                        if (g + 1 < 6) MLA_KREAD(g + 1);
                        FA_SBAR();
#pragma unroll
                        for (int e = 0; e < 2; ++e) { const int d0 = 2 * g + e; const bf16x8 qv = (d0 < 8) ? qr[d0 < 8 ? d0 : 0] : qx[g & 1][e];
                            p0 = __builtin_amdgcn_mfma_f32_32x32x16_bf16(kf[g & 1][2 * e], qv, p0, 0, 0, 0);
                            p1 = __builtin_amdgcn_mfma_f32_32x32x16_bf16(kf[g & 1][2 * e + 1], qv, p1, 0, 0, 0); }
                        FA_SBAR(); }
#undef MLA_KREAD
                    if (tt >= 0) { const int rrel = 32 * wid + r32 - 64 * tt;
#pragma unroll
                        for (int r = 0; r < 16; ++r) { const int kk = crow(r, hi); if (kk > rrel) p0[r] = -1e30f; if (32 + kk > rrel) p1[r] = -1e30f; } }
                    float mn, alpha; partialSM(p0, p1, m_reg, mn, alpha, C, THRS);
                    FA_RESC(alpha, o, al_l, r32, hi);
                    bf16x8 pa0, pa1, pa2, pa3; finishSM(p0, p1, alpha, l_reg, pa0, pa1, pa2, pa3); FA_SBAR();
                    pv_d0(o, vb0 + buf * SHM_V, pa0, pa1, pa2, pa3);
                }
                if (t + 1 < nt) MLA_SWRITE(buf ^ 1);
                __syncthreads();
            }
#undef MLA_SLOAD
#undef MLA_SWRITE
            if (hi == 0) li_l[r32] = l_reg;
            asm volatile("s_waitcnt lgkmcnt(0)" ::: "memory");
            float rli[16];
#pragma unroll
            for (int r = 0; r < 16; ++r) rli[r] = __builtin_amdgcn_rcpf(li_l[crow(r, hi)]);
            { int lane_ = lane; asm volatile("" : "+v"(lane_)); store_o_bf16(o, rli, Oabc + (tok0 + qb * 256 + wid * 32) * 3072 + 2048 + h * 128, 3072, lane_, lane_ & 31, lane_ >> 5); }
        }
    }
}


#define KSWZ256(row, colB) ((row) * 256 + ((colB) ^ (((row) & 7) << 4)))
constexpr int RSL_OFF = 132096 + 8192;
constexpr int XSCR_OFF = 132096;
__device__ __forceinline__ void cross_attn_phase(LAS unsigned char* lds_all, const bf16* XQ, const bf16* MKV, bf16* OX, int vcu, int G, int tid) {
    using namespace fa;
    asm volatile("" : "+v"(tid));
    const int wid = __builtin_amdgcn_readfirstlane(tid >> 6), lane = tid & 63, r32 = lane & 31, hi = lane >> 5;
    LAS unsigned char* lds = lds_all;
    LAS float* li_l = (LAS float*)(lds_all + XSCR_OFF) + wid * 64;
    const int sr = tid >> 4, ch = tid & 15;
    const int kst = KSWZ256(sr, ch * 16), vst = v_st(sr, ch * 8);
    const unsigned loff = (unsigned)((sr * 4096 + ch * 8) * 2);
    const unsigned qoff = (unsigned)(((wid * 32 + r32) * 2048 + hi * 8) * 2);
    const int vb0 = (int)(uintptr_t)lds + v_rd_base(lane);
    int ka[4];
#pragma unroll
    for (int j = 0; j < 4; ++j) ka[j] = r32 * 256 + (((j * 2 + hi) ^ (r32 & 7)) << 4);
    constexpr float SCALE = 0.04419417382415922f, C = SCALE * 1.4426950408889634f;
#pragma unroll 1
    for (int u = vcu; u < 256; u += G) {
        const int b = u >> 6, h = (u >> 4) & 3, qblk = u & 15;
        const char* Qu = (const char*)(XQ + ((size_t)b * SEQ + qblk * 256) * 2048 + h * 512);
        const char* Ku = (const char*)(MKV + (size_t)b * MEML * 4096 + h * 512);
        v4u st[8];
#define XS_LOAD(base) do { _Pragma("unroll") for (int i_ = 0; i_ < 8; ++i_) st[i_] = *(const v4u*)((base) + (size_t)i_ * 262144 + loff); } while (0)
#define XS_WRITE_K(bb) do { _Pragma("unroll") for (int i_ = 0; i_ < 8; ++i_) *(LAS v4u*)(lds + (bb) * 65536 + (i_ >> 1) * 16384 + (i_ & 1) * 8192 + kst) = st[i_]; } while (0)
#define XS_WRITE_V(bb) do { _Pragma("unroll") for (int i_ = 0; i_ < 8; ++i_) *(LAS v4u*)(lds + (bb) * 65536 + (i_ >> 1) * 16384 + (i_ & 1) * 8192 + vst) = st[i_]; } while (0)
        XS_LOAD(Ku); XS_WRITE_K(0); __syncthreads();
        f32x16 p[4][2];
#pragma unroll
        for (int t = 0; t < 4; ++t)
#pragma unroll
            for (int r = 0; r < 16; ++r) { p[t][0][r] = 0.f; p[t][1][r] = 0.f; }
#pragma unroll
        for (int dc = 0; dc < 4; ++dc) {
            if (dc < 3) XS_LOAD(Ku + (dc + 1) * 256); else XS_LOAD(Ku + 4096);
            const LAS unsigned char* Ks = lds + (dc & 1) * 65536;
#pragma unroll
            for (int d0 = 0; d0 < 8; ++d0) {
                const bf16x8 qf = *(const bf16x8*)(Qu + qoff + (dc * 128 + d0 * 16) * 2);
#pragma unroll
                for (int t = 0; t < 4; ++t) {
                    const bf16x8 b0 = *(const LAS bf16x8*)(Ks + t * 16384 + ka[d0 & 3] + (d0 >> 2) * 128); const bf16x8 b1 = *(const LAS bf16x8*)(Ks + t * 16384 + ka[d0 & 3] + (d0 >> 2) * 128 + 32 * 256);
                    p[t][0] = __builtin_amdgcn_mfma_f32_32x32x16_bf16(b0, qf, p[t][0], 0, 0, 0);
                    p[t][1] = __builtin_amdgcn_mfma_f32_32x32x16_bf16(b1, qf, p[t][1], 0, 0, 0); }
                FA_SBAR(); }
            if (dc < 3) XS_WRITE_K((dc + 1) & 1); else XS_WRITE_V(0);
            __syncthreads();
        }
        float mx = p[0][0][0];
#pragma unroll
        for (int t = 0; t < 4; ++t)
#pragma unroll
            for (int r = 0; r < 16; ++r) { mx = fmaxf(mx, p[t][0][r]); mx = fmaxf(mx, p[t][1][r]); }
        { auto rr = __builtin_amdgcn_permlane32_swap(__float_as_uint(mx), __float_as_uint(mx), false, false); mx = fmaxf(__uint_as_float(rr[0]), __uint_as_float(rr[1])); }
        const float mC = -mx * C; float ps = 0.f;
#pragma unroll
        for (int t = 0; t < 4; ++t)
#pragma unroll
            for (int r = 0; r < 16; ++r) { p[t][0][r] = __builtin_amdgcn_exp2f(fmaf(p[t][0][r], C, mC)); p[t][1][r] = __builtin_amdgcn_exp2f(fmaf(p[t][1][r], C, mC)); ps += p[t][0][r] + p[t][1][r]; }
        { auto rr = __builtin_amdgcn_permlane32_swap(__float_as_uint(ps), __float_as_uint(ps), false, false); ps = __uint_as_float(rr[0]) + __uint_as_float(rr[1]); }
        bf16x8 pa[4][4];
#pragma unroll
        for (int t = 0; t < 4; ++t) { FA_PK4(p[t][0], 0, pa[t][0]); FA_PK4(p[t][0], 8, pa[t][1]); FA_PK4(p[t][1], 0, pa[t][2]); FA_PK4(p[t][1], 8, pa[t][3]); }
        if (hi == 0) li_l[r32] = ps;
        asm volatile("s_waitcnt lgkmcnt(0)" ::: "memory");
        float rli[16];
#pragma unroll
        for (int r = 0; r < 16; ++r) rli[r] = __builtin_amdgcn_rcpf(li_l[crow(r, hi)]);
#pragma unroll
        for (int vc = 0; vc < 4; ++vc) {
            if (vc < 3) XS_LOAD(Ku + 4096 + (vc + 1) * 256);
            f32x16 o[4];
#pragma unroll
            for (int d = 0; d < 4; ++d)
#pragma unroll
                for (int r = 0; r < 16; ++r) o[d][r] = 0.f;
            const int vb = vb0 + (vc & 1) * 65536;
            pv_d0<0>(o, vb, pa[0][0], pa[0][1], pa[0][2], pa[0][3]); pv_d0<16384>(o, vb, pa[1][0], pa[1][1], pa[1][2], pa[1][3]);
            pv_d0<32768>(o, vb, pa[2][0], pa[2][1], pa[2][2], pa[2][3]); pv_d0<49152>(o, vb, pa[3][0], pa[3][1], pa[3][2], pa[3][3]);
            store_o_bf16(o, rli, OX + ((size_t)b * SEQ + qblk * 256 + wid * 32) * 2048 + h * 512 + vc * 128, 2048, lane, r32, hi);
            if (vc < 3) XS_WRITE_V((vc + 1) & 1);
            __syncthreads();
        }
#undef XS_LOAD
#undef XS_WRITE_K
#undef XS_WRITE_V
    }
}


constexpr int GL_CUM = 0, GL_QD = 32768, GL_KI = 49152, GL_KS = 32768, GL_V = 65536, GL_BLR = 98304;
__device__ __forceinline__ fa::s16x4 tr_read_dyn(int addr) { fa::s16x4 r; asm volatile("ds_read_b64_tr_b16 %0, %1" : "=&v"(r) : "v"(addr) : "memory"); return r; }
#define GL_PK(L, H) (fa::bf16x8){L[0], L[1], L[2], L[3], H[0], H[1], H[2], H[3]}
struct GlaPre { unsigned short b0, b1; };
__device__ __forceinline__ GlaPre gla_blr_load(const bf16* Z, size_t m0, int tid) {
    GlaPre p; p.b0 = *(const unsigned short*)(Z + (m0 + (tid >> 4)) * NABC + ZC_BLR + (tid & 15)); p.b1 = *(const unsigned short*)(Z + (m0 + 32 + (tid >> 4)) * NABC + ZC_BLR + (tid & 15)); return p; }
__device__ __forceinline__ void gla_cum(LAS unsigned char* lds, const GlaPre pre, const float (&wa)[16], const float ba, int tid) {
    LAS float* cum = (LAS float*)(lds + GL_CUM); LAS float* blr = (LAS float*)(lds + GL_BLR); LAS float* tot = blr + 1024;
    blr[tid] = __uint_as_float((unsigned)pre.b0 << 16); blr[tid + 512] = __uint_as_float((unsigned)pre.b1 << 16);
    const int k = tid & 127, q = tid >> 7;
    __syncthreads();
    float c[16]; float run = 0.f;
#pragma unroll
    for (int i2 = 0; i2 < 16; i2 += 4) {
        f32x4 bb[16];
#pragma unroll
        for (int e = 0; e < 16; ++e) bb[e] = *(const LAS f32x4*)(blr + (16 * q + i2 + (e >> 2)) * 16 + 4 * (e & 3));
        asm volatile("" : "+v"(bb[0]), "+v"(bb[1]), "+v"(bb[2]), "+v"(bb[3]), "+v"(bb[4]), "+v"(bb[5]), "+v"(bb[6]), "+v"(bb[7]), "+v"(bb[8]), "+v"(bb[9]), "+v"(bb[10]), "+v"(bb[11]), "+v"(bb[12]), "+v"(bb[13]), "+v"(bb[14]), "+v"(bb[15]) :: "memory");
#pragma unroll
        for (int ii = 0; ii < 4; ++ii) { float x = ba;
#pragma unroll
            for (int j4 = 0; j4 < 4; ++j4) { const f32x4 b4 = bb[ii * 4 + j4]; x += b4.x * wa[4 * j4] + b4.y * wa[4 * j4 + 1] + b4.z * wa[4 * j4 + 2] + b4.w * wa[4 * j4 + 3]; }
            const float ls = fminf(x, 0.f) - 0.6931471805599453f * __builtin_amdgcn_logf(1.0f + __builtin_amdgcn_exp2f(-1.4426950408889634f * fabsf(x)));
            run += ls * (1.0f / 16.0f); c[i2 + ii] = run; } }
    tot[q * 128 + k] = run;
    __syncthreads();
    float off = 0.f;
#pragma unroll
    for (int qq = 0; qq < 3; ++qq) off += (qq < q) ? tot[qq * 128 + k] : 0.f;
#pragma unroll
    for (int i = 0; i < 16; ++i) cum[(16 * q + i) * 128 + k] = c[i] + off;
    __syncthreads();
}
__device__ __forceinline__ void gla_alpha_load(float (&wa)[16], float& ba, const float* w_alpha, const float* b_alpha, int h, int tid) {
    const int k = tid & 127;
#pragma unroll
    for (int j = 0; j < 16; ++j) wa[j] = w_alpha[j * 512 + h * 128 + k];
    ba = b_alpha[h * 128 + k];
}
struct GlaV { v4u w[4]; };
__device__ __forceinline__ GlaV gla_load_v(const bf16* Z, size_t m0, int h, int tid) {
    GlaV v;
#pragma unroll
    for (int i = 0; i < 4; ++i) { const int piece = tid + 512 * i, t = piece >> 5, cc = (piece & 31) * 8; v.w[i] = *(const v4u*)(Z + (m0 + t) * NABC + ZC_BV + h * 256 + cc); }
    return v; }
__device__ __forceinline__ void gla_write_v(LAS unsigned char* lds, const GlaV& v, int tid) {
#pragma unroll
    for (int i = 0; i < 4; ++i) { const int piece = tid + 512 * i, t = piece >> 5, cc = (piece & 31) * 8; *(LAS v4u*)(lds + GL_V + (cc >> 7) * 16384 + fa::v_st(t, cc & 127)) = v.w[i]; }
}
__device__ __forceinline__ void gla_g1(LAS unsigned char* lds, const bf16* Z, bf16* ST, float* DEC, const GlaPre pre, const float (&wa)[16], const float ba, int item, int tid) {
    using namespace fa;
    asm volatile("" : "+v"(tid));
    const int wid = __builtin_amdgcn_readfirstlane(tid >> 6), lane = tid & 63, r32 = lane & 31, hf = lane >> 5;
    const int bh = item >> 6, n = item & 63, b = bh >> 2, h = bh & 3; const size_t m0 = (size_t)b * SEQ + 64 * n;
    v4u kraw[2];
#pragma unroll
    for (int i = 0; i < 2; ++i) { const int t = (tid >> 4) + 32 * i, kc = (tid & 15) * 8; kraw[i] = *(const v4u*)(Z + (m0 + t) * NABC + ZC_BK + h * 128 + kc); }
    const GlaV vraw = gla_load_v(Z, m0, h, tid);
    gla_cum(lds, pre, wa, ba, tid);
    const LAS float* cum = (const LAS float*)(lds + GL_CUM);
#pragma unroll
    for (int i = 0; i < 2; ++i) { const int t = (tid >> 4) + 32 * i, kc = (tid & 15) * 8;
        const v4u kw = kraw[i];
        const f32x4 c0 = *(const LAS f32x4*)(cum + t * 128 + kc), c1 = *(const LAS f32x4*)(cum + t * 128 + kc + 4), l0 = *(const LAS f32x4*)(cum + 63 * 128 + kc), l1 = *(const LAS f32x4*)(cum + 63 * 128 + kc + 4);
        v4u o; o.x = pk2(bflo(kw.x) * __expf(l0.x - c0.x), bfhi(kw.x) * __expf(l0.y - c0.y)); o.y = pk2(bflo(kw.y) * __expf(l0.z - c0.z), bfhi(kw.y) * __expf(l0.w - c0.w));
        o.z = pk2(bflo(kw.z) * __expf(l1.x - c1.x), bfhi(kw.z) * __expf(l1.y - c1.y)); o.w = pk2(bflo(kw.w) * __expf(l1.z - c1.z), bfhi(kw.w) * __expf(l1.w - c1.w));
        *(LAS v4u*)(lds + GL_KS + v_st(t, kc)) = o; }
    gla_write_v(lds, vraw, tid);
    if (tid < 128) DEC[(size_t)item * 128 + tid] = __expf(cum[63 * 128 + tid]);
    __syncthreads();
    f32x16 acc[4];
#pragma unroll
    for (int kt = 0; kt < 4; ++kt)
#pragma unroll
        for (int r = 0; r < 16; ++r) acc[kt][r] = 0.f;
    const int rb = v_rd_base(lane); const int vbV = (int)(uintptr_t)(lds + GL_V) + (wid >> 2) * 16384 + rb, vbK = (int)(uintptr_t)(lds + GL_KS) + rb;
#pragma unroll
    for (int ks = 0; ks < 4; ++ks) {
        s16x4 bl = tr_read_dyn(vbV + v_rd_off(wid & 3, ks, 0)), bhh = tr_read_dyn(vbV + v_rd_off(wid & 3, ks, 1));
        s16x4 al[4], ah[4];
#pragma unroll
        for (int kt = 0; kt < 4; ++kt) { al[kt] = tr_read_dyn(vbK + v_rd_off(kt, ks, 0)); ah[kt] = tr_read_dyn(vbK + v_rd_off(kt, ks, 1)); }
        asm volatile("s_waitcnt lgkmcnt(0)" : "+v"(bl), "+v"(bhh), "+v"(al[0]), "+v"(ah[0]), "+v"(al[1]), "+v"(ah[1]), "+v"(al[2]), "+v"(ah[2]), "+v"(al[3]), "+v"(ah[3]) :: "memory"); FA_SBAR();
#pragma unroll
        for (int kt = 0; kt < 4; ++kt) acc[kt] = __builtin_amdgcn_mfma_f32_32x32x16_bf16(GL_PK(al[kt], ah[kt]), GL_PK(bl, bhh), acc[kt], 0, 0, 0);
    }
    bf16* stp = ST + ((size_t)item * 256 + 32 * wid + r32) * 128 + 4 * hf;
#pragma unroll
    for (int kt = 0; kt < 4; ++kt)
#pragma unroll
        for (int g = 0; g < 4; ++g) { v2u w; w.x = pk2(acc[kt][4 * g], acc[kt][4 * g + 1]); w.y = pk2(acc[kt][4 * g + 2], acc[kt][4 * g + 3]); *(v2u*)(stp + 32 * kt + 8 * g) = w; }
    __syncthreads();
}
__device__ __forceinline__ void gla_g2(bf16* ST, const float* DEC, int gid) {
    const int bh = gid >> 13, e = gid & 8191, c = e >> 5, k4 = (e & 31) * 4;
    float s0 = 0.f, s1 = 0.f, s2 = 0.f, s3 = 0.f;
    bf16* p = ST + (((size_t)bh * 64) * 256 + c) * 128 + k4; const float* dp = DEC + (size_t)bh * 64 * 128 + k4;
#pragma unroll 8
    for (int n = 0; n < 64; ++n) {
        const v2u d = *(const v2u*)(p + (size_t)n * 256 * 128); const f32x4 dc = *(const f32x4*)(dp + n * 128);
        v2u w; w.x = pk2(s0, s1); w.y = pk2(s2, s3); *(v2u*)(p + (size_t)n * 256 * 128) = w;
        s0 = dc.x * s0 + bflo(d.x); s1 = dc.y * s1 + bfhi(d.x); s2 = dc.z * s2 + bflo(d.y); s3 = dc.w * s3 + bfhi(d.y); }
}
__device__ __forceinline__ void gla_g3(LAS unsigned char* lds, const bf16* Z, const bf16* ST, bf16* Oabc, const GlaPre pre, const float (&wa)[16], const float ba, const float* gla_norm, int item, int tid) {
    using namespace fa;
    asm volatile("" : "+v"(tid));
    const int wid = __builtin_amdgcn_readfirstlane(tid >> 6), lane = tid & 63, r32 = lane & 31, hf = lane >> 5;
    const int bh = item >> 6, n = item & 63, b = bh >> 2, h = bh & 3; const size_t m0 = (size_t)b * SEQ + 64 * n;
    v4u qraw[2], kraw[2];
#pragma unroll
    for (int i = 0; i < 2; ++i) { const int t = (tid >> 4) + 32 * i, kc = (tid & 15) * 8;
        qraw[i] = *(const v4u*)(Z + (m0 + t) * NABC + ZC_BQ + h * 128 + kc); kraw[i] = *(const v4u*)(Z + (m0 + t) * NABC + ZC_BK + h * 128 + kc); }
    const GlaV vraw = gla_load_v(Z, m0, h, tid);
    gla_cum(lds, pre, wa, ba, tid);
    const LAS float* cum = (const LAS float*)(lds + GL_CUM);
    const float qscale = 0.08838834764831845f;
#pragma unroll
    for (int i = 0; i < 2; ++i) { const int t = (tid >> 4) + 32 * i, kc = (tid & 15) * 8;
        const v4u qw = qraw[i], kw = kraw[i];
        const f32x4 c0 = *(const LAS f32x4*)(cum + t * 128 + kc), c1 = *(const LAS f32x4*)(cum + t * 128 + kc + 4);
        const float e[8] = {__expf(c0.x), __expf(c0.y), __expf(c0.z), __expf(c0.w), __expf(c1.x), __expf(c1.y), __expf(c1.z), __expf(c1.w)};
        const float ei[8] = {__expf(-c0.x), __expf(-c0.y), __expf(-c0.z), __expf(-c0.w), __expf(-c1.x), __expf(-c1.y), __expf(-c1.z), __expf(-c1.w)};
        v4u qo, ko;
        qo.x = pk2(bflo(qw.x) * qscale * e[0], bfhi(qw.x) * qscale * e[1]); qo.y = pk2(bflo(qw.y) * qscale * e[2], bfhi(qw.y) * qscale * e[3]);
        qo.z = pk2(bflo(qw.z) * qscale * e[4], bfhi(qw.z) * qscale * e[5]); qo.w = pk2(bflo(qw.w) * qscale * e[6], bfhi(qw.w) * qscale * e[7]);
        ko.x = pk2(bflo(kw.x) * ei[0], bfhi(kw.x) * ei[1]); ko.y = pk2(bflo(kw.y) * ei[2], bfhi(kw.y) * ei[3]);
        ko.z = pk2(bflo(kw.z) * ei[4], bfhi(kw.z) * ei[5]); ko.w = pk2(bflo(kw.w) * ei[6], bfhi(kw.w) * ei[7]);
        *(LAS v4u*)(lds + GL_QD + KSWZ256(t, kc * 2)) = qo; *(LAS v4u*)(lds + GL_KI + KSWZ256(t, kc * 2)) = ko; }
    gla_write_v(lds, vraw, tid);
    __syncthreads();
    const int ri = wid & 1, cq = wid >> 1;
    bf16x8 qf[8];
#pragma unroll
    for (int d0 = 0; d0 < 8; ++d0) qf[d0] = *(const LAS bf16x8*)(lds + GL_QD + KSWZ256(32 * ri + r32, (d0 * 16 + hf * 8) * 2));
    bf16x8 sfr[2][8];
#pragma unroll
    for (int dd = 0; dd < 2; ++dd) { const bf16* sp = ST + ((size_t)item * 256 + 64 * cq + 32 * dd + r32) * 128 + hf * 8;
#pragma unroll
        for (int d0 = 0; d0 < 8; ++d0) sfr[dd][d0] = *(const bf16x8*)(sp + d0 * 16); }
    f32x16 p0, p1;
#pragma unroll
    for (int r = 0; r < 16; ++r) { p0[r] = 0.f; p1[r] = 0.f; }
#pragma unroll
    for (int d0 = 0; d0 < 8; ++d0) {
        const bf16x8 a0 = *(const LAS bf16x8*)(lds + GL_KI + KSWZ256(r32, (d0 * 16 + hf * 8) * 2)), a1 = *(const LAS bf16x8*)(lds + GL_KI + KSWZ256(32 + r32, (d0 * 16 + hf * 8) * 2));
        p0 = __builtin_amdgcn_mfma_f32_32x32x16_bf16(a0, qf[d0], p0, 0, 0, 0);
        p1 = __builtin_amdgcn_mfma_f32_32x32x16_bf16(a1, qf[d0], p1, 0, 0, 0); }
    { const int irow = 32 * ri + r32;
#pragma unroll
      for (int r = 0; r < 16; ++r) { const int j = crow(r, hf); if (j > irow) p0[r] = 0.f; if (32 + j > irow) p1[r] = 0.f; } }
    bf16x8 pa0, pa1, pa2, pa3;
    FA_PK4(p0, 0, pa0); FA_PK4(p0, 8, pa1); FA_PK4(p1, 0, pa2); FA_PK4(p1, 8, pa3);
    f32x16 o[2];
#pragma unroll
    for (int r = 0; r < 16; ++r) { o[0][r] = 0.f; o[1][r] = 0.f; }
    const int vb = (int)(uintptr_t)(lds + GL_V) + (cq >> 1) * 16384 + v_rd_base(lane);
#pragma unroll
    for (int dd = 0; dd < 2; ++dd) { const int d0v = 2 * (cq & 1) + dd;
        s16x4 l0 = tr_read_dyn(vb + v_rd_off(d0v, 0, 0)), h0 = tr_read_dyn(vb + v_rd_off(d0v, 0, 1)), l1 = tr_read_dyn(vb + v_rd_off(d0v, 1, 0)), h1 = tr_read_dyn(vb + v_rd_off(d0v, 1, 1));
        s16x4 l2 = tr_read_dyn(vb + v_rd_off(d0v, 2, 0)), h2 = tr_read_dyn(vb + v_rd_off(d0v, 2, 1)), l3 = tr_read_dyn(vb + v_rd_off(d0v, 3, 0)), h3 = tr_read_dyn(vb + v_rd_off(d0v, 3, 1));
        asm volatile("s_waitcnt lgkmcnt(0)" : "+v"(l0), "+v"(h0), "+v"(l1), "+v"(h1), "+v"(l2), "+v"(h2), "+v"(l3), "+v"(h3) :: "memory"); FA_SBAR();
        o[dd] = __builtin_amdgcn_mfma_f32_32x32x16_bf16(pa0, GL_PK(l0, h0), o[dd], 0, 0, 0);
        o[dd] = __builtin_amdgcn_mfma_f32_32x32x16_bf16(pa1, GL_PK(l1, h1), o[dd], 0, 0, 0);
        o[dd] = __builtin_amdgcn_mfma_f32_32x32x16_bf16(pa2, GL_PK(l2, h2), o[dd], 0, 0, 0);
        o[dd] = __builtin_amdgcn_mfma_f32_32x32x16_bf16(pa3, GL_PK(l3, h3), o[dd], 0, 0, 0); }
#pragma unroll
    for (int dd = 0; dd < 2; ++dd) {
#pragma unroll
        for (int d0 = 0; d0 < 8; ++d0) o[dd] = __builtin_amdgcn_mfma_f32_32x32x16_bf16(qf[d0], sfr[dd][d0], o[dd], 0, 0, 0); }
    __syncthreads();
    LAS float* Ol = (LAS float*)lds;
#pragma unroll
    for (int dd = 0; dd < 2; ++dd)
#pragma unroll
        for (int r = 0; r < 16; ++r) Ol[(32 * ri + crow(r, hf)) * 256 + 64 * cq + 32 * dd + r32] = o[dd][r];
    __syncthreads();
    { const f32x4 gn = *(const f32x4*)(gla_norm + h * 256 + 4 * lane);
      v2u rw[8]; f32x4 ov[8]; float ss[8];
#pragma unroll
      for (int j = 0; j < 8; ++j) { const int t = wid + NWAVES * j; rw[j] = *(const v2u*)(Z + (m0 + t) * NABC + ZC_BR + h * 256 + 4 * lane); ov[j] = *(const LAS f32x4*)(Ol + t * 256 + 4 * lane); }
      asm volatile("" : "+v"(ov[0]), "+v"(ov[1]), "+v"(ov[2]), "+v"(ov[3]), "+v"(ov[4]), "+v"(ov[5]), "+v"(ov[6]), "+v"(ov[7]) :: "memory");
#pragma unroll
      for (int j = 0; j < 8; ++j) ss[j] = (ov[j].x * ov[j].x + ov[j].y * ov[j].y) + (ov[j].z * ov[j].z + ov[j].w * ov[j].w);
#pragma unroll
      for (int j = 0; j < 8; ++j) ss[j] = wave_sum(ss[j]);
#pragma unroll
      for (int j = 0; j < 8; ++j) { const int t = wid + NWAVES * j; const float rstd = 1.0f / sqrtf(ss[j] * (1.f / 256.f) + EPS);
          const float r0 = bflo(rw[j].x), r1 = bfhi(rw[j].x), r2 = bflo(rw[j].y), r3 = bfhi(rw[j].y);
          v2u w; w.x = pk2(ov[j].x * rstd * gn.x * (r0 * __builtin_amdgcn_rcpf(1.0f + __expf(-r0))), ov[j].y * rstd * gn.y * (r1 * __builtin_amdgcn_rcpf(1.0f + __expf(-r1))));
          w.y = pk2(ov[j].z * rstd * gn.z * (r2 * __builtin_amdgcn_rcpf(1.0f + __expf(-r2))), ov[j].w * rstd * gn.w * (r3 * __builtin_amdgcn_rcpf(1.0f + __expf(-r3))));
          *(v2u*)(Oabc + (m0 + t) * 3072 + 1024 + h * 256 + 4 * lane) = w; } }
    __syncthreads();
}


constexpr int ABIAS_OFF = XSCR_OFF, ASCR_OFF = XSCR_OFF + 12416;
template <int PASS>
__device__ __forceinline__ void attn_a_pass(LAS unsigned char* lds_all, const bf16* ZA, bf16* Oabc, float* ML, const float* rel_bias, int gw, int ngw, int xcd, int inx, int tid) {
    using namespace fa;
    asm volatile("" : "+v"(tid));
    const int wid = __builtin_amdgcn_readfirstlane(tid >> 6);
    constexpr float SCALE = 0.08838834764831845f, C = SCALE * 1.4426950408889634f, THRS = 8.0f / SCALE;
    constexpr int RSTR = (PASS == 1) ? 1 : 16;
    LAS float* tab = (LAS float*)(lds_all + ABIAS_OFF);
    const bool per_head = (ngw % 64 == 0);
    const int h_lo = per_head ? xcd : 0, h_hi = per_head ? h_lo + 1 : 8;
    const int wih = per_head ? (inx * 8 + wid) : gw, nwh = per_head ? (ngw >> 3) : ngw;
    LAS float* wsf = (LAS float*)(lds_all + ASCR_OFF) + wid * 64; LAS float* li_l = wsf; LAS float* al_l = wsf + 32;
    LAS unsigned char* Vl = lds_all + wid * 16384;
#pragma unroll 1
    for (int h = h_lo; h < h_hi; ++h) {
    __syncthreads();
    for (int i = wid * 64 + lane_id_now(); i < 3 * 512; i += NWAVES * 64) { const int g = i >> 9, d = (i & 511) - 192;
        tab[i] = (d >= 0 && d <= 128) ? rel_bias[t5_bucket(d << (2 * g)) * 8 + h] * (1.0f / SCALE) : -1e30f; }
    __syncthreads();
#pragma unroll 1
    for (int q = wih; q < 512; q += nwh) {
        const int lane = lane_id_now(), r32 = lane & 31, hf = lane >> 5;
    const int vb = (int)(uintptr_t)Vl + v_rd_base(lane);
        const int vkey = lane >> 4, vch = lane & 15, vstb = v_st(vkey, vch * 8);
        const int kst0 = vkey * 256 + ((vch * 16) ^ (vkey << 4));
        const int ka0 = r32 * 256 + ((hf ^ (r32 & 7)) << 4);
        int t0, b, c16 = 0;
        if (PASS == 1) { t0 = 32 * (q & 127); b = q >> 7; }
        else { const int l0 = 32 * (q & 7); c16 = (q >> 3) & 15; b = q >> 7; t0 = c16 + 16 * l0; }
        const bf16* Zb = ZA + (size_t)b * SEQ * NA + h * 128; const char* Zbc = (const char*)Zb;
        bf16* Ob = Oabc + ((size_t)b * SEQ + t0) * 3072 + h * 128;
        float* MLb = ML + ((size_t)b * SEQ + t0) * 16 + h * 2;
        bf16x8 qf[8];
        { const bf16* qp = Zb + (size_t)(t0 + RSTR * r32) * NA + ZA_Q + hf * 8;
#pragma unroll
          for (int d0 = 0; d0 < 8; ++d0) qf[d0] = *(const bf16x8*)(qp + d0 * 16); }
        float m_reg = -1e30f, l_reg = 0.f; f32x16 o[4];
        if (PASS != 2) {
#pragma unroll
            for (int d = 0; d < 4; ++d)
#pragma unroll
                for (int r = 0; r < 16; ++r) o[d][r] = 0.f;
        } else {
            const float2 ml = *(const float2*)(MLb + (size_t)(RSTR * r32) * 16); m_reg = ml.x; l_reg = ml.y;
            if (hf == 0) li_l[r32] = l_reg;
            asm volatile("s_waitcnt lgkmcnt(0)" ::: "memory");
            unsigned short ob[4][16];
#pragma unroll
            for (int r = 0; r < 16; ++r) {
                const char* rowp = (const char*)(Ob + (size_t)(RSTR * ((r & 3) + 8 * (r >> 2))) * 3072);
                const unsigned lo = (unsigned)((RSTR * 4 * hf * 3072 + r32) * 2);
#pragma unroll
                for (int d = 0; d < 4; ++d) ob[d][r] = *(const unsigned short*)(rowp + lo + 64 * d); }
#pragma unroll
            for (int d = 0; d < 4; ++d)
                asm volatile("" : "+v"(ob[d][0]), "+v"(ob[d][1]), "+v"(ob[d][2]), "+v"(ob[d][3]), "+v"(ob[d][4]), "+v"(ob[d][5]), "+v"(ob[d][6]), "+v"(ob[d][7]), "+v"(ob[d][8]), "+v"(ob[d][9]), "+v"(ob[d][10]), "+v"(ob[d][11]), "+v"(ob[d][12]), "+v"(ob[d][13]), "+v"(ob[d][14]), "+v"(ob[d][15]) :: "memory");
#pragma unroll
            for (int r = 0; r < 16; ++r) { const float lr = li_l[crow(r, hf)];
#pragma unroll
                for (int d = 0; d < 4; ++d) o[d][r] = __uint_as_float((unsigned)ob[d][r] << 16) * lr; }
        }
#pragma unroll 1
        for (int g = (PASS == 2 ? 1 : 0); g < (PASS == 1 ? 1 : 3); ++g) {
            const int sh = 2 * g, sigma = RSTR >> sh, cls = c16 & ((1 << sh) - 1), base = ((t0 - cls) >> sh) - 128, ntile = (31 * sigma + 192) >> 6;
            const LAS float* tg = tab + g * 512;
            v4u kc[16];
#define AA_LOADKC(tile_) do { _Pragma("unroll") for (int i_ = 0; i_ < 16; ++i_) { int tk = cls + ((base + (tile_) * 64 + 4 * i_ + vkey) << sh); tk = tk < 0 ? 0 : (tk > SEQ - 1 ? SEQ - 1 : tk); \
                    kc[i_] = *(const v4u*)(Zbc + (unsigned)tk * (NA * 2) + (ZA_K + vch * 8) * 2); } } while (0)
#define AA_WRITEKC() do { _Pragma("unroll") for (int i_ = 0; i_ < 16; ++i_) *(LAS v4u*)(Vl + i_ * 1024 + ((i_ & 1) ? (kst0 ^ 64) : kst0)) = kc[i_]; } while (0)
            AA_LOADKC(0); AA_WRITEKC();
#pragma unroll 1
            for (int tile = 0; tile < ntile; ++tile) {
#define AA_LOADV(vv_, i0_) do { _Pragma("unroll") for (int i_ = 0; i_ < 8; ++i_) { int tk = cls + ((base + tile * 64 + 4 * ((i0_) + i_) + vkey) << sh); tk = tk < 0 ? 0 : (tk > SEQ - 1 ? SEQ - 1 : tk); \
                    vv_[i_] = *(const v4u*)(Zbc + (unsigned)tk * (NA * 2) + (ZA_V + vch * 8) * 2); } } while (0)
#define AA_WRITEV(vv_, i0_) do { _Pragma("unroll") for (int i_ = 0; i_ < 8; ++i_) { const int i = (i0_) + i_; *(LAS v4u*)(Vl + vstb + ((i & 1) + 2 * (i >> 2)) * 2048 + ((i >> 1) & 1) * 256) = vv_[i_]; } } while (0)
                v4u va[8];
                AA_LOADV(va, 0);
                FA_SBAR();
                f32x16 p0, p1;
#pragma unroll
                for (int r = 0; r < 16; ++r) { p0[r] = 0.f; p1[r] = 0.f; }
#pragma unroll
                for (int d0 = 0; d0 < 8; ++d0) { const bf16x8 b0 = *(const LAS bf16x8*)(Vl + (ka0 ^ (32 * (d0 & 3))) + (d0 >> 2) * 128), b1 = *(const LAS bf16x8*)(Vl + (ka0 ^ (32 * (d0 & 3))) + (d0 >> 2) * 128 + 8192);
                    p0 = __builtin_amdgcn_mfma_f32_32x32x16_bf16(b0, qf[d0], p0, 0, 0, 0); p1 = __builtin_amdgcn_mfma_f32_32x32x16_bf16(b1, qf[d0], p1, 0, 0, 0); }
                asm volatile("s_waitcnt lgkmcnt(0)" ::: "memory"); FA_SBAR();
                AA_WRITEV(va, 0);
                v4u vbq[8];
                AA_LOADV(vbq, 8);
                FA_SBAR();
                { const int dq = sigma * r32 + 128 - tile * 64, sb = base + tile * 64;
                  const LAS float* tl = tg + (dq + 192 - 4 * hf - 59);
                  float tb0[16], tb1[16];
#pragma unroll
                  for (int r = 0; r < 16; ++r) { const int rc = (r & 3) + 8 * (r >> 2); tb0[r] = tl[59 - rc]; tb1[r] = tl[27 - rc]; }
                  asm volatile("" : "+v"(tb0[0]), "+v"(tb0[1]), "+v"(tb0[2]), "+v"(tb0[3]), "+v"(tb0[4]), "+v"(tb0[5]), "+v"(tb0[6]), "+v"(tb0[7]), "+v"(tb0[8]), "+v"(tb0[9]), "+v"(tb0[10]), "+v"(tb0[11]), "+v"(tb0[12]), "+v"(tb0[13]), "+v"(tb0[14]), "+v"(tb0[15]) :: "memory");
                  asm volatile("" : "+v"(tb1[0]), "+v"(tb1[1]), "+v"(tb1[2]), "+v"(tb1[3]), "+v"(tb1[4]), "+v"(tb1[5]), "+v"(tb1[6]), "+v"(tb1[7]), "+v"(tb1[8]), "+v"(tb1[9]), "+v"(tb1[10]), "+v"(tb1[11]), "+v"(tb1[12]), "+v"(tb1[13]), "+v"(tb1[14]), "+v"(tb1[15]) :: "memory");
#pragma unroll
                  for (int r = 0; r < 16; ++r) { p0[r] += tb0[r]; p1[r] += tb1[r]; }
                  if (sb < 0) {
#pragma unroll
                      for (int r = 0; r < 16; ++r) { const int s = crow(r, hf); if (sb + s < 0) p0[r] = -1e30f; if (sb + s + 32 < 0) p1[r] = -1e30f; } } }
                float mn, alpha; partialSM(p0, p1, m_reg, mn, alpha, C, THRS);
                FA_RESC(alpha, o, al_l, r32, hf);
                bf16x8 pa0, pa1, pa2, pa3; finishSM(p0, p1, alpha, l_reg, pa0, pa1, pa2, pa3); FA_SBAR();
                AA_WRITEV(vbq, 8);
                asm volatile("s_waitcnt lgkmcnt(0)" ::: "memory"); FA_SBAR();
                { const int tn = (tile + 1 < ntile) ? tile + 1 : tile; AA_LOADKC(tn); }
                FA_SBAR();
                pv_d0(o, vb, pa0, pa1, pa2, pa3);
                FA_SBAR();
                if (tile + 1 < ntile) AA_WRITEKC();
            }
#undef AA_LOADKC
#undef AA_WRITEKC
#undef AA_LOADV
#undef AA_WRITEV
        }
        if (hf == 0) li_l[r32] = l_reg;
        asm volatile("s_waitcnt lgkmcnt(0)" ::: "memory");
        float rli[16];
#pragma unroll
        for (int r = 0; r < 16; ++r) rli[r] = __builtin_amdgcn_rcpf(li_l[crow(r, hf)]);
        store_o_bf16(o, rli, Ob, RSTR * 3072, lane, r32, hf);
        if (PASS == 1 && hf == 0) *(float2*)(MLb + (size_t)r32 * 16) = make_float2(m_reg, l_reg);
    }
    }
    __syncthreads();
}

__device__ __forceinline__ void group_barrier(unsigned* cnt, const unsigned target, const bool release, const bool thread0) {
    asm volatile("s_waitcnt vmcnt(0)" ::: "memory");
    __syncthreads();
    if (thread0) {
        asm volatile("" : "+s"(cnt));
        if (release) { __builtin_amdgcn_fence(__ATOMIC_RELEASE, "agent"); asm volatile("s_waitcnt vmcnt(0)" ::: "memory"); }
        (void)xb_add(cnt, 1u);
        for (unsigned sp = 0; xb_ld(cnt) < target && sp < XB_SPIN_CAP; ++sp) __builtin_amdgcn_s_sleep(1);
        __builtin_amdgcn_fence(__ATOMIC_ACQUIRE, "agent");
        asm volatile("s_waitcnt vmcnt(0)" ::: "memory");
    }
    __syncthreads();
}

__global__ void __launch_bounds__(NWAVES * 64, 2) fwd_kernel(Args args) {
    extern __shared__ __attribute__((aligned(16))) unsigned char lds_raw[];
    LAS unsigned char* lds = (LAS unsigned char*)lds_raw;
    volatile LAS unsigned* MISC = (volatile LAS unsigned*)(lds + MISC_OFF);
    const int tid0 = threadIdx.x;
    const int wave0 = __builtin_amdgcn_readfirstlane(tid0 >> 6);
    const int G = gridDim.x, bx = blockIdx.x;
    const int vcu = (G % 8 == 0) ? (bx % 8) * (G / 8) + bx / 8 : bx;
    const int ngw = G * NWAVES;
#define PHASE_LOCALS unsigned long long wsu_ = (unsigned long long)ws0; asm volatile("" : "+s"(wsu_)); unsigned char* ws = (unsigned char*)(GAS unsigned char*)wsu_; unsigned long long xou_ = (unsigned long long)xo0; asm volatile("" : "+s"(xou_)); float* xo = (float*)(GAS float*)xou_; BODY_LOCALS
    unsigned char* const ws0 = args.ws;
    for (int u = tid0; u < (LDS_BYTES - LDSCTL_OFF) / 4; u += NWAVES * 64) ((LAS unsigned*)(lds + LDSCTL_OFF))[u] = 0u;
    __syncthreads();
    LAS unsigned long long* PTAB = (LAS unsigned long long*)(lds + PTAB_OFF);
    if (tid0 == 0) {
#define PT(k) PTAB[k] = (unsigned long long)args.in[k];
        PT(0) PT(1) PT(2) PT(3) PT(4) PT(5) PT(6) PT(7) PT(8) PT(9) PT(10) PT(11) PT(12) PT(13) PT(14) PT(15) PT(16) PT(17) PT(18) PT(19) PT(20) PT(21) PT(22) PT(23) PT(24) PT(25) PT(26)
#undef PT
    }
    __syncthreads();
#if MK_ONE_LAUNCH
    { const XcdBarrier bar0 = xcd_barrier_post((unsigned*)(ws0 + WS_CTL) + CW_BAR, MISC + 8);
      unsigned* xp = (unsigned*)(ws0 + WS_CTL) + CW_XID + bx; unsigned xv = bar0.x + 1u; asm volatile("" : "+s"(xp), "+s"(xv));
      if (tid0 == 0) *xp = xv; }
#define GRID_BAR() do { XcdBarrier bar_; bar_.bar = (unsigned*)(ws0 + WS_CTL) + CW_BAR; bar_.x = xb_xcc_id(); bar_.st = MISC + 8; xcd_barrier(bar_, wave0 == 0 && lane_id_now() == 0); } while (0)
#define GROUP_SEAM(k, idx) do { if (IN(k) && IN((k) + 1)) { const bool g4_ = (G == 256); \
        group_barrier((unsigned*)(ws0 + WS_CTL) + CW_GRP + (g4_ ? 32 * (bx & 63) : 0), (g4_ ? 4u : (unsigned)G) * (unsigned)(5 * l + (idx) + 1), MISC[16] == 0u, wave0 == 0 && lane_id_now() == 0); } } while (0)
#else
#define GRID_BAR() do { } while (0)
#define GROUP_SEAM(k, idx) do { } while (0)
#endif
#if !MK_ONE_LAUNCH
    const int lo = args.ph_lo, hi = args.ph_hi;
#endif
#if MK_ONE_LAUNCH
#define IN(k) true
#else
#define IN(k) (lo <= (k) && (k) < hi)
#endif
#define SEAM(k) do { if (IN(k) && IN((k) + 1)) GRID_BAR(); } while (0)

    float* const xo0 = args.out;
#define INP(k) ldptr(PTAB, (k))
#define WSP(off) ((bf16*)(ws + (off)))
    LAS unsigned char* ring = lds + RING_OFF;
#define BODY_LOCALS int tid = wave0 * 64 + lane_id_now(); const int lane = tid & 63; const int wave = __builtin_amdgcn_readfirstlane(tid >> 6); const int gw = vcu * NWAVES + wave; (void)lane; (void)gw; (void)wave;

#define PANEL_RS(S_, same_) bool same_ = true; { int pm_c_ = -1; pg8::Unit u_; for (int i_ = 0; S_.next(i_, u_); ++i_) { if (u_.br == 3) continue; if (pm_c_ < 0) pm_c_ = u_.pm; else if (u_.pm != pm_c_) same_ = false; } \
        if (same_ && pm_c_ >= 0) { const f32x4* p_ = (const f32x4*)((const float*)(ws + WS_SS) + ((size_t)pm_c_ * 256 + (tid >> 1)) * 32 + (tid & 1) * 16); float s_ = 0.f; \
            _Pragma("unroll") for (int j_ = 0; j_ < 4; ++j_) { const f32x4 v_ = p_[j_]; s_ += (v_[0] + v_[1]) + (v_[2] + v_[3]); } \
            s_ += lane_xor1(s_); if ((tid & 1) == 0) ((LAS float*)(lds + RSL_OFF))[tid >> 1] = 1.0f / sqrtf(s_ * (1.f / 2048.f) + EPS); } \
        __syncthreads(); }
#define RS_FROM_SS() do { const float* ss_ = (const float*)(ws + WS_SS); float* rs_ = (float*)(ws + WS_RS); \
        for (int m_ = 2 * gw + (lane >> 5); m_ < M; m_ += 2 * ngw) { float s_ = ss_[(size_t)m_ * 32 + (lane & 31)]; \
            s_ += __shfl_xor(s_, 1); s_ += __shfl_xor(s_, 2); s_ += __shfl_xor(s_, 4); s_ += __shfl_xor(s_, 8); s_ += __shfl_xor(s_, 16); \
            if ((lane & 31) == 0) rs_[m_] = 1.0f / sqrtf(s_ * (1.f / 2048.f) + EPS); } } while (0)
    for (int l = 0; l < 2; ++l) {
        const int P = l * PH_PER_LAYER;

        if (((PHASE_MASK >> 0) & 1) && IN(P + 0)) for (int rep_ = 0; rep_ < 1 + ((PHASE_TWICE >> 0) & 1); ++rep_) { PHASE_LOCALS
            LAS float* scr = (LAS float*)(ring + wave * 16384);
            const float* w_in = INP(4) + (size_t)l * D * DIN_SRC;
            constexpr int TOT = 32 * 160 + 32 * 32 + 32 * 34 + 32 * 1 + 32 * 192 + 8 * 48 + 8 * 64 + 3 * 16 * 64 + 32 * 64 + 32 * 128 + 32 * 64 + 2 * 32 * 176 + 88 * 64;
#ifndef REP0
#define REP0 1
#endif
#pragma unroll 1
            for (int rep0 = 0; rep0 < REP0; ++rep0)
            for (int it = gw; it < TOT; it += ngw) {
                int r = it;
                if (seg_item<MAP_LIN>(r, w_in, D, DIN_SRC, 0, 5120, WSP(WS_WIN), D, 0, 0, scr, lane, INP(3) + l * D)) continue;
                if (seg_item<MAP_LIN>(r, w_in, D, DIN_SRC, 5136, 1024, WSP(WS_WIN), D, 5120, 0, scr, lane, INP(3) + l * D)) continue;
                if (seg_item<MAP_LIN>(r, w_in, D, DIN_SRC, 6160, 1088, WSP(WS_WIN), D, 6144, 0, scr, lane, INP(3) + l * D)) continue;
                if (seg_item<MAP_LIN>(r, w_in, D, DIN_SRC, 5120, 16, WSP(WS_WIN), D, 7232, 0, scr, lane, INP(3) + l * D)) continue;
                if (seg_item8(r, w_in, D, DIN_SRC, 7248, 6144, ws + WS_W8, scr, lane, INP(3) + l * D)) continue;
                if (seg_item<MAP_LIN>(r, INP(10) + (size_t)l * 512 * 1536, 512, 1536, 0, 1536, WSP(WS_WQB), 512, 0, 0, scr, lane)) continue;
                if (seg_item<MAP_LIN>(r, INP(12) + (size_t)l * 512 * 2048, 512, 2048, 0, 2048, WSP(WS_WKVB), 512, 0, 0, scr, lane)) continue;
                if (seg_item<MAP_LIN>(r, INP(13) + (size_t)l * 1024 * 2048, 1024, 2048, 0, 2048, WSP(WS_WUP), 3072, 0, 0, scr, lane)) continue;
                if (seg_item<MAP_LIN>(r, INP(14) + (size_t)l * 1024 * 2048, 1024, 2048, 0, 2048, WSP(WS_WUP), 3072, 0, 1024, scr, lane)) continue;
                if (seg_item<MAP_LIN>(r, INP(15) + (size_t)l * 1024 * 2048, 1024, 2048, 0, 2048, WSP(WS_WUP), 3072, 0, 2048, scr, lane)) continue;
                if (seg_item<MAP_LIN>(r, INP(16) + (size_t)l * D * D, D, D, 0, D, WSP(WS_WO), D, 0, 0, scr, lane)) continue;
                if (seg_item<MAP_LIN>(r, INP(20) + (size_t)l * D * 4096, D, 4096, 0, 4096, WSP(WS_WXKV), D, 0, 0, scr, lane)) continue;
                if (seg_item<MAP_LIN>(r, INP(21) + (size_t)l * D * D, D, D, 0, D, WSP(WS_WXO), D, 0, 0, scr, lane)) continue;
                if (seg_item<MAP_GATE>(r, INP(23) + (size_t)l * D * DFF, D, DFF, 0, DFF, WSP(WS_WFF), LDW, 0, 0, scr, lane, INP(22) + l * D)) continue;
                if (seg_item<MAP_UP>(r, INP(24) + (size_t)l * D * DFF, D, DFF, 0, DFF, WSP(WS_WFF), LDW, 0, 0, scr, lane, INP(22) + l * D)) continue;
                seg_item<MAP_LIN>(r, INP(25) + (size_t)l * DFF * D, DFF, D, 0, D, WSP(WS_WDN), LDACT, 0, 0, scr, lane);
            }
            { const float* wq = INP(19) + (size_t)l * D * D; const float* gq = INP(17) + l * D;
              for (int i = gw * 64 + lane; i < D * D / 8; i += ngw * 64) { const f32x4 a = *(const f32x4*)(wq + (size_t)i * 8), bq = *(const f32x4*)(wq + (size_t)i * 8 + 4); const float gg = gq[i >> 8];
                  v4u o; o.x = pk2(a.x * gg, a.y * gg); o.y = pk2(a.z * gg, a.w * gg); o.z = pk2(bq.x * gg, bq.y * gg); o.w = pk2(bq.z * gg, bq.w * gg); ((v4u*)WSP(WS_WXQ))[i] = o; } }
            { unsigned zz = 0u; asm volatile("" : "+v"(zz)); for (int i = gw * 64 + lane; i < 176 * D / 8; i += ngw * 64) ((v4u*)(WSP(WS_WIN) + (size_t)7248 * D))[i] = (v4u){zz, zz, zz, zz}; }
            if (l == 0) { for (int m = gw; m < M; m += ngw) gain_row_bf16(INP(0) + (size_t)m * D, INP(3), WSP(WS_H) + (size_t)m * D, (float*)(ws + WS_SS) + (size_t)m * 32, ws + WS_H8 + (size_t)m * 2048, lane); }
            for (int m = gw; m < MROWS; m += ngw) rms_row_bf16(INP(1) + (size_t)m * D, INP(18) + l * D, WSP(WS_MEMN) + (size_t)m * D, lane);
            if (l == 0) for (int i = gw * 64 + lane; i < SEQ * 32; i += ngw * 64) { const int pos = i >> 5, f = i & 31; const float inv = powf(10000.0f, -(float)(2 * f) / 64.0f); const float ang = (float)pos * inv;
                ((float*)(ws + WS_ROPE))[i] = cosf(ang); ((float*)(ws + WS_ROPE) + SEQ * 32)[i] = sinf(ang); }
        }
        SEAM(P + 0);
        if (((PHASE_MASK >> 1) & 1) && IN(P + 1)) for (int rep_ = 0; rep_ < 1 + ((PHASE_TWICE >> 1) & 1); ++rep_) { PHASE_LOCALS
            pg8::Gemm g{WSP(WS_H), WSP(WS_WIN), D, D, D};
            pg8::WinOrder S{G, bx, (long)WS_MEMN - (long)WS_H, (long)WS_WXKV - (long)WS_WIN};
            PANEL_RS(S, same)
            pg8::Gemm g8{(const bf16*)(ws + WS_H8), (const bf16*)(ws + WS_W8) - (size_t)29 * 256 * 1024, 1024, 1024, 1024}; pg8::GateOrder S8{G, bx};
            if (same) { pg8::EpiWin<true> E{WSP(WS_ZA), WSP(WS_ZABC), WSP(WS_ZG), WSP(WS_MEMKV), nullptr, INP(5) + (size_t)l * 3 * D, (const LAS float*)(lds + RSL_OFF)};
                        pg8::gemm_phase<pg8::EpiWin<true>, pg8::WinOrder, true>(ring, g, S, E, tid);
                        E.gsc = F8_GSC; pg8::gemm_phase<pg8::EpiWin<true>, pg8::GateOrder, true, true>(ring, g8, S8, E, tid); }
            else      { pg8::EpiWin<false> E{WSP(WS_ZA), WSP(WS_ZABC), WSP(WS_ZG), WSP(WS_MEMKV), (const float*)(ws + WS_SS), INP(5) + (size_t)l * 3 * D, nullptr};
                        pg8::gemm_phase<pg8::EpiWin<false>, pg8::WinOrder, true>(ring, g, S, E, tid);
                        E.gsc = F8_GSC; pg8::gemm_phase<pg8::EpiWin<false>, pg8::GateOrder, true, true>(ring, g8, S8, E, tid); }
        }
        SEAM(P + 1);
        if (((PHASE_MASK >> 2) & 1) && IN(P + 2)) for (int rep_ = 0; rep_ < 1 + ((PHASE_TWICE >> 2) & 1); ++rep_) { PHASE_LOCALS
            { BODY_LOCALS
              for (int it = vcu; it < 1024; it += G) { float wa[16], ba; gla_alpha_load(wa, ba, INP(6) + (size_t)l * 16 * 512, INP(7) + l * 512, (it >> 6) & 3, tid);
                  const GlaPre cur = gla_blr_load(WSP(WS_ZABC), (size_t)(it >> 8) * SEQ + 64 * (it & 63), tid);
                  gla_g1(ring, WSP(WS_ZABC), ((bf16*)xo), (float*)(ws + WS_GLADEC), cur, wa, ba, it, tid); } }
            { BODY_LOCALS attn_a_pass<1>(ring, WSP(WS_ZA), WSP(WS_OABC), (float*)(ws + WS_AML), INP(2), gw, ngw, bx & 7, bx >> 3, tid); }
            if (rep_ == 0) { BODY_LOCALS mla_prep(WSP(WS_ZABC), INP(9) + l * 512, INP(11) + l * 512, ((float*)(ws + WS_ROPE)), ((float*)(ws + WS_ROPE) + SEQ * 32), gw, ngw, lane); }
        }
        SEAM(P + 2);
        if (((PHASE_MASK >> 3) & 1) && IN(P + 3)) for (int rep_ = 0; rep_ < 1 + ((PHASE_TWICE >> 3) & 1); ++rep_) { PHASE_LOCALS
            { BODY_LOCALS attn_a_pass<2>(ring, WSP(WS_ZA), WSP(WS_OABC), (float*)(ws + WS_AML), INP(2), gw, ngw, bx & 7, bx >> 3, tid); }
            { BODY_LOCALS for (int gid = vcu * (NWAVES * 64) + tid; gid < 16 * 8192; gid += G * NWAVES * 64) gla_g2(((bf16*)xo), (const float*)(ws + WS_GLADEC), gid); }
#define MLAKV_D (((bf16*)xo) + (size_t)32 * 1024 * 1024)
            { BODY_LOCALS pg8::Gemm g{WSP(WS_ZABC) + ZC_CQA, WSP(WS_WQB), NABC, 512, 512};
              pg8::UpOrder S{G, bx, (long)(ZC_CKVA - ZC_CQA) * 2, (long)WS_WKVB - (long)WS_WQB};
              pg8::EpiUp E{WSP(WS_MLAQ), MLAKV_D};
              pg8::gemm_phase<pg8::EpiUp, pg8::UpOrder, true>(ring, g, S, E, tid); }
        }
        SEAM(P + 3);
        if (((PHASE_MASK >> 4) & 1) && IN(P + 4)) for (int rep_ = 0; rep_ < 1 + ((PHASE_TWICE >> 4) & 1); ++rep_) { PHASE_LOCALS
            { BODY_LOCALS
              for (int it = vcu; it < 1024; it += G) { float wa[16], ba; gla_alpha_load(wa, ba, INP(6) + (size_t)l * 16 * 512, INP(7) + l * 512, (it >> 6) & 3, tid);
                  const GlaPre cur = gla_blr_load(WSP(WS_ZABC), (size_t)(it >> 8) * SEQ + 64 * (it & 63), tid);
                  gla_g3(ring, WSP(WS_ZABC), ((bf16*)xo), WSP(WS_OABC), cur, wa, ba, INP(8) + l * 1024, it, tid); } }
        }
        if (((PHASE_MASK >> 5) & 1) && IN(P + 5)) for (int rep_ = 0; rep_ < 1 + ((PHASE_TWICE >> 5) & 1); ++rep_) { PHASE_LOCALS
            { BODY_LOCALS mla_attn_phase(ring, WSP(WS_MLAQ), MLAKV_D, WSP(WS_ZABC), WSP(WS_OABC), ((float*)(ws + WS_ROPE)), ((float*)(ws + WS_ROPE) + SEQ * 32), vcu, G, tid); }
            __syncthreads();
            { BODY_LOCALS pg8::Gemm g2{WSP(WS_MEMKV), WSP(WS_WXQ), 4096, D, 512}; pg8::KwOrder S2{G, bx}; pg8::EpiXW E2{WSP(WS_KW), 0};
              pg8::gemm_phase<pg8::EpiXW, pg8::KwOrder, true>(ring, g2, S2, E2, tid); }
            { BODY_LOCALS pg8::Gemm g3{WSP(WS_WXO), WSP(WS_MEMKV), D, 4096, 512}; pg8::VwOrder S3{G, (bx + 128) % G}; pg8::EpiXW E3{WSP(WS_VW), 1};
              pg8::gemm_phase<pg8::EpiXW, pg8::VwOrder, true>(ring, g3, S3, E3, tid); } }
        SEAM(P + 5);
#if MK_ONE_LAUNCH
        if (l == 0) {
            if (wave0 == 0 && lane_id_now() == 0) { unsigned* xid = (unsigned*)(ws0 + WS_CTL) + CW_XID + (bx & 63); asm volatile("" : "+s"(xid));
                const unsigned x0 = xb_ld(xid), x1 = xb_ld(xid + 64), x2 = xb_ld(xid + 128), x3 = xb_ld(xid + 192);
                MISC[16] = (G == 256 && x0 != 0u && x0 == x1 && x0 == x2 && x0 == x3) ? 1u : 0u; }
            __syncthreads(); }
#endif
        if (((PHASE_MASK >> 6) & 1) && IN(P + 6)) for (int rep_ = 0; rep_ < 1 + ((PHASE_TWICE >> 6) & 1); ++rep_) { PHASE_LOCALS
            pg8::Gemm g{WSP(WS_OABC), WSP(WS_WUP), 3072, 3072, 1024}; pg8::StaticOrder S; S.init(M, D, G, bx, 3, 1024);
            pg8::EpiMerge E{WSP(WS_MERGED), WSP(WS_ZG)};
            pg8::gemm_phase<pg8::EpiMerge, pg8::StaticOrder, true>(ring, g, S, E, tid);
        }
        GROUP_SEAM(P + 6, 0);
        if (((PHASE_MASK >> 7) & 1) && IN(P + 7)) for (int rep_ = 0; rep_ < 1 + ((PHASE_TWICE >> 7) & 1); ++rep_) { PHASE_LOCALS
            pg8::Gemm g{WSP(WS_MERGED), WSP(WS_WO), D, D, D}; pg8::StaticOrder S; S.init(M, D, G, bx);
            pg8::EpiResB E{WSP(WS_H), (float*)(ws + WS_SS)};
            pg8::gemm_phase<pg8::EpiResB, pg8::StaticOrder, false>(ring, g, S, E, tid);
        }
        GROUP_SEAM(P + 7, 1);
        if (((PHASE_MASK >> 9) & 1) && IN(P + 9)) for (int rep_ = 0; rep_ < 1 + ((PHASE_TWICE >> 9) & 1); ++rep_) { PHASE_LOCALS
            pg8::Gemm g{WSP(WS_H), WSP(WS_KW), D, D, D}; pg8::BatchOrder S; S.init(M, 1024, G, bx); S.bstride = (long)1024 * 2048 * 2;
            PANEL_RS(S, same)
            if (same) { pg8::EpiSoftmaxP<true> E{WSP(WS_P), nullptr, (PG8_LAS float*)(lds + XSCR_OFF), (const LAS float*)(lds + RSL_OFF)};
                        pg8::gemm_phase<pg8::EpiSoftmaxP<true>, pg8::BatchOrder, true>(ring, g, S, E, tid); }
            else      { pg8::EpiSoftmaxP<false> E{WSP(WS_P), (const float*)(ws + WS_SS), (PG8_LAS float*)(lds + XSCR_OFF), nullptr};
                        pg8::gemm_phase<pg8::EpiSoftmaxP<false>, pg8::BatchOrder, true>(ring, g, S, E, tid); }
        }
        GROUP_SEAM(P + 9, 2);
        if (((PHASE_MASK >> 11) & 1) && IN(P + 11)) for (int rep_ = 0; rep_ < 1 + ((PHASE_TWICE >> 11) & 1); ++rep_) { PHASE_LOCALS
            pg8::Gemm g{WSP(WS_P), WSP(WS_VW), pg8::LDP, 1024, 1024}; pg8::BatchOrder S; S.init(M, D, G, bx); S.bstride = (long)2048 * 1024 * 2;
            pg8::EpiResB E{WSP(WS_H), (float*)(ws + WS_SS)};
            pg8::gemm_phase<pg8::EpiResB, pg8::BatchOrder, false>(ring, g, S, E, tid);
        }
        GROUP_SEAM(P + 11, 3);
        if (((PHASE_MASK >> 13) & 1) && IN(P + 13)) for (int rep_ = 0; rep_ < 1 + ((PHASE_TWICE >> 13) & 1); ++rep_) { PHASE_LOCALS
            pg8::Gemm g{WSP(WS_H), WSP(WS_WFF), D, LDW, D}; pg8::StaticOrder S; S.init(M, NFF2, G, bx);
            PANEL_RS(S, same)
            if (same) { pg8::EpiSwiGLURS<true> E{WSP(WS_ACT), NG, nullptr, (const LAS float*)(lds + RSL_OFF)};
                        pg8::gemm_phase<pg8::EpiSwiGLURS<true>, pg8::StaticOrder, true>(ring, g, S, E, tid); }
            else      { pg8::EpiSwiGLURS<false> E{WSP(WS_ACT), NG, (const float*)(ws + WS_SS), nullptr};
                        pg8::gemm_phase<pg8::EpiSwiGLURS<false>, pg8::StaticOrder, true>(ring, g, S, E, tid); }
        }
        GROUP_SEAM(P + 13, 4);
        if (((PHASE_MASK >> 14) & 1) && IN(P + 14)) for (int rep_ = 0; rep_ < 1 + ((PHASE_TWICE >> 14) & 1); ++rep_) { PHASE_LOCALS
            pg8::Gemm g{WSP(WS_ACT), WSP(WS_WDN), NG  , LDACT, DFF}; pg8::StaticOrder S; S.init(M, D, G, bx);
            pg8::EpiResB E{WSP(WS_H), (float*)(ws + WS_SS), (l == 0) ? (ws + WS_H8) : nullptr}; pg8::gemm_phase<pg8::EpiResB, pg8::StaticOrder, false>(ring, g, S, E, tid);
        }
        if (l == 0) SEAM(P + 14); else GROUP_SEAM(P + 14, 5);
    }
    if (IN(2 * PH_PER_LAYER)) { PHASE_LOCALS
        const float* gfin = INP(26); f32x4 gv[8];
#pragma unroll
        for (int j = 0; j < 4; ++j) { gv[2 * j] = *(const f32x4*)(gfin + 8 * (lane + 64 * j)); gv[2 * j + 1] = *(const f32x4*)(gfin + 8 * (lane + 64 * j) + 4); }
        const bool g4 = (G == 256) && MK_ONE_LAUNCH;
        int m = g4 ? (256 * (8 * (bx & 7) + ((bx >> 3) & 7)) + 64 * (bx >> 6) + 8 * wave) : gw;
        const int step = g4 ? 1 : ngw, cnt = g4 ? 8 : (M - gw + ngw - 1) / ngw;
        for (int i = 0; i < cnt; ++i, m += step) final_row(WSP(WS_H) + (size_t)m * D, (const float*)(ws + WS_SS) + (size_t)m * 32, gv, xo + (size_t)m * D, lane); }
#undef IN
#undef SEAM
}

extern "C" void kernel_launch(void* const* d_in, const int* in_sizes, int n_in, void* d_out, int out_size, void* d_ws, size_t ws_size, hipStream_t stream) {
    static int grid = 0;
    if (grid == 0) {
        if (n_in != 27 || out_size != M * D || ws_size < WS_END) { fprintf(stderr, "kernel_launch: unexpected shapes (n_in %d out %d ws %zu)\n", n_in, out_size, ws_size); grid = -1; return; }
        int dev = 0, cus = 0, per_cu = 0;
        if (hipGetDevice(&dev) != hipSuccess || hipDeviceGetAttribute(&cus, hipDeviceAttributeMultiprocessorCount, dev) != hipSuccess) { grid = -1; return; }
        if (hipFuncSetAttribute((const void*)fwd_kernel, hipFuncAttributeMaxDynamicSharedMemorySize, LDS_BYTES) != hipSuccess) { grid = -1; return; }
        if (hipOccupancyMaxActiveBlocksPerMultiprocessor(&per_cu, (const void*)fwd_kernel, NWAVES * 64, LDS_BYTES) != hipSuccess || per_cu < 1)
            fprintf(stderr, "kernel_launch: occupancy query reports %d workgroups per CU\n", per_cu);
        (void)hipGetLastError();
        grid = cus;
    }
    if (grid < 0) return;
    if (hipMemsetAsync((char*)d_ws + WS_CTL, 0, CTL_ZERO_BYTES, stream) != hipSuccess) return;
    Args a{};
    for (int i = 0; i < 27; ++i) a.in[i] = (const float*)d_in[i];
    a.out = (float*)d_out; a.ws = (unsigned char*)d_ws;
#if MK_ONE_LAUNCH
    a.ph_lo = 0; a.ph_hi = N_PHASES;
    hipLaunchKernelGGL(fwd_kernel, dim3(grid), dim3(NWAVES * 64), LDS_BYTES, stream, a);
#else
    for (int p = 0; p < N_PHASES; ++p) { a.ph_lo = p; a.ph_hi = p + 1; hipLaunchKernelGGL(fwd_kernel, dim3(grid), dim3(NWAVES * 64), LDS_BYTES, stream, a); }
#endif
}
```

```cpp
#include <hip/hip_runtime.h>
#include <cstdio>
#include <cstdint>

#ifndef A_SINGLE
#define A_SINGLE 0
#endif
#ifndef GLA_NAIVE
#define GLA_NAIVE 0
#endif
#ifndef PHASE_TWICE
#define PHASE_TWICE 0
#endif
#ifndef PHASE_MASK
#define PHASE_MASK 0x7fff
#endif
#ifndef MK_ONE_LAUNCH
#define MK_ONE_LAUNCH 1
#endif

template <int CTRL> __device__ __forceinline__ float dpp_f(float v) { return __uint_as_float((unsigned)__builtin_amdgcn_update_dpp(0, (int)__float_as_uint(v), CTRL, 0xF, 0xF, true)); }
__device__ __forceinline__ float lane_xor1(float v) { return dpp_f<0xB1>(v); }
__device__ __forceinline__ float sum_xor16(float v) { auto r = __builtin_amdgcn_permlane16_swap(__float_as_uint(v), __float_as_uint(v), false, false); return __uint_as_float(r[0]) + __uint_as_float(r[1]); }
__device__ __forceinline__ float sum_xor32(float v) { auto r = __builtin_amdgcn_permlane32_swap(__float_as_uint(v), __float_as_uint(v), false, false); return __uint_as_float(r[0]) + __uint_as_float(r[1]); }
__device__ __forceinline__ float max_xor16(float v) { auto r = __builtin_amdgcn_permlane16_swap(__float_as_uint(v), __float_as_uint(v), false, false); return fmaxf(__uint_as_float(r[0]), __uint_as_float(r[1])); }
__device__ __forceinline__ float max_xor32(float v) { auto r = __builtin_amdgcn_permlane32_swap(__float_as_uint(v), __float_as_uint(v), false, false); return fmaxf(__uint_as_float(r[0]), __uint_as_float(r[1])); }
__device__ __forceinline__ float wave_sum(float v) { v += dpp_f<0xB1>(v); v += dpp_f<0x4E>(v); v += dpp_f<0x141>(v); v += dpp_f<0x140>(v); return sum_xor32(sum_xor16(v)); }
__device__ __forceinline__ float wave_max(float v) { v = fmaxf(v, dpp_f<0xB1>(v)); v = fmaxf(v, dpp_f<0x4E>(v)); v = fmaxf(v, dpp_f<0x141>(v)); v = fmaxf(v, dpp_f<0x140>(v)); return max_xor32(max_xor16(v)); }

namespace pg8 {
#define PG8_LAS __attribute__((address_space(3)))
typedef unsigned short bf16_t;
typedef short bf16x8 __attribute__((ext_vector_type(8)));
typedef float f32x4 __attribute__((ext_vector_type(4)));
typedef int i32x4 __attribute__((ext_vector_type(4)));
typedef int i32x8 __attribute__((ext_vector_type(8)));
typedef unsigned u32x4 __attribute__((ext_vector_type(4)));
typedef unsigned u32x2 __attribute__((ext_vector_type(2)));
constexpr int BM = 256, BK = 64, HALF = 128, HTB = HALF * BK * 2, STAGE_BYTES = 8 * HTB, NXCD = 8, WGM = 8;

__host__ __device__ __forceinline__ int lds_byte(int r, int c) { const int st = (r >> 4) * 2 + (c >> 5), rr = r & 15, cc = c & 31, ob = rr * 64 + cc * 2; return st * 1024 + (ob ^ (((ob >> 9) & 1) << 5)); }
__host__ __device__ __forceinline__ void stage_rc(int b, int& R, int& C) { const int st = b / 1024, sb = b % 1024, swz = sb ^ (((sb >> 9) & 1) << 5); R = (st >> 1) * 16 + swz / 64; C = (st & 1) * 32 + (swz % 64) / 2; }
__host__ __device__ __forceinline__ int perm32(int rho) { const int n = rho >> 4, i = rho & 15; return 8 * (i >> 2) + 4 * n + (i & 3); }

struct Unit { int pm, pn, ka, kb, br; long aoff, boff; };
struct Gemm { const bf16_t* A; const bf16_t* Bt; int lda, ldb, K; };

__device__ __forceinline__ void map_tile(int L, int nM, int nN, int& pm, int& pn) {
    const int nwg = nM * nN; int wgid = L; { const int q = nwg / NXCD, r = nwg % NXCD, xcd = wgid % NXCD, off = wgid / NXCD; wgid = (xcd < r ? xcd * (q + 1) : r * (q + 1) + (xcd - r) * q) + off; }
    const int nig = WGM * nN, gid = wgid / nig, fm = gid * WGM, gsz = (nM - fm) < WGM ? (nM - fm) : WGM;
    pm = fm + ((wgid % nig) % gsz); pn = (wgid % nig) / gsz;
}
struct StaticOrder {
    int nM, nN, nwg, G, c, nbr, kbr;
    __device__ __forceinline__ void init(int M, int N, int G_, int c_, int nbr_ = 1, int kbr_ = 0) { nM = M / BM; nN = N / BM; nwg = nM * nN; G = G_; c = c_; nbr = nbr_; kbr = kbr_; }
    __device__ __forceinline__ bool next(int i, Unit& u) const {
        const int it = i / nbr, br = i - it * nbr;
        const long L = (long)it * G + c; if (L >= nwg) return false;
        map_tile((int)L, nM, nN, u.pm, u.pn); u.br = br; u.ka = br * kbr; u.kb = br * kbr; u.aoff = 0; u.boff = 0; return true;
    }
    __device__ __forceinline__ void a_ready(const Unit&) const {}
    __device__ __forceinline__ void done(const Unit&) const {}
};


struct WinOrder {
    int G, c; long aoff3, boff3;
    __device__ __forceinline__ bool next(int i, Unit& u) const {
        const int L = i * G + c; u.ka = 0; u.kb = 0;
        if (L < 64 * 29) { map_tile(L, 64, 29, u.pm, u.pn); u.br = (u.pn < 12) ? 0 : 1; u.aoff = 0; u.boff = 0; return true; }
        const int j = L - 64 * 29; if (j >= 64) return false;
        u.pm = j >> 4; u.pn = j & 15; u.br = 3; u.aoff = aoff3; u.boff = boff3; return true;
    }
    __device__ __forceinline__ void a_ready(const Unit&) const {}
    __device__ __forceinline__ void done(const Unit&) const {}
};
struct GateOrder {
    int G, c;
    __device__ __forceinline__ bool next(int i, Unit& u) const {
        u.ka = 0; u.kb = 0; u.br = 2; u.aoff = 0; u.boff = 0;
        if (G == 256) {
            const int j = c >> 6, cnt = (j < 2) ? 5 : 7, base = (j == 0) ? 0 : ((j == 1) ? 5 : ((j == 2) ? 10 : 17));
            if (i >= cnt) return false;
            u.pm = 8 * (c & 7) + ((c >> 3) & 7); u.pn = 29 + base + i; return true; }
        const int L = i * G + c; if (L >= 64 * 24) return false;
        map_tile(L, 64, 24, u.pm, u.pn); u.pn += 29; return true; }
    __device__ __forceinline__ void a_ready(const Unit&) const {}
    __device__ __forceinline__ void done(const Unit&) const {}
};
struct UpOrder {
    int G, c; long aoff1, boff1;
    __device__ __forceinline__ bool next(int i, Unit& u) const {
        const int L = i * G + c; u.ka = 0; u.kb = 0;
        if (L < 64 * 6) { map_tile(L, 64, 6, u.pm, u.pn); u.br = 0; u.aoff = 0; u.boff = 0; return true; }
        const int j = L - 64 * 6; if (j >= 64 * 8) return false;
        map_tile(j, 64, 8, u.pm, u.pn); u.br = 1; u.aoff = aoff1; u.boff = boff1; return true;
    }
    __device__ __forceinline__ void a_ready(const Unit&) const {}
    __device__ __forceinline__ void done(const Unit&) const {}
};
__device__ __forceinline__ unsigned cvt_pk_bf16(float lo, float hi) { unsigned r; asm volatile("v_cvt_pk_bf16_f32 %0, %1, %2" : "=v"(r) : "v"(lo), "v"(hi)); return r; }
__device__ __forceinline__ float bf_lo(unsigned w) { return __uint_as_float(w << 16); }
__device__ __forceinline__ float bf_hi(unsigned w) { return __uint_as_float(w & 0xffff0000u); }
__device__ __forceinline__ float fast_sigmoid(float x) { return __builtin_amdgcn_rcpf(1.0f + __builtin_amdgcn_exp2f(-1.44269504089f * x)); }

__device__ __forceinline__ float row_rstd(const float* SS, size_t row) {
    const f32x4* p = (const f32x4*)(SS + row * 32); float s = 0.f;
#pragma unroll
    for (int j = 0; j < 8; ++j) { const f32x4 v = p[j]; s += (v[0] + v[1]) + (v[2] + v[3]); }
    return 1.0f / sqrtf(s * (1.0f / 2048.0f) + 1e-6f);
}
struct EpiBf16 {
    static constexpr bool PERM = true;
    bf16_t* O; int ldc;
    __device__ __forceinline__ void operator()(const f32x4 (&acc)[2][2][4][2], const Unit& u, int wr, int wc, int fr, int fq) const {
        const int row0 = u.pm * BM + wr * 64 + fr, col0 = u.pn * BM + wc * 32 + 8 * fq;
        float zf = 0.f; asm volatile("" : "+v"(zf));
#pragma unroll
        for (int ai = 0; ai < 2; ++ai)
#pragma unroll
            for (int m = 0; m < 4; ++m) { bf16_t* rowp = O + (size_t)(row0 + ai * HALF + m * 16) * ldc + col0;
#pragma unroll
                for (int bj = 0; bj < 2; ++bj) { const f32x4 v0 = acc[ai][bj][m][0] + zf, v1 = acc[ai][bj][m][1] + zf;
                    u32x4 w; w.x = cvt_pk_bf16(v0[0], v0[1]); w.y = cvt_pk_bf16(v0[2], v0[3]); w.z = cvt_pk_bf16(v1[0], v1[1]); w.w = cvt_pk_bf16(v1[2], v1[3]);
                    *(u32x4*)(rowp + bj * HALF) = w; } }
    }
};
struct EpiRes {
    static constexpr bool PERM = false;
    const float* base; float* out; int ldc;
    __device__ __forceinline__ void operator()(const f32x4 (&acc)[2][2][4][2], const Unit& u, int wr, int wc, int fr, int fq) const {
        const int row0 = u.pm * BM + wr * 64 + fr, col0 = u.pn * BM + wc * 32 + 4 * fq;
#pragma unroll
        for (int ai = 0; ai < 2; ++ai)
#pragma unroll
            for (int m = 0; m < 4; ++m) { const size_t off = (size_t)(row0 + ai * HALF + m * 16) * ldc + col0;
#pragma unroll
                for (int bj = 0; bj < 2; ++bj)
#pragma unroll
                    for (int n = 0; n < 2; ++n) { const f32x4 bs = *(const f32x4*)(base + off + bj * HALF + n * 16); *(f32x4*)(out + off + bj * HALF + n * 16) = bs + acc[ai][bj][m][n]; }
                if (m & 1) asm volatile("" ::: "memory"); }
    }
};
struct EpiGateRS {
    static constexpr bool PERM = true;
    bf16_t* O; int ldc; const float* RS; const float* bias;
    __device__ __forceinline__ void operator()(const f32x4 (&acc)[2][2][4][2], const Unit& u, int wr, int wc, int fr, int fq) const {
        const int row0 = u.pm * BM + wr * 64 + fr, col0 = u.pn * BM + wc * 32 + 8 * fq;
        f32x4 bg[2][2];
#pragma unroll
        for (int bj = 0; bj < 2; ++bj) { bg[bj][0] = *(const f32x4*)(bias + col0 + bj * HALF); bg[bj][1] = *(const f32x4*)(bias + col0 + bj * HALF + 4); }
#pragma unroll
        for (int ai = 0; ai < 2; ++ai)
#pragma unroll
            for (int m = 0; m < 4; ++m) { const size_t row = (size_t)(row0 + ai * HALF + m * 16); const float rs = RS[row]; bf16_t* rowp = O + row * ldc + col0;
#pragma unroll
                for (int bj = 0; bj < 2; ++bj) { const f32x4 a0 = acc[ai][bj][m][0] * rs + bg[bj][0], a1 = acc[ai][bj][m][1] * rs + bg[bj][1];
                    u32x4 w; w.x = cvt_pk_bf16(fast_sigmoid(a0[0]), fast_sigmoid(a0[1])); w.y = cvt_pk_bf16(fast_sigmoid(a0[2]), fast_sigmoid(a0[3]));
                    w.z = cvt_pk_bf16(fast_sigmoid(a1[0]), fast_sigmoid(a1[1])); w.w = cvt_pk_bf16(fast_sigmoid(a1[2]), fast_sigmoid(a1[3]));
                    *(u32x4*)(rowp + bj * HALF) = w; } }
    }
};
template <bool LRS> struct EpiWin {
    static constexpr bool PERM = true;
    bf16_t* za; bf16_t* zbc; bf16_t* zg; bf16_t* memkv; const float* RS; const float* bgate; const PG8_LAS float* rsl; float gsc = 1.0f;
    __device__ __forceinline__ void operator()(const f32x4 (&acc)[2][2][4][2], const Unit& u, int wr, int wc, int fr, int fq) const {
        const int row0 = u.pm * BM + wr * 64 + fr, cw = wc * 32 + 8 * fq;
        bf16_t* O; int ldc, colb;
        if (u.br == 0) { O = za; ldc = 3072; colb = u.pn * BM; } else if (u.br == 1) { O = zbc; ldc = 4352; colb = (u.pn - 12) * BM; } else if (u.br == 2) { O = zg; ldc = 6144; colb = (u.pn - 29) * BM; } else { O = memkv; ldc = 4096; colb = u.pn * BM; }
        const bool gate = (u.br == 2), scaled = (u.br != 3);
        f32x4 bg[2][2];
#pragma unroll
        for (int bj = 0; bj < 2; ++bj) { bg[bj][0] = gate ? *(const f32x4*)(bgate + colb + cw + bj * HALF) : (f32x4){0.f, 0.f, 0.f, 0.f}; bg[bj][1] = gate ? *(const f32x4*)(bgate + colb + cw + bj * HALF + 4) : (f32x4){0.f, 0.f, 0.f, 0.f}; }
#pragma unroll
        for (int ai = 0; ai < 2; ++ai)
#pragma unroll
            for (int m = 0; m < 4; ++m) { const size_t row = (size_t)(row0 + ai * HALF + m * 16); const float rs = scaled ? (LRS ? rsl[wr * 64 + fr + ai * HALF + m * 16] : row_rstd(RS, row)) : 1.0f; bf16_t* rowp = O + row * ldc + colb + cw;
#pragma unroll
                for (int bj = 0; bj < 2; ++bj) { const float rg = gate ? rs * gsc : rs; f32x4 a0 = acc[ai][bj][m][0] * rg + bg[bj][0], a1 = acc[ai][bj][m][1] * rg + bg[bj][1];
                    if (gate) {
                        unsigned q[8];
#pragma unroll
                        for (int e = 0; e < 4; ++e) { q[e] = (unsigned)(fmaxf(fast_sigmoid(a0[e]) * 255.0f, 1.0f) + 0.5f); q[4 + e] = (unsigned)(fmaxf(fast_sigmoid(a1[e]) * 255.0f, 1.0f) + 0.5f); }
                        u32x2 w8; w8.x = q[0] | (q[1] << 8) | (q[2] << 16) | (q[3] << 24); w8.y = q[4] | (q[5] << 8) | (q[6] << 16) | (q[7] << 24);
                        *(u32x2*)((unsigned char*)zg + row * 12288 + colb + cw + bj * HALF) = w8; }
                    else {
                    u32x4 w; w.x = cvt_pk_bf16(a0[0], a0[1]); w.y = cvt_pk_bf16(a0[2], a0[3]); w.z = cvt_pk_bf16(a1[0], a1[1]); w.w = cvt_pk_bf16(a1[2], a1[3]);
                    *(u32x4*)(rowp + bj * HALF) = w; } } }
    }
};
struct EpiUp {
    static constexpr bool PERM = true;
    bf16_t* q; bf16_t* kv;
    __device__ __forceinline__ void operator()(const f32x4 (&acc)[2][2][4][2], const Unit& u, int wr, int wc, int fr, int fq) const {
        const int row0 = u.pm * BM + wr * 64 + fr, col0 = u.pn * BM + wc * 32 + 8 * fq;
        bf16_t* O = (u.br == 0) ? q : kv; const int ldc = (u.br == 0) ? 1536 : 2048;
        float zf = 0.f; asm volatile("" : "+v"(zf));
#pragma unroll
        for (int ai = 0; ai < 2; ++ai)
#pragma unroll
            for (int m = 0; m < 4; ++m) { bf16_t* rowp = O + (size_t)(row0 + ai * HALF + m * 16) * ldc + col0;
#pragma unroll
                for (int bj = 0; bj < 2; ++bj) { const f32x4 v0 = acc[ai][bj][m][0] + zf, v1 = acc[ai][bj][m][1] + zf;
                    u32x4 w; w.x = cvt_pk_bf16(v0[0], v0[1]); w.y = cvt_pk_bf16(v0[2], v0[3]); w.z = cvt_pk_bf16(v1[0], v1[1]); w.w = cvt_pk_bf16(v1[2], v1[3]);
                    *(u32x4*)(rowp + bj * HALF) = w; } }
    }
};
struct KwOrder { int G, c0;
    __device__ __forceinline__ bool next(int i, Unit& u) const { const int c = i * G + c0; if (c >= 128) return false; const int b = c >> 5, h = (c >> 3) & 3; u.pm = 0; u.pn = c & 7; u.ka = 512 * h; u.kb = 512 * h; u.br = (b << 2) | h;
        u.aoff = (long)b * 256 * 4096 * 2; u.boff = 0; return true; }
    __device__ __forceinline__ void a_ready(const Unit&) const {} __device__ __forceinline__ void done(const Unit&) const {} };
struct VwOrder { int G, c0;
    __device__ __forceinline__ bool next(int i, Unit& u) const { const int c = i * G + c0; if (c >= 128) return false; const int b = c >> 5, h = (c >> 3) & 3; u.pm = c & 7; u.pn = 0; u.ka = 512 * h; u.kb = 2048 + 512 * h; u.br = (b << 2) | h;
        u.aoff = 0; u.boff = (long)b * 256 * 4096 * 2; return true; }
    __device__ __forceinline__ void a_ready(const Unit&) const {} __device__ __forceinline__ void done(const Unit&) const {} };
struct EpiXW {
    static constexpr bool PERM = true;
    bf16_t* O; int mode;
    __device__ __forceinline__ void operator()(const f32x4 (&acc)[2][2][4][2], const Unit& u, int wr, int wc, int fr, int fq) const {
        const int b = u.br >> 2, h = u.br & 3; const int cw = wc * 32 + 8 * fq, rw = wr * 64 + fr;
        bf16_t* base; int ldc;
        if (mode == 0) { ldc = 2048; base = O + ((size_t)b * 1024 + 256 * h + rw) * 2048 + u.pn * BM + cw; }
        else { ldc = 1024; base = O + ((size_t)b * 2048 + u.pm * BM + rw) * 1024 + 256 * h + cw; }
        float zf = 0.f; asm volatile("" : "+v"(zf));
#pragma unroll
        for (int ai = 0; ai < 2; ++ai)
#pragma unroll
            for (int m = 0; m < 4; ++m) { bf16_t* rowp = base + (size_t)(ai * HALF + m * 16) * ldc;
#pragma unroll
                for (int bj = 0; bj < 2; ++bj) { const f32x4 v0 = acc[ai][bj][m][0] + zf, v1 = acc[ai][bj][m][1] + zf;
                    u32x4 w; w.x = cvt_pk_bf16(v0[0], v0[1]); w.y = cvt_pk_bf16(v0[2], v0[3]); w.z = cvt_pk_bf16(v1[0], v1[1]); w.w = cvt_pk_bf16(v1[2], v1[3]);
                    *(u32x4*)(rowp + bj * HALF) = w; } }
    }
};
struct BatchOrder : StaticOrder { long bstride;
    __device__ __forceinline__ bool next(int i, Unit& u) const { if (!StaticOrder::next(i, u)) return false; u.boff = (long)(u.pm >> 4) * bstride; return true; } };
constexpr int LDP = 1024;
template <bool LRS> struct EpiSoftmaxP {
    static constexpr bool PERM = true;
    bf16_t* P; const float* RS; PG8_LAS float* xch; const PG8_LAS float* rsl;
    __device__ __forceinline__ void operator()(const f32x4 (&acc)[2][2][4][2], const Unit& u, int wr, int wc, int fr, int fq) const {
        constexpr float C = 0.04419417382415922f * 1.4426950408889634f;
        PG8_LAS float* xm = xch; PG8_LAS float* xs = xch + 1024;
        f32x4 v[2][4][2][2]; float mx[2][4];
#pragma unroll
        for (int ai = 0; ai < 2; ++ai)
#pragma unroll
            for (int m = 0; m < 4; ++m) { const float rs = (LRS ? rsl[ai * HALF + wr * 64 + m * 16 + fr] : row_rstd(RS, (size_t)(u.pm * BM + ai * HALF + wr * 64 + m * 16 + fr))) * C; float mm = -3.0e38f;
#pragma unroll
                for (int bj = 0; bj < 2; ++bj)
#pragma unroll
                    for (int n = 0; n < 2; ++n) { const f32x4 x = acc[ai][bj][m][n] * rs; v[ai][m][bj][n] = x; mm = fmaxf(mm, fmaxf(fmaxf(x[0], x[1]), fmaxf(x[2], x[3]))); }
                mm = max_xor32(max_xor16(mm)); mx[ai][m] = mm;
                if (fq == 0) xm[wc * 256 + ai * HALF + wr * 64 + m * 16 + fr] = mm; }
        asm volatile("s_waitcnt lgkmcnt(0)" ::: "memory"); __builtin_amdgcn_s_barrier(); asm volatile("" ::: "memory");
        float sm[2][4];
#pragma unroll
        for (int ai = 0; ai < 2; ++ai)
#pragma unroll
            for (int m = 0; m < 4; ++m) { const int r = ai * HALF + wr * 64 + m * 16 + fr; const float mm = fmaxf(fmaxf(xm[r], xm[256 + r]), fmaxf(xm[512 + r], xm[768 + r])); float s = 0.f;
#pragma unroll
                for (int bj = 0; bj < 2; ++bj)
#pragma unroll
                    for (int n = 0; n < 2; ++n) { f32x4 x = v[ai][m][bj][n];
#pragma unroll
                        for (int e = 0; e < 4; ++e) { x[e] = __builtin_amdgcn_exp2f(x[e] - mm); s += x[e]; }
                        v[ai][m][bj][n] = x; }
                s = sum_xor32(sum_xor16(s)); sm[ai][m] = s;
                if (fq == 0) xs[wc * 256 + r] = s; }
        asm volatile("s_waitcnt lgkmcnt(0)" ::: "memory"); __builtin_amdgcn_s_barrier(); asm volatile("" ::: "memory");
        const int row0 = u.pm * BM + wr * 64 + fr, col0 = u.pn * BM + wc * 32 + 8 * fq;
#pragma unroll
        for (int ai = 0; ai < 2; ++ai)
#pragma unroll
            for (int m = 0; m < 4; ++m) { const int r = ai * HALF + wr * 64 + m * 16 + fr; const float inv = __builtin_amdgcn_rcpf((xs[r] + xs[256 + r]) + (xs[512 + r] + xs[768 + r]));
                bf16_t* rowp = P + (size_t)(row0 + ai * HALF + m * 16) * LDP + col0;
#pragma unroll
                for (int bj = 0; bj < 2; ++bj) { const f32x4 v0 = v[ai][m][bj][0] * inv, v1 = v[ai][m][bj][1] * inv;
                    u32x4 w; w.x = cvt_pk_bf16(v0[0], v0[1]); w.y = cvt_pk_bf16(v0[2], v0[3]); w.z = cvt_pk_bf16(v1[0], v1[1]); w.w = cvt_pk_bf16(v1[2], v1[3]);
                    *(u32x4*)(rowp + bj * HALF) = w; } }
        asm volatile("s_waitcnt lgkmcnt(0)" ::: "memory"); __builtin_amdgcn_s_barrier(); asm volatile("" ::: "memory");
        (void)mx; (void)sm;
    }
};
struct EpiMerge {
    static constexpr bool PERM = true, CHAIN = true;
    bf16_t* O; const bf16_t* zg;
    __device__ __forceinline__ void operator()(f32x4 (&acc)[2][2][4][2], const Unit& u, int wr, int wc, int fr, int fq) const {
        const int row0 = u.pm * BM + wr * 64 + fr, col0 = u.pn * BM + wc * 32 + 8 * fq, gc0 = u.br * 2048 + col0;
        const bool more = (u.br < 2);
        u32x2 z[2][2][2], zn[2][2][2];
        const unsigned char* zg8 = (const unsigned char*)zg;
#define MG_LOAD(buf_, q_) do { _Pragma("unroll") for (int mm = 0; mm < 2; ++mm) { const size_t row = (size_t)(row0 + ((q_) >> 1) * HALF + (2 * ((q_) & 1) + mm) * 16); \
            _Pragma("unroll") for (int bj = 0; bj < 2; ++bj) { z[buf_][mm][bj] = *(const u32x2*)(zg8 + row * 12288 + gc0 + bj * HALF); \
                zn[buf_][mm][bj] = more ? *(const u32x2*)(zg8 + row * 12288 + gc0 + 2048 + bj * HALF) : (u32x2){0x01010101u, 0x01010101u}; } } } while (0)
#define MG_APPLY(buf_, q_) do { _Pragma("unroll") for (int mm = 0; mm < 2; ++mm) { const int ai = (q_) >> 1, m = 2 * ((q_) & 1) + mm; bf16_t* rowp = O + (size_t)(row0 + ai * HALF + m * 16) * 2048 + col0; \
            _Pragma("unroll") for (int bj = 0; bj < 2; ++bj) { const u32x2 a = z[buf_][mm][bj], b = zn[buf_][mm][bj]; float f[8], d[8]; \
                _Pragma("unroll") for (int e = 0; e < 4; ++e) { f[e] = (float)((a.x >> (8 * e)) & 0xffu); f[4 + e] = (float)((a.y >> (8 * e)) & 0xffu); d[e] = (float)((b.x >> (8 * e)) & 0xffu); d[4 + e] = (float)((b.y >> (8 * e)) & 0xffu); } \
                _Pragma("unroll") for (int e = 0; e < 8; ++e) f[e] = more ? f[e] * __builtin_amdgcn_rcpf(d[e]) : f[e] * (1.0f / 255.0f); \
                f32x4 a0 = acc[ai][bj][m][0], a1 = acc[ai][bj][m][1]; \
                a0[0] *= f[0]; a0[1] *= f[1]; a0[2] *= f[2]; a0[3] *= f[3]; a1[0] *= f[4]; a1[1] *= f[5]; a1[2] *= f[6]; a1[3] *= f[7]; \
                acc[ai][bj][m][0] = a0; acc[ai][bj][m][1] = a1; \
                if (!more) { u32x4 w; w.x = cvt_pk_bf16(a0[0], a0[1]); w.y = cvt_pk_bf16(a0[2], a0[3]); w.z = cvt_pk_bf16(a1[0], a1[1]); w.w = cvt_pk_bf16(a1[2], a1[3]); *(u32x4*)(rowp + bj * HALF) = w; } } } } while (0)
        MG_LOAD(0, 0);
        MG_LOAD(1, 1); asm volatile("" ::: "memory"); MG_APPLY(0, 0);
        MG_LOAD(0, 2); asm volatile("" ::: "memory"); MG_APPLY(1, 1);
        MG_LOAD(1, 3); asm volatile("" ::: "memory"); MG_APPLY(0, 2);
        asm volatile("" ::: "memory"); MG_APPLY(1, 3);
#undef MG_LOAD
#undef MG_APPLY
    }
};
struct EpiSwiGLU {
    static constexpr bool PERM = false;
    bf16_t* O; int ldc;
    __device__ __forceinline__ void operator()(const f32x4 (&acc)[2][2][4][2], const Unit& u, int wr, int wc, int fr, int fq) const {
        const int row0 = u.pm * BM + wr * 64 + fr;
#pragma unroll
        for (int ai = 0; ai < 2; ++ai)
#pragma unroll
            for (int m = 0; m < 4; ++m) { bf16_t* rowp = O + (size_t)(row0 + ai * HALF + m * 16) * ldc;
#pragma unroll
                for (int bj = 0; bj < 2; ++bj) { const int G = 8 * u.pn + 4 * bj + wc; const f32x4 g = acc[ai][bj][m][0], up = acc[ai][bj][m][1];
                    float o[4];
#pragma unroll
                    for (int e = 0; e < 4; ++e) o[e] = g[e] * fast_sigmoid(g[e]) * up[e];
                    u32x2 w; w.x = cvt_pk_bf16(o[0], o[1]); w.y = cvt_pk_bf16(o[2], o[3]);
                    *(u32x2*)(rowp + 16 * G + 4 * fq) = w; } }
    }
};


struct EpiBf16RS {
    static constexpr bool PERM = true;
    bf16_t* O; int ldc; const float* SS;
    __device__ __forceinline__ void operator()(const f32x4 (&acc)[2][2][4][2], const Unit& u, int wr, int wc, int fr, int fq) const {
        const int row0 = u.pm * BM + wr * 64 + fr, col0 = u.pn * BM + wc * 32 + 8 * fq;
#pragma unroll
        for (int ai = 0; ai < 2; ++ai)
#pragma unroll
            for (int m = 0; m < 4; ++m) { const size_t row = (size_t)(row0 + ai * HALF + m * 16); const float rs = row_rstd(SS, row); bf16_t* rowp = O + row * ldc + col0;
#pragma unroll
                for (int bj = 0; bj < 2; ++bj) { const f32x4 v0 = acc[ai][bj][m][0] * rs, v1 = acc[ai][bj][m][1] * rs;
                    u32x4 w; w.x = cvt_pk_bf16(v0[0], v0[1]); w.y = cvt_pk_bf16(v0[2], v0[3]); w.z = cvt_pk_bf16(v1[0], v1[1]); w.w = cvt_pk_bf16(v1[2], v1[3]);
                    *(u32x4*)(rowp + bj * HALF) = w; } }
    }
};
struct EpiResN {
    static constexpr bool PERM = false;
    const float* base; float* out; int ldc; bf16_t* xb; const float* gnext; float* SS;
    __device__ __forceinline__ void operator()(const f32x4 (&acc)[2][2][4][2], const Unit& u, int wr, int wc, int fr, int fq) const {
        const int row0 = u.pm * BM + wr * 64 + fr, col0 = u.pn * BM + wc * 32 + 4 * fq;
        f32x4 gv[2][2];
#pragma unroll
        for (int bj = 0; bj < 2; ++bj)
#pragma unroll
            for (int n = 0; n < 2; ++n) gv[bj][n] = *(const f32x4*)(gnext + col0 + bj * HALF + n * 16);
#pragma unroll
        for (int ai = 0; ai < 2; ++ai)
#pragma unroll
            for (int m = 0; m < 4; ++m) { const size_t row = (size_t)(row0 + ai * HALF + m * 16); const size_t off = row * ldc + col0; float ss = 0.f;
#pragma unroll
                for (int bj = 0; bj < 2; ++bj)
#pragma unroll
                    for (int n = 0; n < 2; ++n) { const f32x4 bs = *(const f32x4*)(base + off + bj * HALF + n * 16); const f32x4 x = bs + acc[ai][bj][m][n];
                        *(f32x4*)(out + off + bj * HALF + n * 16) = x; ss += (x[0] * x[0] + x[1] * x[1]) + (x[2] * x[2] + x[3] * x[3]);
                        const f32x4 xg = x * gv[bj][n]; u32x2 w; w.x = cvt_pk_bf16(xg[0], xg[1]); w.y = cvt_pk_bf16(xg[2], xg[3]);
                        *(u32x2*)(xb + off + bj * HALF + n * 16) = w; }
                ss = sum_xor32(sum_xor16(ss));
                if (fq == 0) SS[row * 32 + u.pn * 4 + wc] = ss;
                if (m & 1) asm volatile("" ::: "memory"); }
    }
};
constexpr float F8_SA_ = 2.0f;
__device__ __forceinline__ unsigned pk4_fp8_(float a, float b, float c, float d) { int w = __builtin_amdgcn_cvt_pk_fp8_f32(a, b, 0, false); w = __builtin_amdgcn_cvt_pk_fp8_f32(c, d, w, true); return (unsigned)w; }
struct EpiResB {
    static constexpr bool PERM = true;
    bf16_t* xb; float* SS; unsigned char* h8 = nullptr;
    __device__ __forceinline__ void operator()(const f32x4 (&acc)[2][2][4][2], const Unit& u, int wr, int wc, int fr, int fq) const {
        const int row0 = u.pm * BM + wr * 64 + fr, col0 = u.pn * BM + wc * 32 + 8 * fq;
#pragma unroll
        for (int ai = 0; ai < 2; ++ai) {
            u32x4 old[4][2];
#pragma unroll
            for (int m = 0; m < 4; ++m)
#pragma unroll
                for (int bj = 0; bj < 2; ++bj) old[m][bj] = *(const u32x4*)(xb + (size_t)(row0 + ai * HALF + m * 16) * 2048 + col0 + bj * HALF);
#pragma unroll
            for (int m = 0; m < 4; ++m) { const size_t row = (size_t)(row0 + ai * HALF + m * 16); bf16_t* rowp = xb + row * 2048 + col0; float ss = 0.f;
#pragma unroll
                for (int bj = 0; bj < 2; ++bj) { const u32x4 oo = old[m][bj]; const f32x4 a0 = acc[ai][bj][m][0], a1 = acc[ai][bj][m][1];
                    const float x0 = a0[0] + bf_lo(oo.x), x1 = a0[1] + bf_hi(oo.x), x2 = a0[2] + bf_lo(oo.y), x3 = a0[3] + bf_hi(oo.y), x4 = a1[0] + bf_lo(oo.z), x5 = a1[1] + bf_hi(oo.z), x6 = a1[2] + bf_lo(oo.w), x7 = a1[3] + bf_hi(oo.w);
                    ss += (x0 * x0 + x1 * x1) + (x2 * x2 + x3 * x3) + (x4 * x4 + x5 * x5) + (x6 * x6 + x7 * x7);
                    u32x4 w; w.x = cvt_pk_bf16(x0, x1); w.y = cvt_pk_bf16(x2, x3); w.z = cvt_pk_bf16(x4, x5); w.w = cvt_pk_bf16(x6, x7);
                    *(u32x4*)(rowp + bj * HALF) = w;
                    if (h8) { u32x2 q; q.x = pk4_fp8_(x0 * F8_SA_, x1 * F8_SA_, x2 * F8_SA_, x3 * F8_SA_); q.y = pk4_fp8_(x4 * F8_SA_, x5 * F8_SA_, x6 * F8_SA_, x7 * F8_SA_);
                        *(u32x2*)(h8 + row * 2048 + col0 + bj * HALF) = q; } }
                ss = sum_xor32(sum_xor16(ss));
                if (fq == 0) SS[row * 32 + u.pn * 4 + wc] = ss; }
            asm volatile("" ::: "memory"); }
    }
};
struct EpiResF {
    static constexpr bool PERM = false;
    const bf16_t* xb; float* out;
    __device__ __forceinline__ void operator()(const f32x4 (&acc)[2][2][4][2], const Unit& u, int wr, int wc, int fr, int fq) const {
        const int row0 = u.pm * BM + wr * 64 + fr, col0 = u.pn * BM + wc * 32 + 4 * fq;
#pragma unroll
        for (int ai = 0; ai < 2; ++ai) {
            u32x2 old[16];
#pragma unroll
            for (int e = 0; e < 16; ++e) old[e] = *(const u32x2*)(xb + (size_t)(row0 + ai * HALF + (e >> 2) * 16) * 2048 + col0 + ((e >> 1) & 1) * HALF + (e & 1) * 16);
            asm volatile("" : "+v"(old[0]), "+v"(old[1]), "+v"(old[2]), "+v"(old[3]), "+v"(old[4]), "+v"(old[5]), "+v"(old[6]), "+v"(old[7]), "+v"(old[8]), "+v"(old[9]), "+v"(old[10]), "+v"(old[11]), "+v"(old[12]), "+v"(old[13]), "+v"(old[14]), "+v"(old[15]) :: "memory");
#pragma unroll
            for (int m = 0; m < 4; ++m) { const size_t off = (size_t)(row0 + ai * HALF + m * 16) * 2048 + col0;
#pragma unroll
                for (int bj = 0; bj < 2; ++bj)
#pragma unroll
                    for (int n = 0; n < 2; ++n) { const u32x2 oo = old[m * 4 + bj * 2 + n]; const f32x4 a = acc[ai][bj][m][n];
                        *(f32x4*)(out + off + bj * HALF + n * 16) = (f32x4){a[0] + bf_lo(oo.x), a[1] + bf_hi(oo.x), a[2] + bf_lo(oo.y), a[3] + bf_hi(oo.y)}; }
                if (m & 1) asm volatile("" ::: "memory"); } }
    }
};
template <bool LRS> struct EpiSwiGLURS {
    static constexpr bool PERM = false;
    bf16_t* O; int ldc; const float* SS; const PG8_LAS float* rsl;
    __device__ __forceinline__ void operator()(const f32x4 (&acc)[2][2][4][2], const Unit& u, int wr, int wc, int fr, int fq) const {
        const int row0 = u.pm * BM + wr * 64 + fr;
#pragma unroll
        for (int ai = 0; ai < 2; ++ai)
#pragma unroll
            for (int mp = 0; mp < 4; mp += 2) {
                float rs2[2];
#pragma unroll
                for (int q = 0; q < 2; ++q) rs2[q] = LRS ? rsl[wr * 64 + fr + ai * HALF + (mp + q) * 16] : row_rstd(SS, (size_t)(row0 + ai * HALF + (mp + q) * 16));
                bf16_t* rowp = O + (size_t)(row0 + ai * HALF + (mp + (fq & 1)) * 16) * ldc + 8 * (fq >> 1);
#pragma unroll
                for (int bj = 0; bj < 2; ++bj) { const int Gq = 8 * u.pn + 4 * bj + wc; unsigned px[2], py[2];
#pragma unroll
                    for (int q = 0; q < 2; ++q) { const f32x4 g = acc[ai][bj][mp + q][0] * rs2[q], up = acc[ai][bj][mp + q][1] * rs2[q];
                        float o[4];
#pragma unroll
                        for (int e = 0; e < 4; ++e) o[e] = g[e] * fast_sigmoid(g[e]) * up[e];
                        px[q] = cvt_pk_bf16(o[0], o[1]); py[q] = cvt_pk_bf16(o[2], o[3]); }
                    const auto r0 = __builtin_amdgcn_permlane16_swap(px[0], px[1], false, false), r1 = __builtin_amdgcn_permlane16_swap(py[0], py[1], false, false);
                    u32x4 w; w.x = r0[0]; w.y = r1[0]; w.z = r0[1]; w.w = r1[1];
                    *(u32x4*)(rowp + 16 * Gq) = w; } }
    }
};
template <class E, class = void> struct epi_chain { static constexpr bool value = false; };
template <class E> struct epi_chain<E, decltype((void)E::CHAIN)> { static constexpr bool value = E::CHAIN; };
template <class Epi, class Sched, bool ALIGN_EPI, bool F8 = false>
__device__ __forceinline__ void gemm_phase(PG8_LAS unsigned char* lds, const Gemm g, const Sched& S, const Epi& E, int tid) {
    asm volatile("" : "+v"(tid));
    const int wid = __builtin_amdgcn_readfirstlane(tid >> 6), lane = tid & 63, wr = wid >> 2, wc = wid & 3, fr = lane & 15, fq = lane >> 4;
    const int nt = g.K / BK;
    unsigned voffA[2], voffB[2];
#pragma unroll
    for (int i = 0; i < 2; ++i) { int R, C; stage_rc(tid * 16 + i * 8192, R, C); const int Rb = Epi::PERM ? ((R & ~31) + perm32(R & 31)) : R;
        voffA[i] = (unsigned)(R * g.lda + C) * 2u; voffB[i] = (unsigned)(Rb * g.ldb + C) * 2u; }
    const size_t kstep = (size_t)(BK * 2);
    const size_t hstepA = (size_t)HALF * g.lda * 2, hstepB = (size_t)HALF * g.ldb * 2;
    const unsigned ldsw = (unsigned)wid * 1024u;
    const int aoff = lds_byte(wr * 64 + fr, fq * 8), boff = lds_byte(wc * 32 + fr, fq * 8);
#define PG8_SA(b, h) (((b) * 2 + (h)) * HTB)
#define PG8_SB(b, h) ((4 + (b) * 2 + (h)) * HTB)
#define PG8_STAGE(bufoff, gbase, voff) do { _Pragma("unroll") for (int _i = 0; _i < 2; ++_i) \
        __builtin_amdgcn_global_load_lds((const unsigned*)((const char*)(gbase) + (voff)[_i]), (PG8_LAS unsigned*)(lds + (bufoff) + ldsw + _i * 8192), 16, 0, 0); } while (0)
#define PG8_CAT8(lo_, hi_) __builtin_shufflevector(lo_, hi_, 0, 1, 2, 3, 4, 5, 6, 7)
#define PG8_LDA(dst, b, h) do { if constexpr (F8) { _Pragma("unroll") for (int m = 0; m < 4; ++m) dst##8[m] = PG8_CAT8(*(const PG8_LAS i32x4*)(lds + PG8_SA(b, h) + aoff + m * 2048), *(const PG8_LAS i32x4*)(lds + PG8_SA(b, h) + aoff + m * 2048 + 1024)); } \
        else { _Pragma("unroll") for (int m = 0; m < 4; ++m) _Pragma("unroll") for (int k = 0; k < 2; ++k) dst[m][k] = *(const PG8_LAS bf16x8*)(lds + PG8_SA(b, h) + aoff + m * 2048 + k * 1024); } } while (0)
#define PG8_LDB(dst, b, h) do { if constexpr (F8) { _Pragma("unroll") for (int n = 0; n < 2; ++n) dst##8[n] = PG8_CAT8(*(const PG8_LAS i32x4*)(lds + PG8_SB(b, h) + boff + n * 2048), *(const PG8_LAS i32x4*)(lds + PG8_SB(b, h) + boff + n * 2048 + 1024)); } \
        else { _Pragma("unroll") for (int n = 0; n < 2; ++n) _Pragma("unroll") for (int k = 0; k < 2; ++k) dst[n][k] = *(const PG8_LAS bf16x8*)(lds + PG8_SB(b, h) + boff + n * 2048 + k * 1024); } } while (0)
#define PG8_MMA(ai, bj, At, Bt) do { __builtin_amdgcn_s_setprio(1); _Pragma("unroll") for (int m = 0; m < 4; ++m) _Pragma("unroll") for (int n = 0; n < 2; ++n) { \
        if constexpr (F8) asm volatile("v_mfma_f32_16x16x128_f8f6f4 %0, %1, %2, %0" : "+v"(acc[ai][bj][m][n]) : "v"(Bt##8[n]), "v"(At##8[m]));   \
        else { _Pragma("unroll") for (int k = 0; k < 2; ++k) acc[ai][bj][m][n] = __builtin_amdgcn_mfma_f32_16x16x32_bf16(Bt[n][k], At[m][k], acc[ai][bj][m][n], 0, 0, 0); } } \
        __builtin_amdgcn_s_setprio(0); } while (0)
#define PG8_WAIT_V(n) asm volatile("s_waitcnt vmcnt(" #n ")" ::: "memory")
#define PG8_WAIT_L(n) asm volatile("s_waitcnt lgkmcnt(" #n ")" ::: "memory")
#define PG8_BAR __builtin_amdgcn_s_barrier()
#define PG8_SCHED __builtin_amdgcn_sched_barrier(0)
    Unit cur, nxt; int ui = 0;
    if (!S.next(0, cur)) return;
    f32x4 acc[2][2][4][2];
#pragma unroll
    for (int a = 0; a < 2; ++a)
#pragma unroll
        for (int b = 0; b < 2; ++b)
#pragma unroll
            for (int m = 0; m < 4; ++m)
#pragma unroll
                for (int n = 0; n < 2; ++n) acc[a][b][m][n] = (f32x4){0.f, 0.f, 0.f, 0.f};
    bf16x8 At[4][2], B0[2][2], B1[2][2]; i32x8 At8[4], B08[2], B18[2];
    const char* cA = (const char*)g.A + cur.aoff + (size_t)cur.pm * 2 * hstepA + (size_t)cur.ka * 2; const char* cB = (const char*)g.Bt + cur.boff + (size_t)cur.pn * 2 * hstepB + (size_t)cur.kb * 2;
    S.a_ready(cur);
    PG8_STAGE(PG8_SB(0, 0), cB, voffB); PG8_STAGE(PG8_SB(0, 1), cB + hstepB, voffB); PG8_STAGE(PG8_SA(0, 0), cA, voffA); PG8_STAGE(PG8_SA(0, 1), cA + hstepA, voffA);
    if (wr == 1) PG8_BAR;
    PG8_WAIT_V(2); PG8_BAR;
    PG8_STAGE(PG8_SB(1, 0), cB + kstep, voffB); PG8_STAGE(PG8_SA(1, 0), cA + kstep, voffA); PG8_STAGE(PG8_SB(1, 1), cB + hstepB + kstep, voffB);
    PG8_WAIT_V(6); PG8_BAR;
    for (;;) {
        const bool has_next = S.next(ui + 1, nxt);
        const char* nA = has_next ? (const char*)g.A + nxt.aoff + (size_t)nxt.pm * 2 * hstepA + (size_t)nxt.ka * 2 : cA; const char* nB = has_next ? (const char*)g.Bt + nxt.boff + (size_t)nxt.pn * 2 * hstepB + (size_t)nxt.kb * 2 : cB;
        for (int t = 0; t < nt; t += 2) {
            const bool last = (t == nt - 2);
            const char* a1 = cA + (size_t)(t + 1) * kstep;
            const char* a2 = last ? nA : cA + (size_t)(t + 2) * kstep; const char* b2 = last ? nB : cB + (size_t)(t + 2) * kstep;
            const char* a3 = a2 + kstep; const char* b3 = b2 + kstep;
            if (last && has_next) S.a_ready(nxt);
            PG8_LDB(B0, 0, 0); PG8_LDB(B1, 0, 1); PG8_SCHED; PG8_LDA(At, 0, 0); PG8_STAGE(PG8_SA(1, 1), a1 + hstepA, voffA);
            PG8_WAIT_V(8); PG8_WAIT_L(0); PG8_BAR; PG8_MMA(0, 0, At, B0); PG8_MMA(0, 1, At, B1); PG8_BAR; PG8_SCHED;
            PG8_LDA(At, 0, 1); PG8_STAGE(PG8_SB(0, 0), b2, voffB); PG8_STAGE(PG8_SB(0, 1), b2 + hstepB, voffB); PG8_STAGE(PG8_SA(0, 0), a2, voffA);
            PG8_WAIT_V(8); PG8_WAIT_L(0); PG8_BAR; PG8_MMA(1, 0, At, B0); PG8_MMA(1, 1, At, B1); PG8_BAR; PG8_SCHED;
            PG8_LDB(B0, 1, 0); PG8_LDB(B1, 1, 1); PG8_SCHED; PG8_LDA(At, 1, 0); PG8_STAGE(PG8_SA(0, 1), a2 + hstepA, voffA);
            PG8_WAIT_V(8); PG8_WAIT_L(0); PG8_BAR; PG8_MMA(0, 0, At, B0); PG8_MMA(0, 1, At, B1); PG8_BAR; PG8_SCHED;
            PG8_LDA(At, 1, 1); PG8_STAGE(PG8_SB(1, 0), b3, voffB); PG8_STAGE(PG8_SB(1, 1), b3 + hstepB, voffB); PG8_STAGE(PG8_SA(1, 0), a3, voffA);
            PG8_WAIT_V(8); PG8_WAIT_L(0); PG8_BAR; PG8_MMA(1, 0, At, B0); PG8_MMA(1, 1, At, B1); PG8_BAR; PG8_SCHED;
        }
        if constexpr (ALIGN_EPI) { if (wr == 0) PG8_BAR; }
        if constexpr (F8) asm volatile("s_nop 15\n\ts_nop 15" ::: "memory");
        E(acc, cur, wr, wc, fr, fq); S.done(cur);
        if (!has_next) break;
        if (!(epi_chain<Epi>::value && nxt.br != 0))
#pragma unroll
        for (int a = 0; a < 2; ++a)
#pragma unroll
            for (int b = 0; b < 2; ++b)
#pragma unroll
                for (int m = 0; m < 4; ++m)
#pragma unroll
                    for (int n = 0; n < 2; ++n) acc[a][b][m][n] = (f32x4){0.f, 0.f, 0.f, 0.f};
        cur = nxt; cA = nA; cB = nB; ++ui;
        if constexpr (ALIGN_EPI) { if (wr == 1) PG8_BAR; }
    }
    PG8_WAIT_V(0);
    if constexpr (!ALIGN_EPI) { if (wr == 0) PG8_BAR; }
    PG8_BAR;
#undef PG8_SA
#undef PG8_SB
#undef PG8_STAGE
#undef PG8_LDA
#undef PG8_LDB
#undef PG8_MMA
#undef PG8_WAIT_V
#undef PG8_WAIT_L
#undef PG8_BAR
#undef PG8_SCHED
}
}

constexpr int NWAVES = 8;
constexpr int NB = 4, SEQ = 4096, M = NB * SEQ, D = 2048, MEML = 256, MROWS = NB * MEML;
constexpr int NA = 3072, NABC = 4352  , NG = 6144, NIN = NA + NABC + NG, DFF = 5632, NFF2 = 2 * DFF, DIN_SRC = 13392, LDW = D + 64  , LDACT = DFF + 64  ;
constexpr int ZA_Q = 0, ZA_K = 1024, ZA_V = 2048;
constexpr int ZC_BQ = 0, ZC_BK = 512, ZC_BV = 1024, ZC_BR = 2048, ZC_CQA = 3072, ZC_CKVA = 3584, ZC_CKR = 4096, ZC_BLR = 4160;
constexpr float EPS = 1e-6f;
constexpr int PH_PER_LAYER = 15, N_PHASES = 2 * PH_PER_LAYER + 1;

constexpr size_t MiB = 1u << 20;
constexpr size_t WS_CTL = 0, CTL_ZERO_BYTES = 32768;
constexpr size_t WS_ROPE = 1 * MiB;
constexpr size_t WS_WIN = 2 * MiB, WS_WQB = 55 * MiB, WS_WKVB = 57 * MiB, WS_WUP = 59 * MiB, WS_WO = 71 * MiB, WS_WXQ = 79 * MiB, WS_WXKV = 87 * MiB, WS_WXO = 103 * MiB, WS_WFF = 111 * MiB, WS_WDN = 158 * MiB;
constexpr size_t WS_H = 182 * MiB;
constexpr size_t WS_ZA = 246 * MiB, WS_MLAKV = 246 * MiB, WS_ZABC = 342 * MiB  , WS_GLAST = 182 * MiB  , WS_GLADEC = 826 * MiB, WS_AML = 826 * MiB + 512 * 1024  ;
constexpr size_t WS_MERGED = 246 * MiB, WS_XQ = 246 * MiB, WS_OX = 310 * MiB;
constexpr size_t WS_P = 342 * MiB  , WS_KW = 310 * MiB  , WS_VW = 326 * MiB  ;
constexpr size_t WS_ZG = 478 * MiB;
constexpr size_t WS_ACT = 478 * MiB;
constexpr size_t WS_OABC = 670 * MiB;
constexpr size_t WS_MLAQ = 766 * MiB;
constexpr size_t WS_MEMKV = 814 * MiB;
constexpr size_t WS_MEMN = 822 * MiB;
constexpr size_t WS_SS = 828 * MiB;
constexpr size_t WS_RS = 830 * MiB;
constexpr size_t WS_END = 831 * MiB;
static_assert(WS_WFF + (size_t)NFF2 * LDW * 2 <= WS_WDN && WS_WIN + (size_t)NIN * D * 2 <= WS_WQB && WS_WDN + (size_t)D * LDACT * 2 <= WS_H && WS_ZA + (size_t)M * NA * 2 <= WS_ZABC && WS_ZABC + (size_t)M * NABC * 2 <= WS_ZG && WS_ZG + (size_t)M * NG * 2 <= WS_OABC && WS_ACT + (size_t)M * LDACT * 2 <= WS_OABC, "ws map");
constexpr size_t WS_W8 = WS_WIN + (size_t)7424 * D * 2, WS_H8 = WS_MLAQ;
static_assert(pg8::F8_SA_ == 2.0f, "fp8 stream scale");
constexpr float F8_SA = 2.0f, F8_SW = 256.0f, F8_GSC = 1.0f / (F8_SA * F8_SW);
constexpr int CW_BAR = 4096, CW_XID = 128  , CW_GRP = 512  ;

constexpr int RING_OFF = 0, RING_BYTES = 131072;
constexpr int LDSCTL_OFF = RING_BYTES, MISC_OFF = LDSCTL_OFF + 320;
constexpr int PTAB_OFF = MISC_OFF + 128;
constexpr int LDS_BYTES = 147456;

#define GAS __attribute__((address_space(1)))
#define LAS __attribute__((address_space(3)))
typedef unsigned short bf16;
typedef unsigned v4u __attribute__((ext_vector_type(4)));
typedef unsigned v2u __attribute__((ext_vector_type(2)));
typedef float f32x4 __attribute__((ext_vector_type(4)));
typedef GAS unsigned gu32;
#define LDS_WAIT() asm volatile("s_waitcnt lgkmcnt(0)" ::: "memory")
__device__ __forceinline__ unsigned f2bf(float f) { unsigned u = __builtin_bit_cast(unsigned, f); return (u + 0x7fffu + ((u >> 16) & 1u)) >> 16; }
__device__ __forceinline__ unsigned pk2(float lo, float hi) { return f2bf(lo) | (f2bf(hi) << 16); }
__device__ __forceinline__ float bf2f(bf16 b) { return __uint_as_float(((unsigned)b) << 16); }
__device__ __forceinline__ float bflo(unsigned w) { return __uint_as_float(w << 16); }
__device__ __forceinline__ float bfhi(unsigned w) { return __uint_as_float(w & 0xffff0000u); }

__device__ __forceinline__ int lane_id_now() { int l; asm volatile("v_mbcnt_lo_u32_b32 %0, -1, 0\n\tv_mbcnt_hi_u32_b32 %0, -1, %0" : "=&v"(l)); return l; }
#define XB_TMO      128
#define XB_XCNT(j)  (256  + 64 * (j))
#define XB_XSUB(j)  (1280 + 64 * (j))
#define XB_XGEN(j)  (2304 + 64 * (j))
#define XB_TOP      3328
#define XB_TOPGEN   3392
#define XCD_BAR_WORDS 3456
#define XB_SPIN_CAP (1u << 22)
__device__ __forceinline__ unsigned xb_ld(unsigned* p)              { return __hip_atomic_load(p, __ATOMIC_RELAXED, __HIP_MEMORY_SCOPE_AGENT); }
__device__ __forceinline__ unsigned xb_add(unsigned* p, unsigned v) { return __hip_atomic_fetch_add(p, v, __ATOMIC_RELAXED, __HIP_MEMORY_SCOPE_AGENT); }
__device__ __forceinline__ unsigned xb_xcc_id() { return (unsigned)__builtin_amdgcn_s_getreg((3 << 11) | 20) & 0xFu; }
#define XB_SPIN(cond, bar) do { unsigned _sp = 0; while (cond) { __builtin_amdgcn_s_sleep(1); \
    if ((++_sp & 255u) == 0u) { if (xb_ld(&(bar)[XB_TMO])) break; if (_sp > XB_SPIN_CAP) { atomicAdd(&(bar)[XB_TMO], 1u); break; } } } } while (0)
struct XcdBarrier { unsigned* bar; unsigned x; volatile LAS unsigned* st; };
__device__ __forceinline__ XcdBarrier xcd_barrier_post(unsigned* bar, volatile LAS unsigned* st) {
    XcdBarrier b; b.bar = bar; b.x = xb_xcc_id(); b.st = st;
    if (threadIdx.x == 0) (void)xb_add(&bar[XB_XCNT(b.x)], 1u);
    return b;
}
__device__ __forceinline__ void xcd_barrier_complete(unsigned* bar, unsigned x, unsigned& nloc, unsigned& nx) {
    const unsigned G = gridDim.x * gridDim.y * gridDim.z;
    unsigned sum, cnt, mine, sp = 0u;
    for (;;) {
        sum = 0u; cnt = 0u; mine = 0u;
#pragma unroll
        for (unsigned j = 0; j < 16; ++j) { const unsigned c = xb_ld(&bar[XB_XCNT(j)]); sum += c; cnt += (c > 0u) ? 1u : 0u; mine = (j == x) ? c : mine; }
        if (sum == G) break;
        __builtin_amdgcn_s_sleep(1);
        if ((++sp & 255u) == 0u) { if (xb_ld(&bar[XB_TMO])) break; if (sp > XB_SPIN_CAP) { atomicAdd(&bar[XB_TMO], 1u); break; } }
    }
    nloc = mine > 0u ? mine : 1u; nx = cnt > 0u ? cnt : 1u;
}
__device__ __forceinline__ void xcd_barrier(const XcdBarrier& b, const bool thread0) {
    asm volatile("s_waitcnt vmcnt(0)" ::: "memory");
    __syncthreads();
    if (thread0) {
        unsigned* bar = b.bar; asm volatile("" : "+s"(bar));
        __builtin_amdgcn_s_waitcnt(0);
        unsigned nloc = b.st[0], nx = b.st[1];
        if (nloc == 0u) { xcd_barrier_complete(bar, b.x, nloc, nx); b.st[0] = nloc; b.st[1] = nx; }
        const unsigned old = xb_add(&bar[XB_XSUB(b.x)], 1u);
        const unsigned gen = old / nloc;
        if (old + 1u == (gen + 1u) * nloc) {
            __builtin_amdgcn_fence(__ATOMIC_RELEASE, "agent");
            asm volatile("s_waitcnt vmcnt(0)" ::: "memory");
            const unsigned og = xb_add(&bar[XB_TOP], 1u);
            const unsigned tg = og / nx;
            if (og + 1u == (tg + 1u) * nx) xb_add(&bar[XB_TOPGEN], 1u);
            else XB_SPIN(xb_ld(&bar[XB_TOPGEN]) == tg, bar);
            __builtin_amdgcn_fence(__ATOMIC_ACQUIRE, "agent");
            xb_add(&bar[XB_XGEN(b.x)], 1u);
            asm volatile("s_waitcnt vmcnt(0)" ::: "memory");
        } else {
            XB_SPIN(xb_ld(&bar[XB_XGEN(b.x)]) == gen, bar);
            __builtin_amdgcn_fence(__ATOMIC_ACQUIRE, "agent");
            asm volatile("s_waitcnt vmcnt(0)" ::: "memory");
        }
    }
    __syncthreads();
}

__device__ __forceinline__ float dot8(v4u k, const LAS float* q) {
    const f32x4 q0 = *(const LAS f32x4*)q, q1 = *(const LAS f32x4*)(q + 4);
    float s = bflo(k.x) * q0.x; s += bfhi(k.x) * q0.y; s += bflo(k.y) * q0.z; s += bfhi(k.y) * q0.w;
    s += bflo(k.z) * q1.x; s += bfhi(k.z) * q1.y; s += bflo(k.w) * q1.z; s += bfhi(k.w) * q1.w; return s;
}

enum { MAP_LIN = 0, MAP_GATE = 1, MAP_UP = 2 };
__device__ __forceinline__ unsigned pk4_fp8(float a, float b, float c, float d) { int w = __builtin_amdgcn_cvt_pk_fp8_f32(a, b, 0, false); w = __builtin_amdgcn_cvt_pk_fp8_f32(c, d, w, true); return (unsigned)w; }
__device__ __forceinline__ void transpose_item8(const float* W, int ldw, int k0, int n0, int ncnt, unsigned char* W8, int nbase, LAS float* scr, int lane, const float* gk) {
    { const int kr = lane >> 3, c4 = (lane & 7) * 4;
      const float* wp = W + (size_t)(k0 + kr) * ldw + n0 + c4;
      f32x4 v[8]; float gj[8];
#pragma unroll
      for (int j = 0; j < 8; ++j) gj[j] = gk[k0 + 8 * j + kr] * F8_SW;
#pragma unroll
      for (int j = 0; j < 8; ++j) v[j] = (c4 < ncnt) ? *(const f32x4*)(wp + (size_t)(8 * j) * ldw) : (f32x4){0.f, 0.f, 0.f, 0.f};
      asm volatile("" : "+v"(v[0]), "+v"(v[1]), "+v"(v[2]), "+v"(v[3]), "+v"(v[4]), "+v"(v[5]), "+v"(v[6]), "+v"(v[7]) :: "memory");
#pragma unroll
      for (int j = 0; j < 8; ++j) { v[j] = v[j] * gj[j]; LAS float* d = scr + (8 * j + kr) * 33 + c4; d[0] = v[j].x; d[1] = v[j].y; d[2] = v[j].z; d[3] = v[j].w; } }
    LDS_WAIT(); asm volatile("" ::: "memory");
    const int c = lane & 7;
#pragma unroll
    for (int j = 0; j < 4; ++j) { const int n = (lane >> 3) + 8 * j; const LAS float* sp = scr + (8 * c) * 33 + n;
        v2u o; o.x = pk4_fp8(sp[0 * 33], sp[1 * 33], sp[2 * 33], sp[3 * 33]); o.y = pk4_fp8(sp[4 * 33], sp[5 * 33], sp[6 * 33], sp[7 * 33]);
        if (n < ncnt) *(v2u*)(W8 + (size_t)(n0 + n - nbase) * 2048 + k0 + 8 * c) = o; }
    LDS_WAIT(); asm volatile("" ::: "memory");
}
__device__ __forceinline__ bool seg_item8(int& r, const float* W, int K, int ldw, int ns, int ncols, unsigned char* W8, LAS float* scr, int lane, const float* gk) {
    const int nblk = (ncols + 31) / 32, cnt = (K / 64) * nblk;
    if (r >= cnt) { r -= cnt; return false; }
    const int kb = r / nblk, nb = r - kb * nblk, n0 = ns + 32 * nb, nc = (ncols - 32 * nb) < 32 ? (ncols - 32 * nb) : 32;
    transpose_item8(W, ldw, 64 * kb, n0, nc, W8, ns, scr, lane, gk);
    return true;
}
template <int MAPK>
__device__ __forceinline__ void transpose_item(const float* W, int ldw, int k0, int n0, int ncnt, bf16* WT, int ldd, int dcol0, int moff, LAS float* scr, int lane, const float* gk) {
    { const int kr = lane >> 3, c4 = (lane & 7) * 4;
      const float* wp = W + (size_t)(k0 + kr) * ldw + n0 + c4;
      f32x4 v[8]; float gj[8];
#pragma unroll
      for (int j = 0; j < 8; ++j) gj[j] = 1.0f;
      if (gk) {
#pragma unroll
          for (int j = 0; j < 8; ++j) gj[j] = gk[k0 + 8 * j + kr]; }
#pragma unroll
      for (int j = 0; j < 8; ++j) v[j] = (c4 < ncnt) ? *(const f32x4*)(wp + (size_t)(8 * j) * ldw) : (f32x4){0.f, 0.f, 0.f, 0.f};
      asm volatile("" : "+v"(v[0]), "+v"(v[1]), "+v"(v[2]), "+v"(v[3]), "+v"(v[4]), "+v"(v[5]), "+v"(v[6]), "+v"(v[7]) :: "memory");
#pragma unroll
      for (int j = 0; j < 8; ++j) v[j] = v[j] * gj[j];
#pragma unroll
      for (int j = 0; j < 8; ++j) { LAS float* d = scr + (8 * j + kr) * 33 + c4; d[0] = v[j].x; d[1] = v[j].y; d[2] = v[j].z; d[3] = v[j].w; } }
    LDS_WAIT(); asm volatile("" ::: "memory");
    const int c = lane & 7;
#pragma unroll
    for (int j = 0; j < 4; ++j) { const int n = (lane >> 3) + 8 * j; const LAS float* s = scr + (8 * c) * 33 + n;
        v4u o; o.x = pk2(s[0 * 33], s[1 * 33]); o.y = pk2(s[2 * 33], s[3 * 33]); o.z = pk2(s[4 * 33], s[5 * 33]); o.w = pk2(s[6 * 33], s[7 * 33]);
        const int sn = n0 + n - moff;
        int drow;
        if (MAPK == MAP_LIN) drow = sn; else if (MAPK == MAP_GATE) drow = 32 * (sn >> 4) + (sn & 15); else drow = 32 * (sn >> 4) + 16 + (sn & 15);
        if (n < ncnt) *(v4u*)(WT + (size_t)drow * ldd + dcol0 + k0 + 8 * c) = o; }
    LDS_WAIT(); asm volatile("" ::: "memory");
}
template <int MAPK>
__device__ __forceinline__ bool seg_item(int& r, const float* W, int K, int ldw, int ns, int ncols, bf16* WT, int ldd, int drow0, int dcol0, LAS float* scr, int lane, const float* gk = nullptr) {
    const int nblk = (ncols + 31) / 32, cnt = (K / 64) * nblk;
    if (r >= cnt) { r -= cnt; return false; }
    const int kb = r / nblk, nb = r - kb * nblk, n0 = ns + 32 * nb, nc = (ncols - 32 * nb) < 32 ? (ncols - 32 * nb) : 32;
    transpose_item<MAPK>(W, ldw, 64 * kb, n0, nc, WT, ldd, dcol0, (MAPK == MAP_LIN) ? (ns - drow0) : ns, scr, lane, gk);
    return true;
}

__device__ __forceinline__ void rms_row_bf16(const float* xrow, const float* g, bf16* orow, int lane) {
    const f32x4* xr = (const f32x4*)xrow + lane; const f32x4* gr = (const f32x4*)g + lane;
    f32x4 v[8]; float s = 0.f;
#pragma unroll
    for (int j = 0; j < 8; ++j) { v[j] = xr[64 * j]; s += (v[j].x * v[j].x + v[j].y * v[j].y) + (v[j].z * v[j].z + v[j].w * v[j].w); }
    const float rstd = 1.0f / sqrtf(wave_sum(s) * (1.f / 2048.f) + EPS);
    v2u* o8 = (v2u*)orow + lane;
#pragma unroll
    for (int j = 0; j < 8; ++j) { const f32x4 gg = gr[64 * j]; v2u w; w.x = pk2(v[j].x * rstd * gg.x, v[j].y * rstd * gg.y); w.y = pk2(v[j].z * rstd * gg.z, v[j].w * rstd * gg.w); o8[64 * j] = w; }
}

__device__ __forceinline__ void gain_row_bf16(const float* xrow, const float* g, bf16* orow, float* ssrow, unsigned char* h8row, int lane) {
    const f32x4* xr = (const f32x4*)xrow + lane; const f32x4* gr = (const f32x4*)g + lane;
    f32x4 v[8]; float s = 0.f;
#pragma unroll
    for (int j = 0; j < 8; ++j) { v[j] = xr[64 * j]; s += (v[j].x * v[j].x + v[j].y * v[j].y) + (v[j].z * v[j].z + v[j].w * v[j].w); }
    s = wave_sum(s);
    v2u* o8 = (v2u*)orow + lane;
#pragma unroll
    for (int j = 0; j < 8; ++j) { (void)gr; v2u w; w.x = pk2(v[j].x, v[j].y); w.y = pk2(v[j].z, v[j].w); o8[64 * j] = w;
        ((unsigned*)h8row)[lane + 64 * j] = pk4_fp8(v[j].x * F8_SA, v[j].y * F8_SA, v[j].z * F8_SA, v[j].w * F8_SA); }
    if (lane < 32) ssrow[lane] = (lane == 0) ? s : 0.f;
}
__device__ __forceinline__ void final_row(const bf16* hrow, const float* ss, const f32x4 (&gv)[8], float* orow, int lane) {
    v4u h[4];
#pragma unroll
    for (int j = 0; j < 4; ++j) h[j] = *(const v4u*)(hrow + 8 * (lane + 64 * j));
    const float s = wave_sum((lane < 32) ? ss[lane & 31] : 0.f);
    const float rstd = 1.0f / sqrtf(s * (1.f / 2048.f) + EPS);
#pragma unroll
    for (int j = 0; j < 4; ++j) { float* op = orow + 8 * (lane + 64 * j);
        *(f32x4*)op = (f32x4){bflo(h[j].x) * rstd * gv[2 * j].x, bfhi(h[j].x) * rstd * gv[2 * j].y, bflo(h[j].y) * rstd * gv[2 * j].z, bfhi(h[j].y) * rstd * gv[2 * j].w};
        *(f32x4*)(op + 4) = (f32x4){bflo(h[j].z) * rstd * gv[2 * j + 1].x, bfhi(h[j].z) * rstd * gv[2 * j + 1].y, bflo(h[j].w) * rstd * gv[2 * j + 1].z, bfhi(h[j].w) * rstd * gv[2 * j + 1].w}; }
}
__device__ __forceinline__ void rms_row_f32_inplace(float* xrow, const float* g, int lane) {
    f32x4* xr = (f32x4*)xrow + lane; const f32x4* gr = (const f32x4*)g + lane;
    f32x4 v[8]; float s = 0.f;
#pragma unroll
    for (int j = 0; j < 8; ++j) { v[j] = xr[64 * j]; s += (v[j].x * v[j].x + v[j].y * v[j].y) + (v[j].z * v[j].z + v[j].w * v[j].w); }
    const float rstd = 1.0f / sqrtf(wave_sum(s) * (1.f / 2048.f) + EPS);
#pragma unroll
    for (int j = 0; j < 8; ++j) { const f32x4 gg = gr[64 * j]; xr[64 * j] = (f32x4){v[j].x * rstd * gg.x, v[j].y * rstd * gg.y, v[j].z * rstd * gg.z, v[j].w * rstd * gg.w}; }
}

__device__ __forceinline__ const float* ldptr(LAS unsigned long long* tab, int k) {
    unsigned ta = (unsigned)(uintptr_t)(tab + k); asm volatile("" : "+s"(ta));
    const unsigned long long v = *(LAS unsigned long long*)ta; const unsigned lo = __builtin_amdgcn_readfirstlane((unsigned)v), hi = __builtin_amdgcn_readfirstlane((unsigned)(v >> 32));
    return (const float*)(const GAS float*)(((unsigned long long)hi << 32) | lo);
}
struct Args { const float* in[27]; float* out; unsigned char* ws; int ph_lo, ph_hi; };

__device__ __forceinline__ int t5_bucket(int dist) {
    if (dist < 16) return dist;
    const float n = (float)dist;
    int large = 16 + (int)(logf(n / 16.0f) / 4.852030263919617f * 16.0f);
    return large < 31 ? large : 31;
}

__device__ __forceinline__ void naive_attn_a(LAS unsigned char* lds, const bf16* Z, bf16* Oabc, const float* rel_bias, int gw, int ngw, int wave, int lane, int tid) {
    LAS float* bias = (LAS float*)lds;
    for (int i = tid; i < 3 * 129 * 8; i += NWAVES * 64) { const int h = i & 7, gd = i >> 3, g = gd / 129, d = gd - g * 129; const int dil = (g == 0) ? 1 : (g == 1 ? 4 : 16);
        bias[i] = rel_bias[t5_bucket(d * dil) * 8 + h]; }
    __syncthreads();
    LAS float* qs = (LAS float*)(lds + 16384 + wave * 1024);
    LAS float* ps = qs + 128;
    const float scale = 0.08838834764831845f;
    for (int item = gw; item < M * 8; item += ngw) {
        const int h = item & 7, mt = item >> 3, b = mt >> 12, t = mt & 4095;
        { const unsigned w = *(const unsigned*)(Z + (size_t)mt * NA + ZA_Q + h * 128 + 2 * lane); qs[2 * lane] = bflo(w) * scale; qs[2 * lane + 1] = bfhi(w) * scale; }
        LDS_WAIT();
        float m_run = -1e30f, l_run = 0.f, o0 = 0.f, o1 = 0.f;
        for (int g = 0; g < 3; ++g) {
            const int dil = (g == 0) ? 1 : (g == 1 ? 4 : 16);
            const int dmax = (t / dil) < 128 ? (t / dil) : 128;
            for (int d0 = 0; d0 <= dmax; d0 += 64) {
                const int d = d0 + lane; const bool valid = d <= dmax; const int tk = valid ? t - d * dil : t;
                const v4u* kp = (const v4u*)(Z + (size_t)(b * SEQ + tk) * NA + ZA_K + h * 128);
                float s = 0.f;
#pragma unroll
                for (int c = 0; c < 16; ++c) s += dot8(kp[c], qs + 8 * c);
                s = valid ? s + bias[(g * 129 + (valid ? d : 0)) * 8 + h] : -1e30f;
                const float m_new = fmaxf(m_run, wave_max(s)); const float alpha = __expf(m_run - m_new); const float p = valid ? __expf(s - m_new) : 0.f;
                l_run = l_run * alpha + wave_sum(p); o0 *= alpha; o1 *= alpha; m_run = m_new;
                ps[lane] = p; LDS_WAIT();
                const int nk = (dmax - d0 + 1) < 64 ? (dmax - d0 + 1) : 64;
                for (int jj = 0; jj < nk; ++jj) { const float pj = ps[jj]; const int tkj = t - (d0 + jj) * dil;
                    const unsigned w = *(const unsigned*)(Z + (size_t)(b * SEQ + tkj) * NA + ZA_V + h * 128 + 2 * lane); o0 += pj * bflo(w); o1 += pj * bfhi(w); }
                LDS_WAIT();
            }
        }
        const float inv = 1.0f / l_run;
        *(unsigned*)(Oabc + (size_t)mt * 3072 + h * 128 + 2 * lane) = pk2(o0 * inv, o1 * inv);
    }
}

__device__ __forceinline__ void mla_prep(bf16* Z, const float* qg, const float* kvg, const float* ropec, const float* ropes, int gw, int ngw, int lane) {
    const f32x4 gq0 = *(const f32x4*)(qg + 8 * lane), gq1 = *(const f32x4*)(qg + 8 * lane + 4), gk0 = *(const f32x4*)(kvg + 8 * lane), gk1 = *(const f32x4*)(kvg + 8 * lane + 4);
    for (int mt0 = gw; mt0 < M; mt0 += 4 * ngw) {
        v4u w[4][2]; float ss[4][2]; float x1[4], x2[4]; int mts[4];
#pragma unroll
        for (int j = 0; j < 4; ++j) { const int mt = (mt0 + j * ngw < M) ? mt0 + j * ngw : mt0; mts[j] = mt; bf16* zr = Z + (size_t)mt * NABC;
            w[j][0] = *(const v4u*)(zr + ZC_CQA + 8 * lane); w[j][1] = *(const v4u*)(zr + ZC_CKVA + 8 * lane);
            x1[j] = bf2f(zr[ZC_CKR + (lane & 31)]); x2[j] = bf2f(zr[ZC_CKR + 32 + (lane & 31)]);
#pragma unroll
            for (int q = 0; q < 2; ++q) { const v4u a = w[j][q]; const float v0 = bflo(a.x), v1 = bfhi(a.x), v2 = bflo(a.y), v3 = bfhi(a.y), v4 = bflo(a.z), v5 = bfhi(a.z), v6 = bflo(a.w), v7 = bfhi(a.w);
                ss[j][q] = (v0 * v0 + v1 * v1) + (v2 * v2 + v3 * v3) + (v4 * v4 + v5 * v5) + (v6 * v6 + v7 * v7); } }
#pragma unroll
        for (int j = 0; j < 4; ++j) { ss[j][0] = wave_sum(ss[j][0]); ss[j][1] = wave_sum(ss[j][1]); }
#pragma unroll
        for (int j = 0; j < 4; ++j) { if (j > 0 && mt0 + j * ngw >= M) continue; const int mt = mts[j]; bf16* zr = Z + (size_t)mt * NABC; const int s_pos = mt & 4095;
#pragma unroll
            for (int q = 0; q < 2; ++q) { const float rstd = 1.0f / sqrtf(ss[j][q] * (1.f / 512.f) + EPS); const v4u a = w[j][q]; const f32x4 g0 = q ? gk0 : gq0, g1 = q ? gk1 : gq1;
                v4u o; o.x = pk2(bflo(a.x) * rstd * g0.x, bfhi(a.x) * rstd * g0.y); o.y = pk2(bflo(a.y) * rstd * g0.z, bfhi(a.y) * rstd * g0.w);
                o.z = pk2(bflo(a.z) * rstd * g1.x, bfhi(a.z) * rstd * g1.y); o.w = pk2(bflo(a.w) * rstd * g1.z, bfhi(a.w) * rstd * g1.w);
                *(v4u*)(zr + (q ? ZC_CKVA : ZC_CQA) + 8 * lane) = o; }
            const float c = ropec[s_pos * 32 + (lane & 31)], sn = ropes[s_pos * 32 + (lane & 31)];
            const float r = (lane < 32) ? (x1[j] * c - x2[j] * sn) : (x1[j] * sn + x2[j] * c);
            zr[ZC_CKR + lane] = (bf16)f2bf(r); }
    }
}

__device__ __forceinline__ void naive_attn_mla(LAS unsigned char* lds, const bf16* Q, const bf16* KV, const bf16* Z, bf16* Oabc, const float* ropec, const float* ropes, int gw, int ngw, int wave, int lane) {
    LAS float* qs = (LAS float*)(lds + wave * 4096);
    LAS float* ps = qs + 768;
    const float scale = 0.07216878364870322f;
    const int nitems = NB * 8 * (SEQ / 4);
    for (int item = gw; item < nitems; item += ngw) {
        const int qg = item % (SEQ / 4), bh = item / (SEQ / 4), b = bh >> 3, h = bh & 7, i0 = 4 * qg;
#pragma unroll
        for (int r = 0; r < 4; ++r) {
            const bf16* qp = Q + (size_t)(b * SEQ + i0 + r) * 1536 + h * 192;
            qs[r * 192 + lane] = bf2f(qp[lane]) * scale; qs[r * 192 + 64 + lane] = bf2f(qp[64 + lane]) * scale;
            const float x1 = bf2f(qp[128 + (lane & 31)]), x2 = bf2f(qp[160 + (lane & 31)]);
            const float c = ropec[(i0 + r) * 32 + (lane & 31)], sn = ropes[(i0 + r) * 32 + (lane & 31)];
            qs[r * 192 + 128 + lane] = ((lane < 32) ? (x1 * c - x2 * sn) : (x1 * sn + x2 * c)) * scale;
        }
        LDS_WAIT();
        float m_run[4], l_run[4], o0[4], o1[4];
#pragma unroll
        for (int r = 0; r < 4; ++r) { m_run[r] = -1e30f; l_run[r] = 0.f; o0[r] = 0.f; o1[r] = 0.f; }
        const int jlast = i0 + 3;
        for (int j0 = 0; j0 <= jlast; j0 += 64) {
            const int j = j0 + lane, jc = j <= jlast ? j : jlast;
            const v4u* kn = (const v4u*)(KV + (size_t)(b * SEQ + jc) * 2048 + h * 256);
            const v4u* kr = (const v4u*)(Z + (size_t)(b * SEQ + jc) * NABC + ZC_CKR);
            float s[4] = {0.f, 0.f, 0.f, 0.f};
#pragma unroll 4
            for (int c = 0; c < 16; ++c) { const v4u kk = kn[c];
#pragma unroll
                for (int r = 0; r < 4; ++r) s[r] += dot8(kk, qs + r * 192 + 8 * c); }
#pragma unroll 4
            for (int c = 0; c < 8; ++c) { const v4u kk = kr[c];
#pragma unroll
                for (int r = 0; r < 4; ++r) s[r] += dot8(kk, qs + r * 192 + 128 + 8 * c); }
#pragma unroll
            for (int r = 0; r < 4; ++r) { const bool valid = j <= i0 + r; const float sv = valid ? s[r] : -1e30f;
                const float m_new = fmaxf(m_run[r], wave_max(sv)); const float alpha = __expf(m_run[r] - m_new); const float p = valid ? __expf(sv - m_new) : 0.f;
                l_run[r] = l_run[r] * alpha + wave_sum(p); o0[r] *= alpha; o1[r] *= alpha; m_run[r] = m_new; ps[r * 64 + lane] = p; }
            LDS_WAIT();
            const int nk = (jlast - j0 + 1) < 64 ? (jlast - j0 + 1) : 64;
            for (int jj = 0; jj < nk; ++jj) {
                const unsigned w = *(const unsigned*)(KV + (size_t)(b * SEQ + j0 + jj) * 2048 + h * 256 + 128 + 2 * lane); const float v0 = bflo(w), v1 = bfhi(w);
#pragma unroll
                for (int r = 0; r < 4; ++r) { const float pj = ps[r * 64 + jj]; o0[r] += pj * v0; o1[r] += pj * v1; } }
            LDS_WAIT();
        }
#pragma unroll
        for (int r = 0; r < 4; ++r) { const float inv = 1.0f / l_run[r]; *(unsigned*)(Oabc + (size_t)(b * SEQ + i0 + r) * 3072 + 2048 + h * 128 + 2 * lane) = pk2(o0[r] * inv, o1[r] * inv); }
    }
}

__device__ __forceinline__ void naive_attn_cross(LAS unsigned char* lds, const bf16* XQ, const bf16* MKV, bf16* OX, int gw, int ngw, int wave, int lane) {
    LAS float* qs = (LAS float*)(lds + wave * 12288);
    LAS float* ps = qs + 2048;
    const float scale = 0.04419417382415922f;
    const int nitems = (M / 4) * 4;
    for (int item = gw; item < nitems; item += ngw) {
        const int h = item & 3, m0 = (item >> 2) * 4, b = m0 >> 12;
#pragma unroll
        for (int r = 0; r < 4; ++r) { const v4u w = *(const v4u*)(XQ + (size_t)(m0 + r) * 2048 + h * 512 + 8 * lane); LAS float* q = qs + r * 512 + 8 * lane;
            q[0] = bflo(w.x) * scale; q[1] = bfhi(w.x) * scale; q[2] = bflo(w.y) * scale; q[3] = bfhi(w.y) * scale; q[4] = bflo(w.z) * scale; q[5] = bfhi(w.z) * scale; q[6] = bflo(w.w) * scale; q[7] = bfhi(w.w) * scale; }
        LDS_WAIT();
        float m_run[4], l_run[4], o[4][8];
#pragma unroll
        for (int r = 0; r < 4; ++r) { m_run[r] = -1e30f; l_run[r] = 0.f;
#pragma unroll
            for (int e = 0; e < 8; ++e) o[r][e] = 0.f; }
        for (int j0 = 0; j0 < MEML; j0 += 64) {
            const v4u* kp = (const v4u*)(MKV + (size_t)(b * MEML + j0 + lane) * 4096 + h * 512);
            float s[4] = {0.f, 0.f, 0.f, 0.f};
#pragma unroll 4
            for (int c = 0; c < 64; ++c) { const v4u kk = kp[c];
#pragma unroll
                for (int r = 0; r < 4; ++r) s[r] += dot8(kk, qs + r * 512 + 8 * c); }
#pragma unroll
            for (int r = 0; r < 4; ++r) { const float m_new = fmaxf(m_run[r], wave_max(s[r])); const float alpha = __expf(m_run[r] - m_new); const float p = __expf(s[r] - m_new);
                l_run[r] = l_run[r] * alpha + wave_sum(p); m_run[r] = m_new; ps[r * 64 + lane] = p;
#pragma unroll
                for (int e = 0; e < 8; ++e) o[r][e] *= alpha; }
            LDS_WAIT();
            for (int jj = 0; jj < 64; ++jj) {
                const v4u w = *(const v4u*)(MKV + (size_t)(b * MEML + j0 + jj) * 4096 + 2048 + h * 512 + 8 * lane);
                const float v[8] = {bflo(w.x), bfhi(w.x), bflo(w.y), bfhi(w.y), bflo(w.z), bfhi(w.z), bflo(w.w), bfhi(w.w)};
#pragma unroll
                for (int r = 0; r < 4; ++r) { const float pj = ps[r * 64 + jj];
#pragma unroll
                    for (int e = 0; e < 8; ++e) o[r][e] += pj * v[e]; } }
            LDS_WAIT();
        }
#pragma unroll
        for (int r = 0; r < 4; ++r) { const float inv = 1.0f / l_run[r]; v4u w; w.x = pk2(o[r][0] * inv, o[r][1] * inv); w.y = pk2(o[r][2] * inv, o[r][3] * inv); w.z = pk2(o[r][4] * inv, o[r][5] * inv); w.w = pk2(o[r][6] * inv, o[r][7] * inv);
            *(v4u*)(OX + (size_t)(m0 + r) * 2048 + h * 512 + 8 * lane) = w; }
    }
}

__device__ __forceinline__ void naive_gla(LAS unsigned char* lds, const bf16* Z, bf16* Oabc, const float* w_alpha, const float* b_alpha, const float* gla_norm, int bh, int tid, int wave, int lane) {
    constexpr int CH = 16;
    LAS float* qs = (LAS float*)lds;
    LAS float* ks = qs + CH * 128;
    LAS float* as = ks + CH * 128;
    LAS float* vs = as + CH * 128;
    LAS float* op = vs + CH * 256;
    const int b = bh >> 2, h = bh & 3, c = tid & 255, half = tid >> 8, kcol = tid & 127;
    float wa[16];
#pragma unroll
    for (int j = 0; j < 16; ++j) wa[j] = w_alpha[j * 512 + h * 128 + kcol];
    const float ba = b_alpha[h * 128 + kcol];
    float S[64];
#pragma unroll
    for (int k = 0; k < 64; ++k) S[k] = 0.f;
    const float qscale = 0.08838834764831845f;
    for (int t0 = 0; t0 < SEQ; t0 += CH) {
        const size_t m0 = (size_t)b * SEQ + t0;
        for (int idx = tid; idx < CH * 128; idx += NWAVES * 64) { const int t = idx >> 7; const bf16* zr = Z + (m0 + t) * NABC;
            qs[idx] = bf2f(zr[ZC_BQ + h * 128 + kcol]) * qscale; ks[idx] = bf2f(zr[ZC_BK + h * 128 + kcol]);
            float x = ba;
#pragma unroll
            for (int j = 0; j < 16; ++j) x += bf2f(zr[ZC_BLR + j]) * wa[j];
            const float ls = fminf(x, 0.f) - log1pf(__expf(-fabsf(x)));
            as[idx] = __expf(ls * (1.0f / 16.0f)); }
        for (int idx = tid; idx < CH * 256; idx += NWAVES * 64) { const int t = idx >> 8; vs[idx] = bf2f(Z[(m0 + t) * NABC + ZC_BV + h * 256 + (idx & 255)]); }
        __syncthreads();
        for (int t = 0; t < CH; ++t) {
            const float v = vs[t * 256 + c]; float acc = 0.f;
            const LAS f32x4* a4 = (const LAS f32x4*)(as + t * 128 + half * 64); const LAS f32x4* k4 = (const LAS f32x4*)(ks + t * 128 + half * 64); const LAS f32x4* q4 = (const LAS f32x4*)(qs + t * 128 + half * 64);
#pragma unroll
            for (int k = 0; k < 16; ++k) { const f32x4 a = a4[k], kk = k4[k], q = q4[k];
                S[4 * k + 0] = a.x * S[4 * k + 0] + kk.x * v; acc += q.x * S[4 * k + 0];
                S[4 * k + 1] = a.y * S[4 * k + 1] + kk.y * v; acc += q.y * S[4 * k + 1];
                S[4 * k + 2] = a.z * S[4 * k + 2] + kk.z * v; acc += q.z * S[4 * k + 2];
                S[4 * k + 3] = a.w * S[4 * k + 3] + kk.w * v; acc += q.w * S[4 * k + 3];
                if ((k & 3) == 3) asm volatile("" ::: "memory"); }
            op[(half * CH + t) * 256 + c] = acc;
        }
        __syncthreads();
        for (int t = wave; t < CH; t += NWAVES) {
            float o[4]; float ss = 0.f;
#pragma unroll
            for (int i = 0; i < 4; ++i) { o[i] = op[t * 256 + lane + 64 * i] + op[(CH + t) * 256 + lane + 64 * i]; ss += o[i] * o[i]; }
            const float rstd = 1.0f / sqrtf(wave_sum(ss) * (1.f / 256.f) + EPS);
#pragma unroll
            for (int i = 0; i < 4; ++i) { const int cc = lane + 64 * i; const float r = bf2f(Z[(m0 + t) * NABC + ZC_BR + h * 256 + cc]);
                const float y = o[i] * rstd * gla_norm[h * 256 + cc] * (r / (1.0f + __expf(-r)));
                Oabc[(m0 + t) * 3072 + 1024 + h * 256 + cc] = (bf16)f2bf(y); }
        }
        __syncthreads();
    }
}


namespace fa {
using bf16x8 = __attribute__((ext_vector_type(8))) short;
using s16x4  = __attribute__((ext_vector_type(4))) short;
using f32x16 = __attribute__((ext_vector_type(16))) float;
using u32x4  = __attribute__((ext_vector_type(4))) unsigned;
#define FA_SBAR() __builtin_amdgcn_sched_barrier(0)
__device__ __forceinline__ int crow(int r, int hi) { return (r & 3) + 8 * (r >> 2) + 4 * hi; }
__device__ __forceinline__ unsigned cvtpk(float lo, float hi) { unsigned r; asm volatile("v_cvt_pk_bf16_f32 %0, %1, %2" : "=v"(r) : "v"(lo), "v"(hi)); return r; }
__device__ __forceinline__ void partialSM(f32x16& p0, f32x16& p1, float& m_reg, float& mn, float& alpha, const float C, const float thr) {
  float pmax = p0[0];
#pragma unroll
  for (int r = 1; r < 16; ++r) pmax = fmaxf(pmax, p0[r]);
#pragma unroll
  for (int r = 0; r < 16; ++r) pmax = fmaxf(pmax, p1[r]);
  { auto rr = __builtin_amdgcn_permlane32_swap(__float_as_uint(pmax), __float_as_uint(pmax), false, false);
    pmax = fmaxf(__uint_as_float(rr[0]), __uint_as_float(rr[1])); }
  if (__builtin_expect(__all(pmax - m_reg <= thr), 1)) { mn = m_reg; alpha = 1.f; }
  else { mn = fmaxf(m_reg, pmax); alpha = __builtin_amdgcn_exp2f((m_reg - mn) * C); m_reg = mn; }
  const float mnC = -mn * C;
#pragma unroll
  for (int r = 0; r < 16; ++r) p0[r] = fmaf(p0[r], C, mnC);
#pragma unroll
  for (int r = 0; r < 16; ++r) p1[r] = fmaf(p1[r], C, mnC);
#pragma unroll
  for (int r = 0; r < 16; ++r) p0[r] = __builtin_amdgcn_exp2f(p0[r]);
}
#define FA_PK4(P, BASE, OUT) do { unsigned a0 = fa::cvtpk(P[BASE + 0], P[BASE + 1]), a1 = fa::cvtpk(P[BASE + 2], P[BASE + 3]);   \
    unsigned b0 = fa::cvtpk(P[BASE + 4], P[BASE + 5]), b1 = fa::cvtpk(P[BASE + 6], P[BASE + 7]);                              \
    auto r0 = __builtin_amdgcn_permlane32_swap(a0, b0, false, false); auto r1 = __builtin_amdgcn_permlane32_swap(a1, b1, false, false); \
    fa::u32x4 w = {r0[0], r1[0], r0[1], r1[1]}; OUT = *reinterpret_cast<fa::bf16x8*>(&w); } while (0)
__device__ __forceinline__ void finishSM(f32x16& p0, f32x16& p1, float alpha, float& l_reg, bf16x8& pa0, bf16x8& pa1, bf16x8& pa2, bf16x8& pa3) {
#pragma unroll
  for (int r = 0; r < 16; ++r) p1[r] = __builtin_amdgcn_exp2f(p1[r]);
  float ps = 0;
#pragma unroll
  for (int r = 0; r < 16; ++r) ps += p0[r];
#pragma unroll
  for (int r = 0; r < 16; ++r) ps += p1[r];
  { auto rr = __builtin_amdgcn_permlane32_swap(__float_as_uint(ps), __float_as_uint(ps), false, false);
    ps = __uint_as_float(rr[0]) + __uint_as_float(rr[1]); }
  l_reg = l_reg * alpha + ps;
  FA_PK4(p0, 0, pa0); FA_PK4(p0, 8, pa1); FA_PK4(p1, 0, pa2); FA_PK4(p1, 8, pa3);
}
__device__ __forceinline__ int v_st(int k, int c) { const int kk = (k & ~0xC) | ((k & 4) << 1) | ((k & 8) >> 1); return ((kk >> 3) * 4 + (c >> 5)) * 512 + ((kk & 7) * 32 + (c & 31)) * 2; }
__device__ __forceinline__ int v_rd_base(int lane) { return ((lane & 3) << 3) | (((lane >> 2) & 3) << 6) | (((lane >> 4) & 1) << 5) | (((lane >> 5) & 1) << 8); }
constexpr int v_rd_off(int d0, int ks, int half) { return d0 * 512 + ks * 4096 + half * 2048; }
template <int OFF> __device__ __forceinline__ s16x4 tr_read(int vb) {
  s16x4 r; asm volatile("ds_read_b64_tr_b16 %0, %1 offset:%2" : "=&v"(r) : "v"(vb), "i"(OFF) : "memory"); return r;
}
template <int D0, int BASE = 0> __device__ __forceinline__ void pv_one(f32x16& od, int vb, bf16x8 pa0, bf16x8 pa1, bf16x8 pa2, bf16x8 pa3) {
  s16x4 l0 = tr_read<BASE + v_rd_off(D0, 0, 0)>(vb), h0 = tr_read<BASE + v_rd_off(D0, 0, 1)>(vb), l1 = tr_read<BASE + v_rd_off(D0, 1, 0)>(vb), h1 = tr_read<BASE + v_rd_off(D0, 1, 1)>(vb);
  s16x4 l2 = tr_read<BASE + v_rd_off(D0, 2, 0)>(vb), h2 = tr_read<BASE + v_rd_off(D0, 2, 1)>(vb), l3 = tr_read<BASE + v_rd_off(D0, 3, 0)>(vb), h3 = tr_read<BASE + v_rd_off(D0, 3, 1)>(vb);
  asm volatile("s_waitcnt lgkmcnt(0)" : "+v"(l0), "+v"(h0), "+v"(l1), "+v"(h1), "+v"(l2), "+v"(h2), "+v"(l3), "+v"(h3) :: "memory"); FA_SBAR();
#define FA_PK(L, H) (bf16x8){L[0], L[1], L[2], L[3], H[0], H[1], H[2], H[3]}
  od = __builtin_amdgcn_mfma_f32_32x32x16_bf16(pa0, FA_PK(l0, h0), od, 0, 0, 0);
  od = __builtin_amdgcn_mfma_f32_32x32x16_bf16(pa1, FA_PK(l1, h1), od, 0, 0, 0);
  od = __builtin_amdgcn_mfma_f32_32x32x16_bf16(pa2, FA_PK(l2, h2), od, 0, 0, 0);
  od = __builtin_amdgcn_mfma_f32_32x32x16_bf16(pa3, FA_PK(l3, h3), od, 0, 0, 0);
#undef FA_PK
}
template <int BASE = 0> __device__ __forceinline__ void pv_d0(f32x16* o, int vb, bf16x8 pa0, bf16x8 pa1, bf16x8 pa2, bf16x8 pa3) {
  pv_one<0, BASE>(o[0], vb, pa0, pa1, pa2, pa3); pv_one<1, BASE>(o[1], vb, pa0, pa1, pa2, pa3); pv_one<2, BASE>(o[2], vb, pa0, pa1, pa2, pa3); pv_one<3, BASE>(o[3], vb, pa0, pa1, pa2, pa3);
}
#define FA_RESC(a, o, al_l, r32, hi) do { if (__any((a) < 1.f)) { if ((hi) == 0) (al_l)[r32] = (a); asm volatile("s_waitcnt lgkmcnt(0)" ::: "memory"); \
    _Pragma("unroll") for (int d_ = 0; d_ < 4; ++d_) _Pragma("unroll") for (int r_ = 0; r_ < 16; ++r_) (o)[d_][r_] *= (al_l)[fa::crow(r_, hi)]; } } while (0)
__device__ __forceinline__ void store_o_bf16(const f32x16* o, const float* rli, bf16* Ow, int ldo, int lane, int r32, int hi) {
  const unsigned loff = (unsigned)((((lane & 1) + 4 * hi) * ldo + (r32 & ~1)) * 2);
#pragma unroll
  for (int r = 0; r < 16; r += 2) {
    char* rowp = (char*)(Ow + (size_t)((r & 3) + 8 * (r >> 2)) * ldo);
#pragma unroll
    for (int d0 = 0; d0 < 4; ++d0) {
      const float a = o[d0][r] * rli[r], b = o[d0][r + 1] * rli[r + 1];
      const float send = (lane & 1) ? a : b; const float recv = lane_xor1(send);
      const unsigned w = cvtpk((lane & 1) ? recv : a, (lane & 1) ? b : recv);
      *(unsigned*)(rowp + loff + d0 * 64) = w; } }
}
}

#define KSWZ192(row, colB) ((row) * 384 + ((colB) ^ (((row) & 7) << 4)))
__device__ __forceinline__ void mla_attn_phase(LAS unsigned char* lds, const bf16* Q, const bf16* KV, const bf16* Z, bf16* Oabc, const float* ropec, const float* ropes, int vcu, int G, int tid) {
    using namespace fa;
    asm volatile("" : "+v"(tid));
    const int wid = __builtin_amdgcn_readfirstlane(tid >> 6), lane = tid & 63, r32 = lane & 31, hi = lane >> 5;
    constexpr int SHM_K = 64 * 384, SHM_V = 16384;
    LAS unsigned char* K_lds = lds; LAS unsigned char* V_lds = lds + 2 * SHM_K;
    LAS float* wsf = (LAS float*)(lds + 2 * SHM_K + 2 * SHM_V) + wid * 64; LAS float* li_l = wsf; LAS float* al_l = wsf + 32;
    LAS unsigned char* qrl = lds + 86016 + wid * 4096;
    const int sr = tid >> 4, sc = (tid & 15) * 8, vst0 = v_st(sr, sc);
    const int kr_row = tid >> 3, kr_c = (tid & 7) * 8;
    const int kst0 = KSWZ192(sr, sc * 2), kst2 = KSWZ192(kr_row, 256 + kr_c * 2);
    const int vb0 = (int)(uintptr_t)V_lds + v_rd_base(lane);
    int ka[4];
#pragma unroll
    for (int j = 0; j < 4; ++j) ka[j] = r32 * 384 + (((j * 2 + hi) ^ (r32 & 7)) << 4);
    constexpr float SCALE = 0.07216878364870322f, C = SCALE * 1.4426950408889634f, THRS = 8.0f / SCALE;
    const unsigned qoff = (unsigned)(((wid * 32 + r32) * 1536 + hi * 8) * 2), roff = (unsigned)(((wid * 32 + r32) * 32 + hi * 8) * 4);
    const unsigned kvoff = (unsigned)((sr * 2048 + sc) * 2), zoff = (unsigned)((kr_row * NABC + ZC_CKR + kr_c) * 2);
#pragma unroll 1
    for (int pi = vcu; pi < 256; pi += G) {
        const int bh = pi >> 3, b = bh >> 3, h = bh & 7;
        const size_t tok0 = (size_t)b * SEQ;
#pragma unroll 1
        for (int half = 0; half < 2; ++half) {
            const int qb = half ? 15 - (pi & 7) : (pi & 7);
            bf16x8 qr[8];
            { bf16x8 qrope[4]; unsigned qoff_ = qoff, roff_ = roff; asm volatile("" : "+v"(qoff_), "+v"(roff_));
              const char* Qu = (const char*)(Q + (tok0 + qb * 256) * 1536 + h * 192);
              const char* cu = (const char*)(ropec + (size_t)(qb * 256) * 32); const char* su = (const char*)(ropes + (size_t)(qb * 256) * 32);
#pragma unroll
              for (int d0 = 0; d0 < 8; ++d0) qr[d0] = *(const bf16x8*)(Qu + qoff_ + d0 * 32);
#pragma unroll
              for (int d0 = 0; d0 < 4; ++d0) qrope[d0] = *(const bf16x8*)(Qu + qoff_ + (8 + d0) * 32);
#pragma unroll
              for (int pr = 0; pr < 2; ++pr) {
                  const f32x4 c0 = *(const f32x4*)(cu + roff_ + pr * 64), c1 = *(const f32x4*)(cu + roff_ + pr * 64 + 16), s0 = *(const f32x4*)(su + roff_ + pr * 64), s1 = *(const f32x4*)(su + roff_ + pr * 64 + 16);
                  const float cc[8] = {c0.x, c0.y, c0.z, c0.w, c1.x, c1.y, c1.z, c1.w}, ss[8] = {s0.x, s0.y, s0.z, s0.w, s1.x, s1.y, s1.z, s1.w};
                  bf16x8 xa = qrope[pr], xb = qrope[2 + pr];
#pragma unroll
                  for (int e = 0; e < 8; ++e) { const float x1 = bf2f((bf16)xa[e]), x2 = bf2f((bf16)xb[e]);
                      xa[e] = (short)f2bf(x1 * cc[e] - x2 * ss[e]); xb[e] = (short)f2bf(x1 * ss[e] + x2 * cc[e]); }
                  *(LAS bf16x8*)(qrl + (pr * 64 + lane) * 16) = xa; *(LAS bf16x8*)(qrl + ((2 + pr) * 64 + lane) * 16) = xb; } }
            v4u vs0, vs1, ks0, ks1, krr;
            const char* KVu = (const char*)(KV + tok0 * 2048 + h * 256); const char* Zu = (const char*)(Z + tok0 * NABC);
#define MLA_SLOAD(k0) do { const char* kvp = KVu + (size_t)(k0) * 4096; const char* zp = Zu + (size_t)(k0) * (NABC * 2); \
            ks0 = *(const v4u*)(kvp + kvoff); vs0 = *(const v4u*)(kvp + kvoff + 256); ks1 = *(const v4u*)(kvp + 32 * 4096 + kvoff); vs1 = *(const v4u*)(kvp + 32 * 4096 + kvoff + 256); \
            krr = *(const v4u*)(zp + zoff); } while (0)
#define MLA_SWRITE(bb) do { *(LAS v4u*)(V_lds + (bb) * SHM_V + vst0) = vs0; *(LAS v4u*)(V_lds + (bb) * SHM_V + vst0 + 8192) = vs1; \
            *(LAS v4u*)(K_lds + (bb) * SHM_K + kst0) = ks0; *(LAS v4u*)(K_lds + (bb) * SHM_K + kst0 + 32 * 384) = ks1; \
            *(LAS v4u*)(K_lds + (bb) * SHM_K + kst2) = krr; } while (0)
            const int nt = 4 * qb + 4;
            float m_reg = -1e30f, l_reg = 0.f; f32x16 o[4];
#pragma unroll
            for (int d = 0; d < 4; ++d)
#pragma unroll
                for (int r = 0; r < 16; ++r) o[d][r] = 0.f;
            MLA_SLOAD(0); MLA_SWRITE(0); __syncthreads();
#pragma unroll 1
            for (int t = 0; t < nt; ++t) {
                const int buf = t & 1;
                if (t + 1 < nt) MLA_SLOAD((t + 1) * 64);
                FA_SBAR();
                const int tt = t - 4 * qb;
                {
                    f32x16 p0, p1;
#pragma unroll
                    for (int r = 0; r < 16; ++r) { p0[r] = 0.f; p1[r] = 0.f; }
                    const LAS unsigned char* Ks = K_lds + buf * SHM_K;
                    bf16x8 kf[2][4], qx[2][2];
#define MLA_KREAD(g_) do { _Pragma("unroll") for (int e_ = 0; e_ < 2; ++e_) { const int d_ = 2 * (g_) + e_; \
                        kf[(g_) & 1][2 * e_] = *(const LAS bf16x8*)(Ks + ka[d_ & 3] + (d_ >> 2) * 128); kf[(g_) & 1][2 * e_ + 1] = *(const LAS bf16x8*)(Ks + ka[d_ & 3] + (d_ >> 2) * 128 + 32 * 384); \
                        if (d_ >= 8) qx[(g_) & 1][e_] = *(const LAS bf16x8*)(qrl + ((d_ - 8) * 64 + lane) * 16); } } while (0)
                    MLA_KREAD(0);
#pragma unroll
                    for (int g = 0; g < 6; ++g) {
                        if (g + 1 < 6) MLA_KREAD(g + 1);
                        FA_SBAR();
#pragma unroll
                        for (int e = 0; e < 2; ++e) { const int d0 = 2 * g + e; const bf16x8 qv = (d0 < 8) ? qr[d0 < 8 ? d0 : 0] : qx[g & 1][e];
                            p0 = __builtin_amdgcn_mfma_f32_32x32x16_bf16(kf[g & 1][2 * e], qv, p0, 0, 0, 0);
                            p1 = __builtin_amdgcn_mfma_f32_32x32x16_bf16(kf[g & 1][2 * e + 1], qv, p1, 0, 0, 0); }
                        FA_SBAR(); }
#undef MLA_KREAD
                    if (tt >= 0) { const int rrel = 32 * wid + r32 - 64 * tt;
#pragma unroll
                        for (int r = 0; r < 16; ++r) { const int kk = crow(r, hi); if (kk > rrel) p0[r] = -1e30f; if (32 + kk > rrel) p1[r] = -1e30f; } }
                    float mn, alpha; partialSM(p0, p1, m_reg, mn, alpha, C, THRS);
                    FA_RESC(alpha, o, al_l, r32, hi);
                    bf16x8 pa0, pa1, pa2, pa3; finishSM(p0, p1, alpha, l_reg, pa0, pa1, pa2, pa3); FA_SBAR();
                    pv_d0(o, vb0 + buf * SHM_V, pa0, pa1, pa2, pa3);
                }
                if (t + 1 < nt) MLA_SWRITE(buf ^ 1);
                __syncthreads();
            }
#undef MLA_SLOAD
#undef MLA_SWRITE
            if (hi == 0) li_l[r32] = l_reg;
            asm volatile("s_waitcnt lgkmcnt(0)" ::: "memory");
            float rli[16];
#pragma unroll
            for (int r = 0; r < 16; ++r) rli[r] = __builtin_amdgcn_rcpf(li_l[crow(r, hi)]);
            { int lane_ = lane; asm volatile("" : "+v"(lane_)); store_o_bf16(o, rli, Oabc + (tok0 + qb * 256 + wid * 32) * 3072 + 2048 + h * 128, 3072, lane_, lane_ & 31, lane_ >> 5); }
        }
    }
}


#define KSWZ256(row, colB) ((row) * 256 + ((colB) ^ (((row) & 7) << 4)))
constexpr int RSL_OFF = 132096 + 8192;
constexpr int XSCR_OFF = 132096;
__device__ __forceinline__ void cross_attn_phase(LAS unsigned char* lds_all, const bf16* XQ, const bf16* MKV, bf16* OX, int vcu, int G, int tid) {
    using namespace fa;
    asm volatile("" : "+v"(tid));
    const int wid = __builtin_amdgcn_readfirstlane(tid >> 6), lane = tid & 63, r32 = lane & 31, hi = lane >> 5;
    LAS unsigned char* lds = lds_all;
    LAS float* li_l = (LAS float*)(lds_all + XSCR_OFF) + wid * 64;
    const int sr = tid >> 4, ch = tid & 15;
    const int kst = KSWZ256(sr, ch * 16), vst = v_st(sr, ch * 8);
    const unsigned loff = (unsigned)((sr * 4096 + ch * 8) * 2);
    const unsigned qoff = (unsigned)(((wid * 32 + r32) * 2048 + hi * 8) * 2);
    const int vb0 = (int)(uintptr_t)lds + v_rd_base(lane);
    int ka[4];
#pragma unroll
    for (int j = 0; j < 4; ++j) ka[j] = r32 * 256 + (((j * 2 + hi) ^ (r32 & 7)) << 4);
    constexpr float SCALE = 0.04419417382415922f, C = SCALE * 1.4426950408889634f;
#pragma unroll 1
    for (int u = vcu; u < 256; u += G) {
        const int b = u >> 6, h = (u >> 4) & 3, qblk = u & 15;
        const char* Qu = (const char*)(XQ + ((size_t)b * SEQ + qblk * 256) * 2048 + h * 512);
        const char* Ku = (const char*)(MKV + (size_t)b * MEML * 4096 + h * 512);
        v4u st[8];
#define XS_LOAD(base) do { _Pragma("unroll") for (int i_ = 0; i_ < 8; ++i_) st[i_] = *(const v4u*)((base) + (size_t)i_ * 262144 + loff); } while (0)
#define XS_WRITE_K(bb) do { _Pragma("unroll") for (int i_ = 0; i_ < 8; ++i_) *(LAS v4u*)(lds + (bb) * 65536 + (i_ >> 1) * 16384 + (i_ & 1) * 8192 + kst) = st[i_]; } while (0)
#define XS_WRITE_V(bb) do { _Pragma("unroll") for (int i_ = 0; i_ < 8; ++i_) *(LAS v4u*)(lds + (bb) * 65536 + (i_ >> 1) * 16384 + (i_ & 1) * 8192 + vst) = st[i_]; } while (0)
        XS_LOAD(Ku); XS_WRITE_K(0); __syncthreads();
        f32x16 p[4][2];
#pragma unroll
        for (int t = 0; t < 4; ++t)
#pragma unroll
            for (int r = 0; r < 16; ++r) { p[t][0][r] = 0.f; p[t][1][r] = 0.f; }
#pragma unroll
        for (int dc = 0; dc < 4; ++dc) {
            if (dc < 3) XS_LOAD(Ku + (dc + 1) * 256); else XS_LOAD(Ku + 4096);
            const LAS unsigned char* Ks = lds + (dc & 1) * 65536;
#pragma unroll
            for (int d0 = 0; d0 < 8; ++d0) {
                const bf16x8 qf = *(const bf16x8*)(Qu + qoff + (dc * 128 + d0 * 16) * 2);
#pragma unroll
                for (int t = 0; t < 4; ++t) {
                    const bf16x8 b0 = *(const LAS bf16x8*)(Ks + t * 16384 + ka[d0 & 3] + (d0 >> 2) * 128); const bf16x8 b1 = *(const LAS bf16x8*)(Ks + t * 16384 + ka[d0 & 3] + (d0 >> 2) * 128 + 32 * 256);
                    p[t][0] = __builtin_amdgcn_mfma_f32_32x32x16_bf16(b0, qf, p[t][0], 0, 0, 0);
                    p[t][1] = __builtin_amdgcn_mfma_f32_32x32x16_bf16(b1, qf, p[t][1], 0, 0, 0); }
                FA_SBAR(); }
            if (dc < 3) XS_WRITE_K((dc + 1) & 1); else XS_WRITE_V(0);
            __syncthreads();
        }
        float mx = p[0][0][0];
#pragma unroll
        for (int t = 0; t < 4; ++t)
#pragma unroll
            for (int r = 0; r < 16; ++r) { mx = fmaxf(mx, p[t][0][r]); mx = fmaxf(mx, p[t][1][r]); }
        { auto rr = __builtin_amdgcn_permlane32_swap(__float_as_uint(mx), __float_as_uint(mx), false, false); mx = fmaxf(__uint_as_float(rr[0]), __uint_as_float(rr[1])); }
        const float mC = -mx * C; float ps = 0.f;
#pragma unroll
        for (int t = 0; t < 4; ++t)
#pragma unroll
            for (int r = 0; r < 16; ++r) { p[t][0][r] = __builtin_amdgcn_exp2f(fmaf(p[t][0][r], C, mC)); p[t][1][r] = __builtin_amdgcn_exp2f(fmaf(p[t][1][r], C, mC)); ps += p[t][0][r] + p[t][1][r]; }
        { auto rr = __builtin_amdgcn_permlane32_swap(__float_as_uint(ps), __float_as_uint(ps), false, false); ps = __uint_as_float(rr[0]) + __uint_as_float(rr[1]); }
        bf16x8 pa[4][4];
#pragma unroll
        for (int t = 0; t < 4; ++t) { FA_PK4(p[t][0], 0, pa[t][0]); FA_PK4(p[t][0], 8, pa[t][1]); FA_PK4(p[t][1], 0, pa[t][2]); FA_PK4(p[t][1], 8, pa[t][3]); }
        if (hi == 0) li_l[r32] = ps;
        asm volatile("s_waitcnt lgkmcnt(0)" ::: "memory");
        float rli[16];
#pragma unroll
        for (int r = 0; r < 16; ++r) rli[r] = __builtin_amdgcn_rcpf(li_l[crow(r, hi)]);
#pragma unroll
        for (int vc = 0; vc < 4; ++vc) {
            if (vc < 3) XS_LOAD(Ku + 4096 + (vc + 1) * 256);
            f32x16 o[4];
#pragma unroll
            for (int d = 0; d < 4; ++d)
#pragma unroll
                for (int r = 0; r < 16; ++r) o[d][r] = 0.f;
            const int vb = vb0 + (vc & 1) * 65536;
            pv_d0<0>(o, vb, pa[0][0], pa[0][1], pa[0][2], pa[0][3]); pv_d0<16384>(o, vb, pa[1][0], pa[1][1], pa[1][2], pa[1][3]);
            pv_d0<32768>(o, vb, pa[2][0], pa[2][1], pa[2][2], pa[2][3]); pv_d0<49152>(o, vb, pa[3][0], pa[3][1], pa[3][2], pa[3][3]);
            store_o_bf16(o, rli, OX + ((size_t)b * SEQ + qblk * 256 + wid * 32) * 2048 + h * 512 + vc * 128, 2048, lane, r32, hi);
            if (vc < 3) XS_WRITE_V((vc + 1) & 1);
            __syncthreads();
        }
#undef XS_LOAD
#undef XS_WRITE_K
#undef XS_WRITE_V
    }
}


constexpr int GL_CUM = 0, GL_QD = 32768, GL_KI = 49152, GL_KS = 32768, GL_V = 65536, GL_BLR = 98304;
__device__ __forceinline__ fa::s16x4 tr_read_dyn(int addr) { fa::s16x4 r; asm volatile("ds_read_b64_tr_b16 %0, %1" : "=&v"(r) : "v"(addr) : "memory"); return r; }
#define GL_PK(L, H) (fa::bf16x8){L[0], L[1], L[2], L[3], H[0], H[1], H[2], H[3]}
struct GlaPre { unsigned short b0, b1; };
__device__ __forceinline__ GlaPre gla_blr_load(const bf16* Z, size_t m0, int tid) {
    GlaPre p; p.b0 = *(const unsigned short*)(Z + (m0 + (tid >> 4)) * NABC + ZC_BLR + (tid & 15)); p.b1 = *(const unsigned short*)(Z + (m0 + 32 + (tid >> 4)) * NABC + ZC_BLR + (tid & 15)); return p; }
__device__ __forceinline__ void gla_cum(LAS unsigned char* lds, const GlaPre pre, const float (&wa)[16], const float ba, int tid) {
    LAS float* cum = (LAS float*)(lds + GL_CUM); LAS float* blr = (LAS float*)(lds + GL_BLR); LAS float* tot = blr + 1024;
    blr[tid] = __uint_as_float((unsigned)pre.b0 << 16); blr[tid + 512] = __uint_as_float((unsigned)pre.b1 << 16);
    const int k = tid & 127, q = tid >> 7;
    __syncthreads();
    float c[16]; float run = 0.f;
#pragma unroll
    for (int i2 = 0; i2 < 16; i2 += 4) {
        f32x4 bb[16];
#pragma unroll
        for (int e = 0; e < 16; ++e) bb[e] = *(const LAS f32x4*)(blr + (16 * q + i2 + (e >> 2)) * 16 + 4 * (e & 3));
        asm volatile("" : "+v"(bb[0]), "+v"(bb[1]), "+v"(bb[2]), "+v"(bb[3]), "+v"(bb[4]), "+v"(bb[5]), "+v"(bb[6]), "+v"(bb[7]), "+v"(bb[8]), "+v"(bb[9]), "+v"(bb[10]), "+v"(bb[11]), "+v"(bb[12]), "+v"(bb[13]), "+v"(bb[14]), "+v"(bb[15]) :: "memory");
#pragma unroll
        for (int ii = 0; ii < 4; ++ii) { float x = ba;
#pragma unroll
            for (int j4 = 0; j4 < 4; ++j4) { const f32x4 b4 = bb[ii * 4 + j4]; x += b4.x * wa[4 * j4] + b4.y * wa[4 * j4 + 1] + b4.z * wa[4 * j4 + 2] + b4.w * wa[4 * j4 + 3]; }
            const float ls = fminf(x, 0.f) - 0.6931471805599453f * __builtin_amdgcn_logf(1.0f + __builtin_amdgcn_exp2f(-1.4426950408889634f * fabsf(x)));
            run += ls * (1.0f / 16.0f); c[i2 + ii] = run; } }
    tot[q * 128 + k] = run;
    __syncthreads();
    float off = 0.f;
#pragma unroll
    for (int qq = 0; qq < 3; ++qq) off += (qq < q) ? tot[qq * 128 + k] : 0.f;
#pragma unroll
    for (int i = 0; i < 16; ++i) cum[(16 * q + i) * 128 + k] = c[i] + off;
    __syncthreads();
}
__device__ __forceinline__ void gla_alpha_load(float (&wa)[16], float& ba, const float* w_alpha, const float* b_alpha, int h, int tid) {
    const int k = tid & 127;
#pragma unroll
    for (int j = 0; j < 16; ++j) wa[j] = w_alpha[j * 512 + h * 128 + k];
    ba = b_alpha[h * 128 + k];
}
struct GlaV { v4u w[4]; };
__device__ __forceinline__ GlaV gla_load_v(const bf16* Z, size_t m0, int h, int tid) {
    GlaV v;
#pragma unroll
    for (int i = 0; i < 4; ++i) { const int piece = tid + 512 * i, t = piece >> 5, cc = (piece & 31) * 8; v.w[i] = *(const v4u*)(Z + (m0 + t) * NABC + ZC_BV + h * 256 + cc); }
    return v; }
__device__ __forceinline__ void gla_write_v(LAS unsigned char* lds, const GlaV& v, int tid) {
#pragma unroll
    for (int i = 0; i < 4; ++i) { const int piece = tid + 512 * i, t = piece >> 5, cc = (piece & 31) * 8; *(LAS v4u*)(lds + GL_V + (cc >> 7) * 16384 + fa::v_st(t, cc & 127)) = v.w[i]; }
}
__device__ __forceinline__ void gla_g1(LAS unsigned char* lds, const bf16* Z, bf16* ST, float* DEC, const GlaPre pre, const float (&wa)[16], const float ba, int item, int tid) {
    using namespace fa;
    asm volatile("" : "+v"(tid));
    const int wid = __builtin_amdgcn_readfirstlane(tid >> 6), lane = tid & 63, r32 = lane & 31, hf = lane >> 5;
    const int bh = item >> 6, n = item & 63, b = bh >> 2, h = bh & 3; const size_t m0 = (size_t)b * SEQ + 64 * n;
    v4u kraw[2];
#pragma unroll
    for (int i = 0; i < 2; ++i) { const int t = (tid >> 4) + 32 * i, kc = (tid & 15) * 8; kraw[i] = *(const v4u*)(Z + (m0 + t) * NABC + ZC_BK + h * 128 + kc); }
    const GlaV vraw = gla_load_v(Z, m0, h, tid);
    gla_cum(lds, pre, wa, ba, tid);
    const LAS float* cum = (const LAS float*)(lds + GL_CUM);
#pragma unroll
    for (int i = 0; i < 2; ++i) { const int t = (tid >> 4) + 32 * i, kc = (tid & 15) * 8;
        const v4u kw = kraw[i];
        const f32x4 c0 = *(const LAS f32x4*)(cum + t * 128 + kc), c1 = *(const LAS f32x4*)(cum + t * 128 + kc + 4), l0 = *(const LAS f32x4*)(cum + 63 * 128 + kc), l1 = *(const LAS f32x4*)(cum + 63 * 128 + kc + 4);
        v4u o; o.x = pk2(bflo(kw.x) * __expf(l0.x - c0.x), bfhi(kw.x) * __expf(l0.y - c0.y)); o.y = pk2(bflo(kw.y) * __expf(l0.z - c0.z), bfhi(kw.y) * __expf(l0.w - c0.w));
        o.z = pk2(bflo(kw.z) * __expf(l1.x - c1.x), bfhi(kw.z) * __expf(l1.y - c1.y)); o.w = pk2(bflo(kw.w) * __expf(l1.z - c1.z), bfhi(kw.w) * __expf(l1.w - c1.w));
        *(LAS v4u*)(lds + GL_KS + v_st(t, kc)) = o; }
    gla_write_v(lds, vraw, tid);
    if (tid < 128) DEC[(size_t)item * 128 + tid] = __expf(cum[63 * 128 + tid]);
    __syncthreads();
    f32x16 acc[4];
#pragma unroll
    for (int kt = 0; kt < 4; ++kt)
#pragma unroll
        for (int r = 0; r < 16; ++r) acc[kt][r] = 0.f;
    const int rb = v_rd_base(lane); const int vbV = (int)(uintptr_t)(lds + GL_V) + (wid >> 2) * 16384 + rb, vbK = (int)(uintptr_t)(lds + GL_KS) + rb;
#pragma unroll
    for (int ks = 0; ks < 4; ++ks) {
        s16x4 bl = tr_read_dyn(vbV + v_rd_off(wid & 3, ks, 0)), bhh = tr_read_dyn(vbV + v_rd_off(wid & 3, ks, 1));
        s16x4 al[4], ah[4];
#pragma unroll
        for (int kt = 0; kt < 4; ++kt) { al[kt] = tr_read_dyn(vbK + v_rd_off(kt, ks, 0)); ah[kt] = tr_read_dyn(vbK + v_rd_off(kt, ks, 1)); }
        asm volatile("s_waitcnt lgkmcnt(0)" : "+v"(bl), "+v"(bhh), "+v"(al[0]), "+v"(ah[0]), "+v"(al[1]), "+v"(ah[1]), "+v"(al[2]), "+v"(ah[2]), "+v"(al[3]), "+v"(ah[3]) :: "memory"); FA_SBAR();
#pragma unroll
        for (int kt = 0; kt < 4; ++kt) acc[kt] = __builtin_amdgcn_mfma_f32_32x32x16_bf16(GL_PK(al[kt], ah[kt]), GL_PK(bl, bhh), acc[kt], 0, 0, 0);
    }
    bf16* stp = ST + ((size_t)item * 256 + 32 * wid + r32) * 128 + 4 * hf;
#pragma unroll
    for (int kt = 0; kt < 4; ++kt)
#pragma unroll
        for (int g = 0; g < 4; ++g) { v2u w; w.x = pk2(acc[kt][4 * g], acc[kt][4 * g + 1]); w.y = pk2(acc[kt][4 * g + 2], acc[kt][4 * g + 3]); *(v2u*)(stp + 32 * kt + 8 * g) = w; }
    __syncthreads();
}
__device__ __forceinline__ void gla_g2(bf16* ST, const float* DEC, int gid) {
    const int bh = gid >> 13, e = gid & 8191, c = e >> 5, k4 = (e & 31) * 4;
    float s0 = 0.f, s1 = 0.f, s2 = 0.f, s3 = 0.f;
    bf16* p = ST + (((size_t)bh * 64) * 256 + c) * 128 + k4; const float* dp = DEC + (size_t)bh * 64 * 128 + k4;
#pragma unroll 8
    for (int n = 0; n < 64; ++n) {
        const v2u d = *(const v2u*)(p + (size_t)n * 256 * 128); const f32x4 dc = *(const f32x4*)(dp + n * 128);
        v2u w; w.x = pk2(s0, s1); w.y = pk2(s2, s3); *(v2u*)(p + (size_t)n * 256 * 128) = w;
        s0 = dc.x * s0 + bflo(d.x); s1 = dc.y * s1 + bfhi(d.x); s2 = dc.z * s2 + bflo(d.y); s3 = dc.w * s3 + bfhi(d.y); }
}
__device__ __forceinline__ void gla_g3(LAS unsigned char* lds, const bf16* Z, const bf16* ST, bf16* Oabc, const GlaPre pre, const float (&wa)[16], const float ba, const float* gla_norm, int item, int tid) {
    using namespace fa;
    asm volatile("" : "+v"(tid));
    const int wid = __builtin_amdgcn_readfirstlane(tid >> 6), lane = tid & 63, r32 = lane & 31, hf = lane >> 5;
    const int bh = item >> 6, n = item & 63, b = bh >> 2, h = bh & 3; const size_t m0 = (size_t)b * SEQ + 64 * n;
    v4u qraw[2], kraw[2];
#pragma unroll
    for (int i = 0; i < 2; ++i) { const int t = (tid >> 4) + 32 * i, kc = (tid & 15) * 8;
        qraw[i] = *(const v4u*)(Z + (m0 + t) * NABC + ZC_BQ + h * 128 + kc); kraw[i] = *(const v4u*)(Z + (m0 + t) * NABC + ZC_BK + h * 128 + kc); }
    const GlaV vraw = gla_load_v(Z, m0, h, tid);
    gla_cum(lds, pre, wa, ba, tid);
    const LAS float* cum = (const LAS float*)(lds + GL_CUM);
    const float qscale = 0.08838834764831845f;
#pragma unroll
    for (int i = 0; i < 2; ++i) { const int t = (tid >> 4) + 32 * i, kc = (tid & 15) * 8;
        const v4u qw = qraw[i], kw = kraw[i];
        const f32x4 c0 = *(const LAS f32x4*)(cum + t * 128 + kc), c1 = *(const LAS f32x4*)(cum + t * 128 + kc + 4);
        const float e[8] = {__expf(c0.x), __expf(c0.y), __expf(c0.z), __expf(c0.w), __expf(c1.x), __expf(c1.y), __expf(c1.z), __expf(c1.w)};
        const float ei[8] = {__expf(-c0.x), __expf(-c0.y), __expf(-c0.z), __expf(-c0.w), __expf(-c1.x), __expf(-c1.y), __expf(-c1.z), __expf(-c1.w)};
        v4u qo, ko;
        qo.x = pk2(bflo(qw.x) * qscale * e[0], bfhi(qw.x) * qscale * e[1]); qo.y = pk2(bflo(qw.y) * qscale * e[2], bfhi(qw.y) * qscale * e[3]);
        qo.z = pk2(bflo(qw.z) * qscale * e[4], bfhi(qw.z) * qscale * e[5]); qo.w = pk2(bflo(qw.w) * qscale * e[6], bfhi(qw.w) * qscale * e[7]);
        ko.x = pk2(bflo(kw.x) * ei[0], bfhi(kw.x) * ei[1]); ko.y = pk2(bflo(kw.y) * ei[2], bfhi(kw.y) * ei[3]);
        ko.z = pk2(bflo(kw.z) * ei[4], bfhi(kw.z) * ei[5]); ko.w = pk2(bflo(kw.w) * ei[6], bfhi(kw.w) * ei[7]);
        *(LAS v4u*)(lds + GL_QD + KSWZ256(t, kc * 2)) = qo; *(LAS v4u*)(lds + GL_KI + KSWZ256(t, kc * 2)) = ko; }
    gla_write_v(lds, vraw, tid);
    __syncthreads();
    const int ri = wid & 1, cq = wid >> 1;
    bf16x8 qf[8];
#pragma unroll
    for (int d0 = 0; d0 < 8; ++d0) qf[d0] = *(const LAS bf16x8*)(lds + GL_QD + KSWZ256(32 * ri + r32, (d0 * 16 + hf * 8) * 2));
    bf16x8 sfr[2][8];
#pragma unroll
    for (int dd = 0; dd < 2; ++dd) { const bf16* sp = ST + ((size_t)item * 256 + 64 * cq + 32 * dd + r32) * 128 + hf * 8;
#pragma unroll
        for (int d0 = 0; d0 < 8; ++d0) sfr[dd][d0] = *(const bf16x8*)(sp + d0 * 16); }
    f32x16 p0, p1;
#pragma unroll
    for (int r = 0; r < 16; ++r) { p0[r] = 0.f; p1[r] = 0.f; }
#pragma unroll
    for (int d0 = 0; d0 < 8; ++d0) {
        const bf16x8 a0 = *(const LAS bf16x8*)(lds + GL_KI + KSWZ256(r32, (d0 * 16 + hf * 8) * 2)), a1 = *(const LAS bf16x8*)(lds + GL_KI + KSWZ256(32 + r32, (d0 * 16 + hf * 8) * 2));
        p0 = __builtin_amdgcn_mfma_f32_32x32x16_bf16(a0, qf[d0], p0, 0, 0, 0);
        p1 = __builtin_amdgcn_mfma_f32_32x32x16_bf16(a1, qf[d0], p1, 0, 0, 0); }
    { const int irow = 32 * ri + r32;
#pragma unroll
      for (int r = 0; r < 16; ++r) { const int j = crow(r, hf); if (j > irow) p0[r] = 0.f; if (32 + j > irow) p1[r] = 0.f; } }
    bf16x8 pa0, pa1, pa2, pa3;
    FA_PK4(p0, 0, pa0); FA_PK4(p0, 8, pa1); FA_PK4(p1, 0, pa2); FA_PK4(p1, 8, pa3);
    f32x16 o[2];
#pragma unroll
    for (int r = 0; r < 16; ++r) { o[0][r] = 0.f; o[1][r] = 0.f; }
    const int vb = (int)(uintptr_t)(lds + GL_V) + (cq >> 1) * 16384 + v_rd_base(lane);
#pragma unroll
    for (int dd = 0; dd < 2; ++dd) { const int d0v = 2 * (cq & 1) + dd;
        s16x4 l0 = tr_read_dyn(vb + v_rd_off(d0v, 0, 0)), h0 = tr_read_dyn(vb + v_rd_off(d0v, 0, 1)), l1 = tr_read_dyn(vb + v_rd_off(d0v, 1, 0)), h1 = tr_read_dyn(vb + v_rd_off(d0v, 1, 1));
        s16x4 l2 = tr_read_dyn(vb + v_rd_off(d0v, 2, 0)), h2 = tr_read_dyn(vb + v_rd_off(d0v, 2, 1)), l3 = tr_read_dyn(vb + v_rd_off(d0v, 3, 0)), h3 = tr_read_dyn(vb + v_rd_off(d0v, 3, 1));
        asm volatile("s_waitcnt lgkmcnt(0)" : "+v"(l0), "+v"(h0), "+v"(l1), "+v"(h1), "+v"(l2), "+v"(h2), "+v"(l3), "+v"(h3) :: "memory"); FA_SBAR();
        o[dd] = __builtin_amdgcn_mfma_f32_32x32x16_bf16(pa0, GL_PK(l0, h0), o[dd], 0, 0, 0);
        o[dd] = __builtin_amdgcn_mfma_f32_32x32x16_bf16(pa1, GL_PK(l1, h1), o[dd], 0, 0, 0);
        o[dd] = __builtin_amdgcn_mfma_f32_32x32x16_bf16(pa2, GL_PK(l2, h2), o[dd], 0, 0, 0);
        o[dd] = __builtin_amdgcn_mfma_f32_32x32x16_bf16(pa3, GL_PK(l3, h3), o[dd], 0, 0, 0); }
#pragma unroll
    for (int dd = 0; dd < 2; ++dd) {
#pragma unroll
        for (int d0 = 0; d0 < 8; ++d0) o[dd] = __builtin_amdgcn_mfma_f32_32x32x16_bf16(qf[d0], sfr[dd][d0], o[dd], 0, 0, 0); }
    __syncthreads();
    LAS float* Ol = (LAS float*)lds;
#pragma unroll
    for (int dd = 0; dd < 2; ++dd)
#pragma unroll
        for (int r = 0; r < 16; ++r) Ol[(32 * ri + crow(r, hf)) * 256 + 64 * cq + 32 * dd + r32] = o[dd][r];
    __syncthreads();
    { const f32x4 gn = *(const f32x4*)(gla_norm + h * 256 + 4 * lane);
      v2u rw[8]; f32x4 ov[8]; float ss[8];
#pragma unroll
      for (int j = 0; j < 8; ++j) { const int t = wid + NWAVES * j; rw[j] = *(const v2u*)(Z + (m0 + t) * NABC + ZC_BR + h * 256 + 4 * lane); ov[j] = *(const LAS f32x4*)(Ol + t * 256 + 4 * lane); }
      asm volatile("" : "+v"(ov[0]), "+v"(ov[1]), "+v"(ov[2]), "+v"(ov[3]), "+v"(ov[4]), "+v"(ov[5]), "+v"(ov[6]), "+v"(ov[7]) :: "memory");
#pragma unroll
      for (int j = 0; j < 8; ++j) ss[j] = (ov[j].x * ov[j].x + ov[j].y * ov[j].y) + (ov[j].z * ov[j].z + ov[j].w * ov[j].w);
#pragma unroll
      for (int j = 0; j < 8; ++j) ss[j] = wave_sum(ss[j]);
#pragma unroll
      for (int j = 0; j < 8; ++j) { const int t = wid + NWAVES * j; const float rstd = 1.0f / sqrtf(ss[j] * (1.f / 256.f) + EPS);
          const float r0 = bflo(rw[j].x), r1 = bfhi(rw[j].x), r2 = bflo(rw[j].y), r3 = bfhi(rw[j].y);
          v2u w; w.x = pk2(ov[j].x * rstd * gn.x * (r0 * __builtin_amdgcn_rcpf(1.0f + __expf(-r0))), ov[j].y * rstd * gn.y * (r1 * __builtin_amdgcn_rcpf(1.0f + __expf(-r1))));
          w.y = pk2(ov[j].z * rstd * gn.z * (r2 * __builtin_amdgcn_rcpf(1.0f + __expf(-r2))), ov[j].w * rstd * gn.w * (r3 * __builtin_amdgcn_rcpf(1.0f + __expf(-r3))));
          *(v2u*)(Oabc + (m0 + t) * 3072 + 1024 + h * 256 + 4 * lane) = w; } }
    __syncthreads();
}


constexpr int ABIAS_OFF = XSCR_OFF, ASCR_OFF = XSCR_OFF + 12416;
template <int PASS>
__device__ __forceinline__ void attn_a_pass(LAS unsigned char* lds_all, const bf16* ZA, bf16* Oabc, float* ML, const float* rel_bias, int gw, int ngw, int xcd, int inx, int tid) {
    using namespace fa;
    asm volatile("" : "+v"(tid));
    const int wid = __builtin_amdgcn_readfirstlane(tid >> 6);
    constexpr float SCALE = 0.08838834764831845f, C = SCALE * 1.4426950408889634f, THRS = 8.0f / SCALE;
    constexpr int RSTR = (PASS == 1) ? 1 : 16;
    LAS float* tab = (LAS float*)(lds_all + ABIAS_OFF);
    const bool per_head = (ngw % 64 == 0);
    const int h_lo = per_head ? xcd : 0, h_hi = per_head ? h_lo + 1 : 8;
    const int wih = per_head ? (inx * 8 + wid) : gw, nwh = per_head ? (ngw >> 3) : ngw;
    LAS float* wsf = (LAS float*)(lds_all + ASCR_OFF) + wid * 64; LAS float* li_l = wsf; LAS float* al_l = wsf + 32;
    LAS unsigned char* Vl = lds_all + wid * 16384;
#pragma unroll 1
    for (int h = h_lo; h < h_hi; ++h) {
    __syncthreads();
    for (int i = wid * 64 + lane_id_now(); i < 3 * 512; i += NWAVES * 64) { const int g = i >> 9, d = (i & 511) - 192;
        tab[i] = (d >= 0 && d <= 128) ? rel_bias[t5_bucket(d << (2 * g)) * 8 + h] * (1.0f / SCALE) : -1e30f; }
    __syncthreads();
#pragma unroll 1
    for (int q = wih; q < 512; q += nwh) {
        const int lane = lane_id_now(), r32 = lane & 31, hf = lane >> 5;
    const int vb = (int)(uintptr_t)Vl + v_rd_base(lane);
        const int vkey = lane >> 4, vch = lane & 15, vstb = v_st(vkey, vch * 8);
        const int kst0 = vkey * 256 + ((vch * 16) ^ (vkey << 4));
        const int ka0 = r32 * 256 + ((hf ^ (r32 & 7)) << 4);
        int t0, b, c16 = 0;
        if (PASS == 1) { t0 = 32 * (q & 127); b = q >> 7; }
        else { const int l0 = 32 * (q & 7); c16 = (q >> 3) & 15; b = q >> 7; t0 = c16 + 16 * l0; }
        const bf16* Zb = ZA + (size_t)b * SEQ * NA + h * 128; const char* Zbc = (const char*)Zb;
        bf16* Ob = Oabc + ((size_t)b * SEQ + t0) * 3072 + h * 128;
        float* MLb = ML + ((size_t)b * SEQ + t0) * 16 + h * 2;
        bf16x8 qf[8];
        { const bf16* qp = Zb + (size_t)(t0 + RSTR * r32) * NA + ZA_Q + hf * 8;
#pragma unroll
          for (int d0 = 0; d0 < 8; ++d0) qf[d0] = *(const bf16x8*)(qp + d0 * 16); }
        float m_reg = -1e30f, l_reg = 0.f; f32x16 o[4];
        if (PASS != 2) {
#pragma unroll
            for (int d = 0; d < 4; ++d)
#pragma unroll
                for (int r = 0; r < 16; ++r) o[d][r] = 0.f;
        } else {
            const float2 ml = *(const float2*)(MLb + (size_t)(RSTR * r32) * 16); m_reg = ml.x; l_reg = ml.y;
            if (hf == 0) li_l[r32] = l_reg;
            asm volatile("s_waitcnt lgkmcnt(0)" ::: "memory");
            unsigned short ob[4][16];
#pragma unroll
            for (int r = 0; r < 16; ++r) {
                const char* rowp = (const char*)(Ob + (size_t)(RSTR * ((r & 3) + 8 * (r >> 2))) * 3072);
                const unsigned lo = (unsigned)((RSTR * 4 * hf * 3072 + r32) * 2);
#pragma unroll
                for (int d = 0; d < 4; ++d) ob[d][r] = *(const unsigned short*)(rowp + lo + 64 * d); }
#pragma unroll
            for (int d = 0; d < 4; ++d)
                asm volatile("" : "+v"(ob[d][0]), "+v"(ob[d][1]), "+v"(ob[d][2]), "+v"(ob[d][3]), "+v"(ob[d][4]), "+v"(ob[d][5]), "+v"(ob[d][6]), "+v"(ob[d][7]), "+v"(ob[d][8]), "+v"(ob[d][9]), "+v"(ob[d][10]), "+v"(ob[d][11]), "+v"(ob[d][12]), "+v"(ob[d][13]), "+v"(ob[d][14]), "+v"(ob[d][15]) :: "memory");
#pragma unroll
            for (int r = 0; r < 16; ++r) { const float lr = li_l[crow(r, hf)];
#pragma unroll
                for (int d = 0; d < 4; ++d) o[d][r] = __uint_as_float((unsigned)ob[d][r] << 16) * lr; }
        }
#pragma unroll 1
        for (int g = (PASS == 2 ? 1 : 0); g < (PASS == 1 ? 1 : 3); ++g) {
            const int sh = 2 * g, sigma = RSTR >> sh, cls = c16 & ((1 << sh) - 1), base = ((t0 - cls) >> sh) - 128, ntile = (31 * sigma + 192) >> 6;
            const LAS float* tg = tab + g * 512;
            v4u kc[16];
#define AA_LOADKC(tile_) do { _Pragma("unroll") for (int i_ = 0; i_ < 16; ++i_) { int tk = cls + ((base + (tile_) * 64 + 4 * i_ + vkey) << sh); tk = tk < 0 ? 0 : (tk > SEQ - 1 ? SEQ - 1 : tk); \
                    kc[i_] = *(const v4u*)(Zbc + (unsigned)tk * (NA * 2) + (ZA_K + vch * 8) * 2); } } while (0)
#define AA_WRITEKC() do { _Pragma("unroll") for (int i_ = 0; i_ < 16; ++i_) *(LAS v4u*)(Vl + i_ * 1024 + ((i_ & 1) ? (kst0 ^ 64) : kst0)) = kc[i_]; } while (0)
            AA_LOADKC(0); AA_WRITEKC();
#pragma unroll 1
            for (int tile = 0; tile < ntile; ++tile) {
#define AA_LOADV(vv_, i0_) do { _Pragma("unroll") for (int i_ = 0; i_ < 8; ++i_) { int tk = cls + ((base + tile * 64 + 4 * ((i0_) + i_) + vkey) << sh); tk = tk < 0 ? 0 : (tk > SEQ - 1 ? SEQ - 1 : tk); \
                    vv_[i_] = *(const v4u*)(Zbc + (unsigned)tk * (NA * 2) + (ZA_V + vch * 8) * 2); } } while (0)
#define AA_WRITEV(vv_, i0_) do { _Pragma("unroll") for (int i_ = 0; i_ < 8; ++i_) { const int i = (i0_) + i_; *(LAS v4u*)(Vl + vstb + ((i & 1) + 2 * (i >> 2)) * 2048 + ((i >> 1) & 1) * 256) = vv_[i_]; } } while (0)
                v4u va[8];
                AA_LOADV(va, 0);
                FA_SBAR();
                f32x16 p0, p1;
#pragma unroll
                for (int r = 0; r < 16; ++r) { p0[r] = 0.f; p1[r] = 0.f; }
#pragma unroll
                for (int d0 = 0; d0 < 8; ++d0) { const bf16x8 b0 = *(const LAS bf16x8*)(Vl + (ka0 ^ (32 * (d0 & 3))) + (d0 >> 2) * 128), b1 = *(const LAS bf16x8*)(Vl + (ka0 ^ (32 * (d0 & 3))) + (d0 >> 2) * 128 + 8192);
                    p0 = __builtin_amdgcn_mfma_f32_32x32x16_bf16(b0, qf[d0], p0, 0, 0, 0); p1 = __builtin_amdgcn_mfma_f32_32x32x16_bf16(b1, qf[d0], p1, 0, 0, 0); }
                asm volatile("s_waitcnt lgkmcnt(0)" ::: "memory"); FA_SBAR();
                AA_WRITEV(va, 0);
                v4u vbq[8];
                AA_LOADV(vbq, 8);
                FA_SBAR();
                { const int dq = sigma * r32 + 128 - tile * 64, sb = base + tile * 64;
                  const LAS float* tl = tg + (dq + 192 - 4 * hf - 59);
                  float tb0[16], tb1[16];
#pragma unroll
                  for (int r = 0; r < 16; ++r) { const int rc = (r & 3) + 8 * (r >> 2); tb0[r] = tl[59 - rc]; tb1[r] = tl[27 - rc]; }
                  asm volatile("" : "+v"(tb0[0]), "+v"(tb0[1]), "+v"(tb0[2]), "+v"(tb0[3]), "+v"(tb0[4]), "+v"(tb0[5]), "+v"(tb0[6]), "+v"(tb0[7]), "+v"(tb0[8]), "+v"(tb0[9]), "+v"(tb0[10]), "+v"(tb0[11]), "+v"(tb0[12]), "+v"(tb0[13]), "+v"(tb0[14]), "+v"(tb0[15]) :: "memory");
                  asm volatile("" : "+v"(tb1[0]), "+v"(tb1[1]), "+v"(tb1[2]), "+v"(tb1[3]), "+v"(tb1[4]), "+v"(tb1[5]), "+v"(tb1[6]), "+v"(tb1[7]), "+v"(tb1[8]), "+v"(tb1[9]), "+v"(tb1[10]), "+v"(tb1[11]), "+v"(tb1[12]), "+v"(tb1[13]), "+v"(tb1[14]), "+v"(tb1[15]) :: "memory");
#pragma unroll
                  for (int r = 0; r < 16; ++r) { p0[r] += tb0[r]; p1[r] += tb1[r]; }
                  if (sb < 0) {
#pragma unroll
                      for (int r = 0; r < 16; ++r) { const int s = crow(r, hf); if (sb + s < 0) p0[r] = -1e30f; if (sb + s + 32 < 0) p1[r] = -1e30f; } } }
                float mn, alpha; partialSM(p0, p1, m_reg, mn, alpha, C, THRS);
                FA_RESC(alpha, o, al_l, r32, hf);
                bf16x8 pa0, pa1, pa2, pa3; finishSM(p0, p1, alpha, l_reg, pa0, pa1, pa2, pa3); FA_SBAR();
                AA_WRITEV(vbq, 8);
                asm volatile("s_waitcnt lgkmcnt(0)" ::: "memory"); FA_SBAR();
                { const int tn = (tile + 1 < ntile) ? tile + 1 : tile; AA_LOADKC(tn); }
                FA_SBAR();
                pv_d0(o, vb, pa0, pa1, pa2, pa3);
                FA_SBAR();
                if (tile + 1 < ntile) AA_WRITEKC();
            }
#undef AA_LOADKC
#undef AA_WRITEKC
#undef AA_LOADV
#undef AA_WRITEV
        }
        if (hf == 0) li_l[r32] = l_reg;
        asm volatile("s_waitcnt lgkmcnt(0)" ::: "memory");
        float rli[16];
#pragma unroll
        for (int r = 0; r < 16; ++r) rli[r] = __builtin_amdgcn_rcpf(li_l[crow(r, hf)]);
        store_o_bf16(o, rli, Ob, RSTR * 3072, lane, r32, hf);
        if (PASS == 1 && hf == 0) *(float2*)(MLb + (size_t)r32 * 16) = make_float2(m_reg, l_reg);
    }
    }
    __syncthreads();
}

__device__ __forceinline__ void group_barrier(unsigned* cnt, const unsigned target, const bool release, const bool thread0) {
    asm volatile("s_waitcnt vmcnt(0)" ::: "memory");
    __syncthreads();
    if (thread0) {
        asm volatile("" : "+s"(cnt));
        if (release) { __builtin_amdgcn_fence(__ATOMIC_RELEASE, "agent"); asm volatile("s_waitcnt vmcnt(0)" ::: "memory"); }
        (void)xb_add(cnt, 1u);
        for (unsigned sp = 0; xb_ld(cnt) < target && sp < XB_SPIN_CAP; ++sp) __builtin_amdgcn_s_sleep(1);
        __builtin_amdgcn_fence(__ATOMIC_ACQUIRE, "agent");
        asm volatile("s_waitcnt vmcnt(0)" ::: "memory");
    }
    __syncthreads();
}

__global__ void __launch_bounds__(NWAVES * 64, 2) fwd_kernel(Args args) {
    extern __shared__ __attribute__((aligned(16))) unsigned char lds_raw[];
    LAS unsigned char* lds = (LAS unsigned char*)lds_raw;
    volatile LAS unsigned* MISC = (volatile LAS unsigned*)(lds + MISC_OFF);
    const int tid0 = threadIdx.x;
    const int wave0 = __builtin_amdgcn_readfirstlane(tid0 >> 6);
    const int G = gridDim.x, bx = blockIdx.x;
    const int vcu = (G % 8 == 0) ? (bx % 8) * (G / 8) + bx / 8 : bx;
    const int ngw = G * NWAVES;
#define PHASE_LOCALS unsigned long long wsu_ = (unsigned long long)ws0; asm volatile("" : "+s"(wsu_)); unsigned char* ws = (unsigned char*)(GAS unsigned char*)wsu_; unsigned long long xou_ = (unsigned long long)xo0; asm volatile("" : "+s"(xou_)); float* xo = (float*)(GAS float*)xou_; BODY_LOCALS
    unsigned char* const ws0 = args.ws;
    for (int u = tid0; u < (LDS_BYTES - LDSCTL_OFF) / 4; u += NWAVES * 64) ((LAS unsigned*)(lds + LDSCTL_OFF))[u] = 0u;
    __syncthreads();
    LAS unsigned long long* PTAB = (LAS unsigned long long*)(lds + PTAB_OFF);
    if (tid0 == 0) {
#define PT(k) PTAB[k] = (unsigned long long)args.in[k];
        PT(0) PT(1) PT(2) PT(3) PT(4) PT(5) PT(6) PT(7) PT(8) PT(9) PT(10) PT(11) PT(12) PT(13) PT(14) PT(15) PT(16) PT(17) PT(18) PT(19) PT(20) PT(21) PT(22) PT(23) PT(24) PT(25) PT(26)
#undef PT
    }
    __syncthreads();
#if MK_ONE_LAUNCH
    { const XcdBarrier bar0 = xcd_barrier_post((unsigned*)(ws0 + WS_CTL) + CW_BAR, MISC + 8);
      unsigned* xp = (unsigned*)(ws0 + WS_CTL) + CW_XID + bx; unsigned xv = bar0.x + 1u; asm volatile("" : "+s"(xp), "+s"(xv));
      if (tid0 == 0) *xp = xv; }
#define GRID_BAR() do { XcdBarrier bar_; bar_.bar = (unsigned*)(ws0 + WS_CTL) + CW_BAR; bar_.x = xb_xcc_id(); bar_.st = MISC + 8; xcd_barrier(bar_, wave0 == 0 && lane_id_now() == 0); } while (0)
#define GROUP_SEAM(k, idx) do { if (IN(k) && IN((k) + 1)) { const bool g4_ = (G == 256); \
        group_barrier((unsigned*)(ws0 + WS_CTL) + CW_GRP + (g4_ ? 32 * (bx & 63) : 0), (g4_ ? 4u : (unsigned)G) * (unsigned)(5 * l + (idx) + 1), MISC[16] == 0u, wave0 == 0 && lane_id_now() == 0); } } while (0)
#else
#define GRID_BAR() do { } while (0)
#define GROUP_SEAM(k, idx) do { } while (0)
#endif
#if !MK_ONE_LAUNCH
    const int lo = args.ph_lo, hi = args.ph_hi;
#endif
#if MK_ONE_LAUNCH
#define IN(k) true
#else
#define IN(k) (lo <= (k) && (k) < hi)
#endif
#define SEAM(k) do { if (IN(k) && IN((k) + 1)) GRID_BAR(); } while (0)

    float* const xo0 = args.out;
#define INP(k) ldptr(PTAB, (k))
#define WSP(off) ((bf16*)(ws + (off)))
    LAS unsigned char* ring = lds + RING_OFF;
#define BODY_LOCALS int tid = wave0 * 64 + lane_id_now(); const int lane = tid & 63; const int wave = __builtin_amdgcn_readfirstlane(tid >> 6); const int gw = vcu * NWAVES + wave; (void)lane; (void)gw; (void)wave;

#define PANEL_RS(S_, same_) bool same_ = true; { int pm_c_ = -1; pg8::Unit u_; for (int i_ = 0; S_.next(i_, u_); ++i_) { if (u_.br == 3) continue; if (pm_c_ < 0) pm_c_ = u_.pm; else if (u_.pm != pm_c_) same_ = false; } \
        if (same_ && pm_c_ >= 0) { const f32x4* p_ = (const f32x4*)((const float*)(ws + WS_SS) + ((size_t)pm_c_ * 256 + (tid >> 1)) * 32 + (tid & 1) * 16); float s_ = 0.f; \
            _Pragma("unroll") for (int j_ = 0; j_ < 4; ++j_) { const f32x4 v_ = p_[j_]; s_ += (v_[0] + v_[1]) + (v_[2] + v_[3]); } \
            s_ += lane_xor1(s_); if ((tid & 1) == 0) ((LAS float*)(lds + RSL_OFF))[tid >> 1] = 1.0f / sqrtf(s_ * (1.f / 2048.f) + EPS); } \
        __syncthreads(); }
#define RS_FROM_SS() do { const float* ss_ = (const float*)(ws + WS_SS); float* rs_ = (float*)(ws + WS_RS); \
        for (int m_ = 2 * gw + (lane >> 5); m_ < M; m_ += 2 * ngw) { float s_ = ss_[(size_t)m_ * 32 + (lane & 31)]; \
            s_ += __shfl_xor(s_, 1); s_ += __shfl_xor(s_, 2); s_ += __shfl_xor(s_, 4); s_ += __shfl_xor(s_, 8); s_ += __shfl_xor(s_, 16); \
            if ((lane & 31) == 0) rs_[m_] = 1.0f / sqrtf(s_ * (1.f / 2048.f) + EPS); } } while (0)
    for (int l = 0; l < 2; ++l) {
        const int P = l * PH_PER_LAYER;

        if (((PHASE_MASK >> 0) & 1) && IN(P + 0)) for (int rep_ = 0; rep_ < 1 + ((PHASE_TWICE >> 0) & 1); ++rep_) { PHASE_LOCALS
            LAS float* scr = (LAS float*)(ring + wave * 16384);
            const float* w_in = INP(4) + (size_t)l * D * DIN_SRC;
            constexpr int TOT = 32 * 160 + 32 * 32 + 32 * 34 + 32 * 1 + 32 * 192 + 8 * 48 + 8 * 64 + 3 * 16 * 64 + 32 * 64 + 32 * 128 + 32 * 64 + 2 * 32 * 176 + 88 * 64;
#ifndef REP0
#define REP0 1
#endif
#pragma unroll 1
            for (int rep0 = 0; rep0 < REP0; ++rep0)
            for (int it = gw; it < TOT; it += ngw) {
                int r = it;
                if (seg_item<MAP_LIN>(r, w_in, D, DIN_SRC, 0, 5120, WSP(WS_WIN), D, 0, 0, scr, lane, INP(3) + l * D)) continue;
                if (seg_item<MAP_LIN>(r, w_in, D, DIN_SRC, 5136, 1024, WSP(WS_WIN), D, 5120, 0, scr, lane, INP(3) + l * D)) continue;
                if (seg_item<MAP_LIN>(r, w_in, D, DIN_SRC, 6160, 1088, WSP(WS_WIN), D, 6144, 0, scr, lane, INP(3) + l * D)) continue;
                if (seg_item<MAP_LIN>(r, w_in, D, DIN_SRC, 5120, 16, WSP(WS_WIN), D, 7232, 0, scr, lane, INP(3) + l * D)) continue;
                if (seg_item8(r, w_in, D, DIN_SRC, 7248, 6144, ws + WS_W8, scr, lane, INP(3) + l * D)) continue;
                if (seg_item<MAP_LIN>(r, INP(10) + (size_t)l * 512 * 1536, 512, 1536, 0, 1536, WSP(WS_WQB), 512, 0, 0, scr, lane)) continue;
                if (seg_item<MAP_LIN>(r, INP(12) + (size_t)l * 512 * 2048, 512, 2048, 0, 2048, WSP(WS_WKVB), 512, 0, 0, scr, lane)) continue;
                if (seg_item<MAP_LIN>(r, INP(13) + (size_t)l * 1024 * 2048, 1024, 2048, 0, 2048, WSP(WS_WUP), 3072, 0, 0, scr, lane)) continue;
                if (seg_item<MAP_LIN>(r, INP(14) + (size_t)l * 1024 * 2048, 1024, 2048, 0, 2048, WSP(WS_WUP), 3072, 0, 1024, scr, lane)) continue;
                if (seg_item<MAP_LIN>(r, INP(15) + (size_t)l * 1024 * 2048, 1024, 2048, 0, 2048, WSP(WS_WUP), 3072, 0, 2048, scr, lane)) continue;
                if (seg_item<MAP_LIN>(r, INP(16) + (size_t)l * D * D, D, D, 0, D, WSP(WS_WO), D, 0, 0, scr, lane)) continue;
                if (seg_item<MAP_LIN>(r, INP(20) + (size_t)l * D * 4096, D, 4096, 0, 4096, WSP(WS_WXKV), D, 0, 0, scr, lane)) continue;
                if (seg_item<MAP_LIN>(r, INP(21) + (size_t)l * D * D, D, D, 0, D, WSP(WS_WXO), D, 0, 0, scr, lane)) continue;
                if (seg_item<MAP_GATE>(r, INP(23) + (size_t)l * D * DFF, D, DFF, 0, DFF, WSP(WS_WFF), LDW, 0, 0, scr, lane, INP(22) + l * D)) continue;
                if (seg_item<MAP_UP>(r, INP(24) + (size_t)l * D * DFF, D, DFF, 0, DFF, WSP(WS_WFF), LDW, 0, 0, scr, lane, INP(22) + l * D)) continue;
                seg_item<MAP_LIN>(r, INP(25) + (size_t)l * DFF * D, DFF, D, 0, D, WSP(WS_WDN), LDACT, 0, 0, scr, lane);
            }
            { const float* wq = INP(19) + (size_t)l * D * D; const float* gq = INP(17) + l * D;
              for (int i = gw * 64 + lane; i < D * D / 8; i += ngw * 64) { const f32x4 a = *(const f32x4*)(wq + (size_t)i * 8), bq = *(const f32x4*)(wq + (size_t)i * 8 + 4); const float gg = gq[i >> 8];
                  v4u o; o.x = pk2(a.x * gg, a.y * gg); o.y = pk2(a.z * gg, a.w * gg); o.z = pk2(bq.x * gg, bq.y * gg); o.w = pk2(bq.z * gg, bq.w * gg); ((v4u*)WSP(WS_WXQ))[i] = o; } }
            { unsigned zz = 0u; asm volatile("" : "+v"(zz)); for (int i = gw * 64 + lane; i < 176 * D / 8; i += ngw * 64) ((v4u*)(WSP(WS_WIN) + (size_t)7248 * D))[i] = (v4u){zz, zz, zz, zz}; }
            if (l == 0) { for (int m = gw; m < M; m += ngw) gain_row_bf16(INP(0) + (size_t)m * D, INP(3), WSP(WS_H) + (size_t)m * D, (float*)(ws + WS_SS) + (size_t)m * 32, ws + WS_H8 + (size_t)m * 2048, lane); }
            for (int m = gw; m < MROWS; m += ngw) rms_row_bf16(INP(1) + (size_t)m * D, INP(18) + l * D, WSP(WS_MEMN) + (size_t)m * D, lane);
            if (l == 0) for (int i = gw * 64 + lane; i < SEQ * 32; i += ngw * 64) { const int pos = i >> 5, f = i & 31; const float inv = powf(10000.0f, -(float)(2 * f) / 64.0f); const float ang = (float)pos * inv;
                ((float*)(ws + WS_ROPE))[i] = cosf(ang); ((float*)(ws + WS_ROPE) + SEQ * 32)[i] = sinf(ang); }
        }
        SEAM(P + 0);
        if (((PHASE_MASK >> 1) & 1) && IN(P + 1)) for (int rep_ = 0; rep_ < 1 + ((PHASE_TWICE >> 1) & 1); ++rep_) { PHASE_LOCALS
            pg8::Gemm g{WSP(WS_H), WSP(WS_WIN), D, D, D};
            pg8::WinOrder S{G, bx, (long)WS_MEMN - (long)WS_H, (long)WS_WXKV - (long)WS_WIN};
            PANEL_RS(S, same)
            pg8::Gemm g8{(const bf16*)(ws + WS_H8), (const bf16*)(ws + WS_W8) - (size_t)29 * 256 * 1024, 1024, 1024, 1024}; pg8::GateOrder S8{G, bx};
            if (same) { pg8::EpiWin<true> E{WSP(WS_ZA), WSP(WS_ZABC), WSP(WS_ZG), WSP(WS_MEMKV), nullptr, INP(5) + (size_t)l * 3 * D, (const LAS float*)(lds + RSL_OFF)};
                        pg8::gemm_phase<pg8::EpiWin<true>, pg8::WinOrder, true>(ring, g, S, E, tid);
                        E.gsc = F8_GSC; pg8::gemm_phase<pg8::EpiWin<true>, pg8::GateOrder, true, true>(ring, g8, S8, E, tid); }
            else      { pg8::EpiWin<false> E{WSP(WS_ZA), WSP(WS_ZABC), WSP(WS_ZG), WSP(WS_MEMKV), (const float*)(ws + WS_SS), INP(5) + (size_t)l * 3 * D, nullptr};
                        pg8::gemm_phase<pg8::EpiWin<false>, pg8::WinOrder, true>(ring, g, S, E, tid);
                        E.gsc = F8_GSC; pg8::gemm_phase<pg8::EpiWin<false>, pg8::GateOrder, true, true>(ring, g8, S8, E, tid); }
        }
        SEAM(P + 1);
        if (((PHASE_MASK >> 2) & 1) && IN(P + 2)) for (int rep_ = 0; rep_ < 1 + ((PHASE_TWICE >> 2) & 1); ++rep_) { PHASE_LOCALS
            { BODY_LOCALS
              for (int it = vcu; it < 1024; it += G) { float wa[16], ba; gla_alpha_load(wa, ba, INP(6) + (size_t)l * 16 * 512, INP(7) + l * 512, (it >> 6) & 3, tid);
                  const GlaPre cur = gla_blr_load(WSP(WS_ZABC), (size_t)(it >> 8) * SEQ + 64 * (it & 63), tid);
                  gla_g1(ring, WSP(WS_ZABC), ((bf16*)xo), (float*)(ws + WS_GLADEC), cur, wa, ba, it, tid); } }
            { BODY_LOCALS attn_a_pass<1>(ring, WSP(WS_ZA), WSP(WS_OABC), (float*)(ws + WS_AML), INP(2), gw, ngw, bx & 7, bx >> 3, tid); }
            if (rep_ == 0) { BODY_LOCALS mla_prep(WSP(WS_ZABC), INP(9) + l * 512, INP(11) + l * 512, ((float*)(ws + WS_ROPE)), ((float*)(ws + WS_ROPE) + SEQ * 32), gw, ngw, lane); }
        }
        SEAM(P + 2);
        if (((PHASE_MASK >> 3) & 1) && IN(P + 3)) for (int rep_ = 0; rep_ < 1 + ((PHASE_TWICE >> 3) & 1); ++rep_) { PHASE_LOCALS
            { BODY_LOCALS attn_a_pass<2>(ring, WSP(WS_ZA), WSP(WS_OABC), (float*)(ws + WS_AML), INP(2), gw, ngw, bx & 7, bx >> 3, tid); }
            { BODY_LOCALS for (int gid = vcu * (NWAVES * 64) + tid; gid < 16 * 8192; gid += G * NWAVES * 64) gla_g2(((bf16*)xo), (const float*)(ws + WS_GLADEC), gid); }
#define MLAKV_D (((bf16*)xo) + (size_t)32 * 1024 * 1024)
            { BODY_LOCALS pg8::Gemm g{WSP(WS_ZABC) + ZC_CQA, WSP(WS_WQB), NABC, 512, 512};
              pg8::UpOrder S{G, bx, (long)(ZC_CKVA - ZC_CQA) * 2, (long)WS_WKVB - (long)WS_WQB};
              pg8::EpiUp E{WSP(WS_MLAQ), MLAKV_D};
              pg8::gemm_phase<pg8::EpiUp, pg8::UpOrder, true>(ring, g, S, E, tid); }
        }
        SEAM(P + 3);
        if (((PHASE_MASK >> 4) & 1) && IN(P + 4)) for (int rep_ = 0; rep_ < 1 + ((PHASE_TWICE >> 4) & 1); ++rep_) { PHASE_LOCALS
            { BODY_LOCALS
              for (int it = vcu; it < 1024; it += G) { float wa[16], ba; gla_alpha_load(wa, ba, INP(6) + (size_t)l * 16 * 512, INP(7) + l * 512, (it >> 6) & 3, tid);
                  const GlaPre cur = gla_blr_load(WSP(WS_ZABC), (size_t)(it >> 8) * SEQ + 64 * (it & 63), tid);
                  gla_g3(ring, WSP(WS_ZABC), ((bf16*)xo), WSP(WS_OABC), cur, wa, ba, INP(8) + l * 1024, it, tid); } }
        }
        if (((PHASE_MASK >> 5) & 1) && IN(P + 5)) for (int rep_ = 0; rep_ < 1 + ((PHASE_TWICE >> 5) & 1); ++rep_) { PHASE_LOCALS
            { BODY_LOCALS mla_attn_phase(ring, WSP(WS_MLAQ), MLAKV_D, WSP(WS_ZABC), WSP(WS_OABC), ((float*)(ws + WS_ROPE)), ((float*)(ws + WS_ROPE) + SEQ * 32), vcu, G, tid); }
            __syncthreads();
            { BODY_LOCALS pg8::Gemm g2{WSP(WS_MEMKV), WSP(WS_WXQ), 4096, D, 512}; pg8::KwOrder S2{G, bx}; pg8::EpiXW E2{WSP(WS_KW), 0};
              pg8::gemm_phase<pg8::EpiXW, pg8::KwOrder, true>(ring, g2, S2, E2, tid); }
            { BODY_LOCALS pg8::Gemm g3{WSP(WS_WXO), WSP(WS_MEMKV), D, 4096, 512}; pg8::VwOrder S3{G, (bx + 128) % G}; pg8::EpiXW E3{WSP(WS_VW), 1};
              pg8::gemm_phase<pg8::EpiXW, pg8::VwOrder, true>(ring, g3, S3, E3, tid); } }
        SEAM(P + 5);
#if MK_ONE_LAUNCH
        if (l == 0) {
            if (wave0 == 0 && lane_id_now() == 0) { unsigned* xid = (unsigned*)(ws0 + WS_CTL) + CW_XID + (bx & 63); asm volatile("" : "+s"(xid));
                const unsigned x0 = xb_ld(xid), x1 = xb_ld(xid + 64), x2 = xb_ld(xid + 128), x3 = xb_ld(xid + 192);
                MISC[16] = (G == 256 && x0 != 0u && x0 == x1 && x0 == x2 && x0 == x3) ? 1u : 0u; }
            __syncthreads(); }
#endif
        if (((PHASE_MASK >> 6) & 1) && IN(P + 6)) for (int rep_ = 0; rep_ < 1 + ((PHASE_TWICE >> 6) & 1); ++rep_) { PHASE_LOCALS
            pg8::Gemm g{WSP(WS_OABC), WSP(WS_WUP), 3072, 3072, 1024}; pg8::StaticOrder S; S.init(M, D, G, bx, 3, 1024);
            pg8::EpiMerge E{WSP(WS_MERGED), WSP(WS_ZG)};
            pg8::gemm_phase<pg8::EpiMerge, pg8::StaticOrder, true>(ring, g, S, E, tid);
        }
        GROUP_SEAM(P + 6, 0);
        if (((PHASE_MASK >> 7) & 1) && IN(P + 7)) for (int rep_ = 0; rep_ < 1 + ((PHASE_TWICE >> 7) & 1); ++rep_) { PHASE_LOCALS
            pg8::Gemm g{WSP(WS_MERGED), WSP(WS_WO), D, D, D}; pg8::StaticOrder S; S.init(M, D, G, bx);
            pg8::EpiResB E{WSP(WS_H), (float*)(ws + WS_SS)};
            pg8::gemm_phase<pg8::EpiResB, pg8::StaticOrder, false>(ring, g, S, E, tid);
        }
        GROUP_SEAM(P + 7, 1);
        if (((PHASE_MASK >> 9) & 1) && IN(P + 9)) for (int rep_ = 0; rep_ < 1 + ((PHASE_TWICE >> 9) & 1); ++rep_) { PHASE_LOCALS
            pg8::Gemm g{WSP(WS_H), WSP(WS_KW), D, D, D}; pg8::BatchOrder S; S.init(M, 1024, G, bx); S.bstride = (long)1024 * 2048 * 2;
            PANEL_RS(S, same)
            if (same) { pg8::EpiSoftmaxP<true> E{WSP(WS_P), nullptr, (PG8_LAS float*)(lds + XSCR_OFF), (const LAS float*)(lds + RSL_OFF)};
                        pg8::gemm_phase<pg8::EpiSoftmaxP<true>, pg8::BatchOrder, true>(ring, g, S, E, tid); }
            else      { pg8::EpiSoftmaxP<false> E{WSP(WS_P), (const float*)(ws + WS_SS), (PG8_LAS float*)(lds + XSCR_OFF), nullptr};
                        pg8::gemm_phase<pg8::EpiSoftmaxP<false>, pg8::BatchOrder, true>(ring, g, S, E, tid); }
        }
        GROUP_SEAM(P + 9, 2);
        if (((PHASE_MASK >> 11) & 1) && IN(P + 11)) for (int rep_ = 0; rep_ < 1 + ((PHASE_TWICE >> 11) & 1); ++rep_) { PHASE_LOCALS
            pg8::Gemm g{WSP(WS_P), WSP(WS_VW), pg8::LDP, 1024, 1024}; pg8::BatchOrder S; S.init(M, D, G, bx); S.bstride = (long)2048 * 1024 * 2;
            pg8::EpiResB E{WSP(WS_H), (float*)(ws + WS_SS)};
            pg8::gemm_phase<pg8::EpiResB, pg8::BatchOrder, false>(ring, g, S, E, tid);
        }
        GROUP_SEAM(P + 11, 3);
        if (((PHASE_MASK >> 13) & 1) && IN(P + 13)) for (int rep_ = 0; rep_ < 1 + ((PHASE_TWICE >> 13) & 1); ++rep_) { PHASE_LOCALS
            pg8::Gemm g{WSP(WS_H), WSP(WS_WFF), D, LDW, D}; pg8::StaticOrder S; S.init(M, NFF2, G, bx);
            PANEL_RS(S, same)
            if (same) { pg8::EpiSwiGLURS<true> E{WSP(WS_ACT), NG, nullptr, (const LAS float*)(lds + RSL_OFF)};
                        pg8::gemm_phase<pg8::EpiSwiGLURS<true>, pg8::StaticOrder, true>(ring, g, S, E, tid); }
            else      { pg8::EpiSwiGLURS<false> E{WSP(WS_ACT), NG, (const float*)(ws + WS_SS), nullptr};
                        pg8::gemm_phase<pg8::EpiSwiGLURS<false>, pg8::StaticOrder, true>(ring, g, S, E, tid); }
        }
        GROUP_SEAM(P + 13, 4);
        if (((PHASE_MASK >> 14) & 1) && IN(P + 14)) for (int rep_ = 0; rep_ < 1 + ((PHASE_TWICE >> 14) & 1); ++rep_) { PHASE_LOCALS
            pg8::Gemm g{WSP(WS_ACT), WSP(WS_WDN), NG  , LDACT, DFF}; pg8::StaticOrder S; S.init(M, D, G, bx);
            pg8::EpiResB E{WSP(WS_H), (float*)(ws + WS_SS), (l == 0) ? (ws + WS_H8) : nullptr}; pg8::gemm_phase<pg8::EpiResB, pg8::StaticOrder, false>(ring, g, S, E, tid);
        }
        if (l == 0) SEAM(P + 14); else GROUP_SEAM(P + 14, 5);
    }
    if (IN(2 * PH_PER_LAYER)) { PHASE_LOCALS
        const float* gfin = INP(26); f32x4 gv[8];
#pragma unroll
        for (int j = 0; j < 4; ++j) { gv[2 * j] = *(const f32x4*)(gfin + 8 * (lane + 64 * j)); gv[2 * j + 1] = *(const f32x4*)(gfin + 8 * (lane + 64 * j) + 4); }
        const bool g4 = (G == 256) && MK_ONE_LAUNCH;
        int m = g4 ? (256 * (8 * (bx & 7) + ((bx >> 3) & 7)) + 64 * (bx >> 6) + 8 * wave) : gw;
        const int step = g4 ? 1 : ngw, cnt = g4 ? 8 : (M - gw + ngw - 1) / ngw;
        for (int i = 0; i < cnt; ++i, m += step) final_row(WSP(WS_H) + (size_t)m * D, (const float*)(ws + WS_SS) + (size_t)m * 32, gv, xo + (size_t)m * D, lane); }
#undef IN
#undef SEAM
}

extern "C" void kernel_launch(void* const* d_in, const int* in_sizes, int n_in, void* d_out, int out_size, void* d_ws, size_t ws_size, hipStream_t stream) {
    static int grid = 0;
    if (grid == 0) {
        if (n_in != 27 || out_size != M * D || ws_size < WS_END) { fprintf(stderr, "kernel_launch: unexpected shapes (n_in %d out %d ws %zu)\n", n_in, out_size, ws_size); grid = -1; return; }
        int dev = 0, cus = 0, per_cu = 0;
        if (hipGetDevice(&dev) != hipSuccess || hipDeviceGetAttribute(&cus, hipDeviceAttributeMultiprocessorCount, dev) != hipSuccess) { grid = -1; return; }
        if (hipFuncSetAttribute((const void*)fwd_kernel, hipFuncAttributeMaxDynamicSharedMemorySize, LDS_BYTES) != hipSuccess) { grid = -1; return; }
        if (hipOccupancyMaxActiveBlocksPerMultiprocessor(&per_cu, (const void*)fwd_kernel, NWAVES * 64, LDS_BYTES) != hipSuccess || per_cu < 1)
            fprintf(stderr, "kernel_launch: occupancy query reports %d workgroups per CU\n", per_cu);
        (void)hipGetLastError();
        grid = cus;
    }
    if (grid < 0) return;
    if (hipMemsetAsync((char*)d_ws + WS_CTL, 0, CTL_ZERO_BYTES, stream) != hipSuccess) return;
    Args a{};
    for (int i = 0; i < 27; ++i) a.in[i] = (const float*)d_in[i];
    a.out = (float*)d_out; a.ws = (unsigned char*)d_ws;
#if MK_ONE_LAUNCH
    a.ph_lo = 0; a.ph_hi = N_PHASES;
    hipLaunchKernelGGL(fwd_kernel, dim3(grid), dim3(NWAVES * 64), LDS_BYTES, stream, a);
#else
    for (int p = 0; p < N_PHASES; ++p) { a.ph_lo = p; a.ph_hi = p + 1; hipLaunchKernelGGL(fwd_kernel, dim3(grid), dim3(NWAVES * 64), LDS_BYTES, stream, a); }
#endif
}
```
